# Optimizing an MI355X kernel written in HIP

```python
import math, functools
import jax, jax.numpy as jnp
from jax import lax
import numpy as np

D_MODEL = 1024
BATCH = 8
SEQ = 2048
DEPTH = 1
DEC_BATCH = 128
DEC_SEQ = 4
PAST_LEN = 16384
PAGE_SIZE = 128

N_META = 16
CHUNK = 64
H_RET = 4
DK_RET = D_MODEL // 8
DV_RET = D_MODEL // 8
H_GDN = 4
DK_GDN = D_MODEL // 8
DV_GDN = D_MODEL // 8
MIX_WIDTH = H_RET * DV_RET + H_GDN * DV_GDN
GDN_QKV = 2 * H_GDN * DK_GDN + H_GDN * DV_GDN
IN_WIDTH = 2 * H_RET * DK_RET + 2 * H_RET * DV_RET + GDN_QKV + H_GDN * DV_GDN + 2 * H_GDN
CONV_GDN = 4
CONV_FFN = 3
D_FF = ((8 * D_MODEL // 3 + 127) // 128) * 128
ROPE_THETA = 10000.0
EPS = 1e-6

kernel_name = 'hybrid_retention_gdn_convffn_step'


def rms_norm(x, w):
    xf = x.astype(jnp.float32)
    y = xf * lax.rsqrt(jnp.mean(xf * xf, axis=-1, keepdims=True) + EPS)
    return (y * w.astype(jnp.float32)).astype(x.dtype)


def head_layer_norm(o, w):
    mu = jnp.mean(o, axis=-1, keepdims=True)
    c = o - mu
    var = jnp.mean(c * c, axis=-1, keepdims=True)
    return c * lax.rsqrt(var + EPS) * w.astype(jnp.float32)


def head_rms_norm(o, w):
    return o * lax.rsqrt(jnp.mean(o * o, axis=-1, keepdims=True) + EPS) * w.astype(jnp.float32)


def l2_normalize(x):
    return x * lax.rsqrt(jnp.sum(x * x, axis=-1, keepdims=True) + EPS)


def rotary(x, pos):
    half = x.shape[-1] // 2
    inv_freq = ROPE_THETA ** (-jnp.arange(half, dtype=jnp.float32) / half)
    ang = pos.astype(jnp.float32)[:, None] * inv_freq[None, :]
    cos = jnp.cos(ang)[None, :, None, :]
    sin = jnp.sin(ang)[None, :, None, :]
    xf = x.astype(jnp.float32)
    x1, x2 = xf[..., :half], xf[..., half:]
    return jnp.concatenate([x1 * cos - x2 * sin, x1 * sin + x2 * cos], axis=-1)


def causal_depthwise_conv(x, buf, w):
    width = w.shape[0]
    length = x.shape[1]
    full = jnp.concatenate([buf.astype(x.dtype), x], axis=1)
    y = full[:, 0:length] * w[0]
    for i in range(1, width):
        y = y + full[:, i:i + length] * w[i]
    return y, full[:, full.shape[1] - (width - 1):]


def retention_log_gamma():
    return jnp.log1p(-jnp.power(2.0, -5.0 - jnp.arange(H_RET, dtype=jnp.float32)))


def to_chunks(x, chunk):
    b, h, l = x.shape[:3]
    return x.reshape((b, h, l // chunk, chunk) + x.shape[3:])


def from_chunks(x):
    b, h, n, c = x.shape[:4]
    return x.reshape((b, h, n * c) + x.shape[4:])


def run_leading_then_chunks(chunk_fn, n_lead, chunk, s0, tensors):
    outs = []
    s = s0
    if n_lead > 0:
        o, s = chunk_fn(*[to_chunks(t[:, :, :n_lead], n_lead) for t in tensors], s)
        outs.append(from_chunks(o))
    o, s = chunk_fn(*[to_chunks(t[:, :, n_lead:], chunk) for t in tensors], s)
    outs.append(from_chunks(o))
    return jnp.concatenate(outs, axis=2), s


def retention_chunked(q, k, v, s0, log_gamma):
    c = q.shape[3]
    idx = jnp.arange(c, dtype=jnp.float32)
    lg = log_gamma[:, None]
    diff = idx[:, None] - idx[None, :]
    dec_intra = jnp.exp(jnp.where(diff[None] >= 0, lg[:, :, None] * diff[None], -jnp.inf))
    q_dec = jnp.exp(lg * (idx + 1.0))[None, :, None, :, None]
    k_dec = jnp.exp(lg * (c - 1.0 - idx))[None, :, None, :, None]
    chunk_dec = jnp.exp(log_gamma * c)[None, :, None, None]
    scores = jnp.einsum('bhncd,bhnsd->bhncs', q, k) * dec_intra[None, :, None]
    o_intra = jnp.einsum('bhncs,bhnse->bhnce', scores, v)
    kv = jnp.einsum('bhncd,bhnce->bhnde', k * k_dec, v)
    qd = q * q_dec

    def step(s, inp):
        qn, kvn = inp
        o = jnp.einsum('bhcd,bhde->bhce', qn, s)
        return chunk_dec * s + kvn, o

    s_fin, o_cross = lax.scan(step, s0, (jnp.moveaxis(qd, 2, 0), jnp.moveaxis(kv, 2, 0)))
    return o_intra + jnp.moveaxis(o_cross, 0, 2), s_fin


def gdn_chunked(q, k, v, g, beta, s0):
    c = q.shape[3]
    cum = jnp.cumsum(g, axis=-1)
    ii = jnp.arange(c)
    tri = ii[:, None] >= ii[None, :]
    strict = ii[:, None] > ii[None, :]
    gdiff = cum[..., :, None] - cum[..., None, :]
    dmask = jnp.exp(jnp.where(tri, gdiff, -jnp.inf))
    kk = jnp.einsum('bhncd,bhnsd->bhncs', k, k)
    a = jnp.where(strict, beta[..., :, None] * kk * dmask, 0.0)
    eye = jnp.eye(c, dtype=q.dtype)
    rhs = jnp.concatenate([v * beta[..., None], k * (beta * jnp.exp(cum))[..., None]], axis=-1)
    sol = lax.linalg.triangular_solve(a + eye, rhs, left_side=True, lower=True, unit_diagonal=True)
    u, wk = sol[..., :v.shape[-1]], sol[..., v.shape[-1]:]
    qk = jnp.where(tri, jnp.einsum('bhncd,bhnsd->bhncs', q, k) * dmask, 0.0)
    q_dec = q * jnp.exp(cum)[..., None]
    k_dec = k * jnp.exp(cum[..., -1:] - cum)[..., None]
    chunk_dec = jnp.exp(cum[..., -1])

    def step(s, inp):
        un, wkn, qdn, qkn, kdn, cdn = inp
        w = un - jnp.einsum('bhcd,bhde->bhce', wkn, s)
        o = jnp.einsum('bhcd,bhde->bhce', qdn, s) + jnp.einsum('bhcs,bhse->bhce', qkn, w)
        s = cdn[:, :, None, None] * s + jnp.einsum('bhcd,bhce->bhde', kdn, w)
        return s, o

    xs = tuple(jnp.moveaxis(t, 2, 0) for t in (u, wk, q_dec, qk, k_dec, chunk_dec))
    s_fin, o = lax.scan(step, s0, xs)
    return jnp.moveaxis(o, 0, 2), s_fin


def decoder_layer(x, pos, n_lead, chunk, s_ret, s_gdn, buf_qkv, buf_ffn,
                  norm_mix, w_in, conv_gdn, gdn_a_log, gdn_dt_bias, norm_ret, norm_gdn, w_out,
                  norm_ffn, w_up, conv_ffn, w_down):
    b, l, _ = x.shape
    f32 = jnp.float32
    h = rms_norm(x, norm_mix)
    proj = h @ w_in
    sizes = [H_RET * DK_RET, H_RET * DK_RET, H_RET * DV_RET, H_RET * DV_RET, GDN_QKV, H_GDN * DV_GDN, H_GDN]
    offsets = [int(o) for o in np.cumsum(sizes)]
    rq, rk, rv, rg, qkv, gg, gb, ga = jnp.split(proj, offsets, axis=-1)

    def to_heads(t, nh):
        return jnp.swapaxes(t.reshape(b, l, nh, -1), 1, 2).astype(f32)

    rq_h = jnp.swapaxes(rotary(rq.reshape(b, l, H_RET, DK_RET), pos), 1, 2)
    rk_h = jnp.swapaxes(rotary(rk.reshape(b, l, H_RET, DK_RET), pos), 1, 2) * (DK_RET ** -0.5)
    rv_h = to_heads(rv, H_RET)
    ret_fn = functools.partial(retention_chunked, log_gamma=retention_log_gamma())
    o_ret, s_ret_new = run_leading_then_chunks(ret_fn, n_lead, chunk, s_ret.astype(f32), [rq_h, rk_h, rv_h])
    o_ret = head_layer_norm(jnp.swapaxes(o_ret, 1, 2), norm_ret.reshape(H_RET, DV_RET))
    o_ret = o_ret.reshape(b, l, H_RET * DV_RET).astype(x.dtype) * jax.nn.silu(rg)

    qkv, buf_qkv_new = causal_depthwise_conv(qkv, buf_qkv, conv_gdn)
    qkv = jax.nn.silu(qkv)
    gq, gk, gv = jnp.split(qkv, [H_GDN * DK_GDN, 2 * H_GDN * DK_GDN], axis=-1)
    gq_h = l2_normalize(to_heads(gq, H_GDN)) * (DK_GDN ** -0.5)
    gk_h = l2_normalize(to_heads(gk, H_GDN))
    gv_h = to_heads(gv, H_GDN)
    beta = jnp.swapaxes(jax.nn.sigmoid(gb.astype(f32)), 1, 2)
    decay = -jnp.exp(gdn_a_log.astype(f32)) * jax.nn.softplus(ga.astype(f32) + gdn_dt_bias.astype(f32))
    decay = jnp.swapaxes(decay, 1, 2)
    o_gdn, s_gdn_new = run_leading_then_chunks(gdn_chunked, n_lead, chunk, s_gdn.astype(f32), [gq_h, gk_h, gv_h, decay, beta])
    o_gdn = head_rms_norm(jnp.swapaxes(o_gdn, 1, 2), norm_gdn)
    o_gdn = o_gdn.reshape(b, l, H_GDN * DV_GDN).astype(x.dtype) * jax.nn.silu(gg)

    x = x + jnp.concatenate([o_ret, o_gdn], axis=-1) @ w_out

    u, buf_ffn_new = causal_depthwise_conv(rms_norm(x, norm_ffn) @ w_up, buf_ffn, conv_ffn)
    gate, val = jnp.split(u, 2, axis=-1)
    x = x + (jax.nn.silu(gate) * val) @ w_down
    return x, s_ret_new, s_gdn_new, buf_qkv_new, buf_ffn_new


def setup_inputs(seed: int = 0) -> dict:
    key = jax.random.key(seed)
    ks = jax.random.split(key, 24)
    f32 = jnp.float32
    n = lambda k, s, sc: jax.random.normal(k, s, f32) * sc
    dt = jnp.exp(jax.random.uniform(ks[10], (DEPTH, H_GDN), f32, math.log(0.001), math.log(0.1)))
    return {
        'x_prompt': n(ks[0], (BATCH, SEQ, D_MODEL), 1.0),
        'x_sample': n(ks[1], (DEC_BATCH, DEC_SEQ, D_MODEL), 1.0),
        'state_ret': n(ks[2], (DEPTH, DEC_BATCH, H_RET, DK_RET, DV_RET), 1.0),
        'state_gdn': n(ks[3], (DEPTH, DEC_BATCH, H_GDN, DK_GDN, DV_GDN), DK_GDN ** -0.5),
        'state_conv_qkv': n(ks[4], (DEPTH, DEC_BATCH, CONV_GDN - 1, GDN_QKV), 1.0),
        'state_ffn_conv': n(ks[5], (DEPTH, DEC_BATCH, CONV_FFN - 1, 2 * D_FF), 1.0),
        'meta_tokens': n(ks[6], (N_META, D_MODEL), 1.0),
        'norm_mix': 1.0 + n(ks[7], (DEPTH, D_MODEL), 0.02),
        'w_in': n(ks[8], (DEPTH, D_MODEL, IN_WIDTH), D_MODEL ** -0.5),
        'conv_gdn': n(ks[9], (DEPTH, CONV_GDN, GDN_QKV), CONV_GDN ** -0.5),
        'gdn_a_log': jnp.log(jax.random.uniform(ks[11], (DEPTH, H_GDN), f32, 1.0, 16.0)),
        'gdn_dt_bias': dt + jnp.log(-jnp.expm1(-dt)),
        'norm_ret': 1.0 + n(ks[12], (DEPTH, H_RET * DV_RET), 0.02),
        'norm_gdn': 1.0 + n(ks[13], (DEPTH, DV_GDN), 0.02),
        'w_out': n(ks[14], (DEPTH, MIX_WIDTH, D_MODEL), MIX_WIDTH ** -0.5),
        'norm_ffn': 1.0 + n(ks[15], (DEPTH, D_MODEL), 0.02),
        'w_up': n(ks[16], (DEPTH, D_MODEL, 2 * D_FF), D_MODEL ** -0.5),
        'conv_ffn': n(ks[17], (DEPTH, CONV_FFN, 2 * D_FF), CONV_FFN ** -0.5),
        'w_down': n(ks[18], (DEPTH, D_FF, D_MODEL), D_FF ** -0.5),
        'norm_final': 1.0 + n(ks[19], (D_MODEL,), 0.02),
    }


def reference(x_prompt, x_sample, state_ret, state_gdn, state_conv_qkv, state_ffn_conv,
              meta_tokens, norm_mix, w_in, conv_gdn, gdn_a_log, gdn_dt_bias, norm_ret, norm_gdn, w_out,
              norm_ffn, w_up, conv_ffn, w_down, norm_final):
    bp = x_prompt.shape[0]
    meta = jnp.broadcast_to(meta_tokens[None].astype(x_prompt.dtype), (bp, N_META, D_MODEL))
    xp = jnp.concatenate([meta, x_prompt], axis=1)
    xs = x_sample
    pos_p = jnp.arange(xp.shape[1], dtype=jnp.int32)
    pos_s = PAST_LEN + jnp.arange(xs.shape[1], dtype=jnp.int32)
    p_ret, p_gdn, p_cq, p_cf = [], [], [], []
    s_ret_l, s_gdn_l, s_cq, s_cf = [], [], [], []
    for layer in range(DEPTH):
        params = (norm_mix[layer], w_in[layer], conv_gdn[layer], gdn_a_log[layer], gdn_dt_bias[layer],
                  norm_ret[layer], norm_gdn[layer], w_out[layer], norm_ffn[layer], w_up[layer],
                  conv_ffn[layer], w_down[layer])
        z_ret = jnp.zeros((bp, H_RET, DK_RET, DV_RET), jnp.float32)
        z_gdn = jnp.zeros((bp, H_GDN, DK_GDN, DV_GDN), jnp.float32)
        z_cq = jnp.zeros((bp, CONV_GDN - 1, GDN_QKV), xp.dtype)
        z_cf = jnp.zeros((bp, CONV_FFN - 1, 2 * D_FF), xp.dtype)
        xp, a, bq, c, d = decoder_layer(xp, pos_p, N_META, CHUNK, z_ret, z_gdn, z_cq, z_cf, *params)
        p_ret.append(a); p_gdn.append(bq); p_cq.append(c); p_cf.append(d)
        xs, a, bq, c, d = decoder_layer(xs, pos_s, 0, xs.shape[1], state_ret[layer], state_gdn[layer],
                                        state_conv_qkv[layer], state_ffn_conv[layer], *params)
        s_ret_l.append(a); s_gdn_l.append(bq); s_cq.append(c); s_cf.append(d)
    y_prompt = rms_norm(xp[:, N_META:], norm_final)
    y_sample = rms_norm(xs, norm_final)
    return (y_prompt, y_sample,
            jnp.stack(p_ret), jnp.stack(p_gdn), jnp.stack(p_cq), jnp.stack(p_cf),
            jnp.stack(s_ret_l), jnp.stack(s_gdn_l), jnp.stack(s_cq), jnp.stack(s_cf))
```

```cpp
#include <hip/hip_runtime.h>
#include <cstdio>
#include <cstdint>

#ifndef MK_N_LAUNCHES
#define MK_N_LAUNCHES 1
#endif

#define LAS __attribute__((address_space(3)))
typedef unsigned short bf16_t;
typedef short bf16x8 __attribute__((ext_vector_type(8)));
typedef short s16x4 __attribute__((ext_vector_type(4)));
typedef float f32x4 __attribute__((ext_vector_type(4)));
typedef unsigned u32x4 __attribute__((ext_vector_type(4)));
typedef unsigned u32x2 __attribute__((ext_vector_type(2)));

constexpr int DM = 1024, LP = 2064, NBATCH = 8, MPROMPT = NBATCH * LP  , NSB = 128, MSAMP = 512, MREAL = MPROMPT + MSAMP  , MPAD = 17152  ;
constexpr int NIN = 4096, INW = 4104, DFF = 2816, NUP = 5632, GQKV = 1536;
constexpr int UP_TROWS = 248, UP_NM = 69;
constexpr float EPS = 1e-6f;
constexpr size_t O_YP = 0, O_YS = 16777216, O_PSR = 17301504, O_PSG = 17825792, O_PCQ = 18350080, O_PCF = 18386944, O_SSR = 18477056, O_SSG = 26865664, O_SCQ = 35254272, O_SCF = 35844096, O_TOTAL = 37285888;
constexpr size_t MiB = 1u << 20;
constexpr size_t WS_CTL = 0, CTL_ZERO_BYTES = 1 * MiB;
constexpr size_t WS_WIN = 1 * MiB, WS_WOUT = 9 * MiB, WS_WUP = 11 * MiB, WS_WDN = 22 * MiB, WS_ROT = 28 * MiB, WS_BG = 30 * MiB, WS_RSQ2 = 31 * MiB, WS_RSQ3 = 32 * MiB + 512 * 1024;
constexpr size_t WS_PGX = 34 * MiB;
constexpr size_t WS_BIG = 36 * MiB;
constexpr size_t WS_PR = WS_BIG, WS_PG = WS_BIG + 67 * MiB, WS_G2A = WS_BIG + 134 * MiB, WS_H = WS_G2A;
constexpr size_t WS_X2F = WS_BIG, WS_X2B = WS_BIG + 67 * MiB, WS_ACT = WS_BIG + 101 * MiB;
constexpr size_t SLOT = 73984;
constexpr size_t WS_END = 256 * MiB;
static_assert(WS_G2A + 1056 * SLOT <= WS_END && WS_ACT + (size_t)MPAD * DFF * 2 <= WS_END, "ws map");
constexpr size_t OS_MIX = 0, OS_SCR = 34 * MiB;
static_assert(OS_SCR + 256 * SLOT <= 64 * MiB, "d_out scratch");
constexpr int CW_BAR = 4096;
constexpr int RING_BYTES = 131072, LDSCTL_OFF = RING_BYTES, MISC_OFF = LDSCTL_OFF + 320, LDS_BYTES = 147456;

#define LDS_WAIT() asm volatile("s_waitcnt lgkmcnt(0)" ::: "memory")
#define VM_WAIT() asm volatile("s_waitcnt vmcnt(0)" ::: "memory")

__device__ __forceinline__ unsigned cvt_pk_bf16(float lo, float hi) { unsigned r; asm volatile("v_cvt_pk_bf16_f32 %0, %1, %2" : "=v"(r) : "v"(lo), "v"(hi)); return r; }
__device__ __forceinline__ float bflo(unsigned w) { return __uint_as_float(w << 16); }
__device__ __forceinline__ float bfhi(unsigned w) { return __uint_as_float(w & 0xffff0000u); }
__device__ __forceinline__ float bfround(float x) { return bflo(cvt_pk_bf16(x, 0.f)); }
__device__ __forceinline__ float silu_f(float y) { return y * __builtin_amdgcn_rcpf(1.0f + __expf(-y)); }
__device__ __forceinline__ float wave_sum(float v) {
#pragma unroll
    for (int o = 1; o < 64; o <<= 1) v += __shfl_xor(v, o);
    return v;
}
__device__ __forceinline__ float dpp_shr1(float x) { return __int_as_float(__builtin_amdgcn_update_dpp(0, __float_as_int(x), 0x111, 0xf, 0xf, true)); }

struct RowInfo { int t, len, idx, samp; };
__device__ __forceinline__ RowInfo rowinfo(int g) {
    RowInfo r;
    if (g < MPROMPT) { r.idx = g / LP; r.t = g - r.idx * LP; r.len = LP; r.samp = 0; }
    else { const int s = g - MPROMPT; r.idx = s >> 2; r.t = s & 3; r.len = 4; r.samp = 1; }
    return r;
}

namespace pg8 {
constexpr int BM = 256, BK = 64, HALF = 128, HTB = HALF * BK * 2, STAGE_BYTES = 8 * HTB, NXCD = 8, WGM = 8;
__host__ __device__ __forceinline__ int lds_byte(int r, int c) { const int st = (r >> 4) * 2 + (c >> 5), rr = r & 15, cc = c & 31, ob = rr * 64 + cc * 2; return st * 1024 + (ob ^ (((ob >> 9) & 1) << 5)); }
__host__ __device__ __forceinline__ void stage_rc(int b, int& R, int& C) { const int st = b / 1024, sb = b % 1024, swz = sb ^ (((sb >> 9) & 1) << 5); R = (st >> 1) * 16 + swz / 64; C = (st & 1) * 32 + (swz % 64) / 2; }
__host__ __device__ __forceinline__ int perm32(int rho) { const int n = rho >> 4, i = rho & 15; return 8 * (i >> 2) + 4 * n + (i & 3); }
struct Unit { int pm, pn; };
struct Gemm { const bf16_t* A; const bf16_t* Bt; int K; };
struct StaticOrder {
    int nM, nN, nwg, G, c;
    __host__ __device__ void init(int nM_, int nN_, int G_, int c_) { nM = nM_; nN = nN_; nwg = nM * nN; G = G_; c = c_; }
    __host__ __device__ bool next(int i, Unit& u) const {
        const long L = (long)i * G + c; if (L >= nwg) return false;
        int wgid = (int)L; { const int q = nwg / NXCD, r = nwg % NXCD, xcd = wgid % NXCD, off = wgid / NXCD; wgid = (xcd < r ? xcd * (q + 1) : r * (q + 1) + (xcd - r) * q) + off; }
        const int nig = WGM * nN, gid = wgid / nig, fm = gid * WGM, gsz = (nM - fm) < WGM ? (nM - fm) : WGM;
        u.pm = fm + ((wgid % nig) % gsz); u.pn = (wgid % nig) / gsz; return true;
    }
    __device__ __forceinline__ void a_ready(const Unit&) const {}
    __device__ __forceinline__ void done(const Unit&) const {}
};
struct MapPlain { static constexpr int HROWS = 128, TROWS = 256; static __device__ __forceinline__ int row(int R) { return R; } };
struct MapUp { static constexpr int HROWS = 124, TROWS = UP_TROWS; static __device__ __forceinline__ int row(int R) { return 62 * (R >> 6) - 2 + 4 * (R & 15) + ((R >> 4) & 3); } };

template <class Epi, class Sched, class AMap, bool ALIGN_EPI = true>
__device__ __forceinline__ void gemm_phase(LAS unsigned char* lds, const Gemm g, const Sched& S, const Epi& E) {
    const int tid = threadIdx.x, wid = __builtin_amdgcn_readfirstlane(tid >> 6), lane = tid & 63, wr = wid >> 2, wc = wid & 3, fr = lane & 15, fq = lane >> 4;
    const int K = g.K, nt = K / BK;
    int voffA[2], voffB[2];
#pragma unroll
    for (int i = 0; i < 2; ++i) { int R, C; stage_rc(tid * 16 + i * 8192, R, C); const int Rb = Epi::PERM ? ((R & ~31) + perm32(R & 31)) : R;
        voffA[i] = (AMap::row(R) * K + C) * 2; voffB[i] = (Rb * K + C) * 2; }
    const size_t kstep = (size_t)(BK * 2);
    const size_t hstepA = (size_t)AMap::HROWS * K * 2, tstepA = (size_t)AMap::TROWS * K * 2;
    const size_t hstepB = (size_t)HALF * K * 2, tstepB = 2 * hstepB;
    const unsigned ldsw = (unsigned)wid * 1024u;
    const int aoff = lds_byte(wr * 64 + fr, fq * 8), boff = lds_byte(wc * 32 + fr, fq * 8);
#define PG8_SA(b, h) (((b) * 2 + (h)) * HTB)
#define PG8_SB(b, h) ((4 + (b) * 2 + (h)) * HTB)
#define PG8_STAGE(bufoff, gbase, voff) do { _Pragma("unroll") for (int _i = 0; _i < 2; ++_i) \
        __builtin_amdgcn_global_load_lds((const unsigned*)((const char*)(gbase) + (voff)[_i]), (LAS unsigned*)(lds + (bufoff) + ldsw + _i * 8192), 16, 0, 0); } while (0)
#define PG8_LDA(dst, b, h) do { _Pragma("unroll") for (int m = 0; m < 4; ++m) _Pragma("unroll") for (int k = 0; k < 2; ++k) dst[m][k] = *(const LAS bf16x8*)(lds + PG8_SA(b, h) + aoff + m * 2048 + k * 1024); } while (0)
#define PG8_LDB(dst, b, h) do { _Pragma("unroll") for (int n = 0; n < 2; ++n) _Pragma("unroll") for (int k = 0; k < 2; ++k) dst[n][k] = *(const LAS bf16x8*)(lds + PG8_SB(b, h) + boff + n * 2048 + k * 1024); } while (0)
#define PG8_MMA(ai, bj, At, Bt) do { __builtin_amdgcn_s_setprio(1); _Pragma("unroll") for (int m = 0; m < 4; ++m) _Pragma("unroll") for (int n = 0; n < 2; ++n) _Pragma("unroll") for (int k = 0; k < 2; ++k) \
        acc[ai][bj][m][n] = __builtin_amdgcn_mfma_f32_16x16x32_bf16(Bt[n][k], At[m][k], acc[ai][bj][m][n], 0, 0, 0); __builtin_amdgcn_s_setprio(0); } while (0)
#define PG8_WAIT_V(n) asm volatile("s_waitcnt vmcnt(" #n ")" ::: "memory")
#define PG8_WAIT_L(n) asm volatile("s_waitcnt lgkmcnt(" #n ")" ::: "memory")
#define PG8_BAR __builtin_amdgcn_s_barrier()
#define PG8_SCHED __builtin_amdgcn_sched_barrier(0)
    Unit cur, nxt; int ui = 0;
    if (!S.next(0, cur)) return;
    f32x4 acc[2][2][4][2];
#pragma unroll
    for (int a = 0; a < 2; ++a)
#pragma unroll
        for (int b = 0; b < 2; ++b)
#pragma unroll
            for (int m = 0; m < 4; ++m)
#pragma unroll
                for (int n = 0; n < 2; ++n) acc[a][b][m][n] = (f32x4){0.f, 0.f, 0.f, 0.f};
    bf16x8 At[4][2], B0[2][2], B1[2][2];
    const char* cA = (const char*)g.A + (size_t)cur.pm * tstepA; const char* cB = (const char*)g.Bt + (size_t)cur.pn * tstepB;
    S.a_ready(cur);
    PG8_STAGE(PG8_SB(0, 0), cB, voffB); PG8_STAGE(PG8_SB(0, 1), cB + hstepB, voffB); PG8_STAGE(PG8_SA(0, 0), cA, voffA); PG8_STAGE(PG8_SA(0, 1), cA + hstepA, voffA);
    if (wr == 1) PG8_BAR;
    PG8_WAIT_V(2); PG8_BAR;
    PG8_STAGE(PG8_SB(1, 0), cB + kstep, voffB); PG8_STAGE(PG8_SA(1, 0), cA + kstep, voffA); PG8_STAGE(PG8_SB(1, 1), cB + hstepB + kstep, voffB);
    PG8_WAIT_V(6); PG8_BAR;
    for (;;) {
        const bool has_next = S.next(ui + 1, nxt);
        const char* nA = has_next ? (const char*)g.A + (size_t)nxt.pm * tstepA : cA; const char* nB = has_next ? (const char*)g.Bt + (size_t)nxt.pn * tstepB : cB;
        for (int t = 0; t < nt; t += 2) {
            const bool last = (t == nt - 2);
            const char* a1 = cA + (size_t)(t + 1) * kstep;
            const char* a2 = last ? nA : cA + (size_t)(t + 2) * kstep; const char* b2 = last ? nB : cB + (size_t)(t + 2) * kstep;
            const char* a3 = a2 + kstep; const char* b3 = b2 + kstep;
            if (last && has_next) S.a_ready(nxt);
            PG8_LDB(B0, 0, 0); PG8_LDB(B1, 0, 1); PG8_SCHED; PG8_LDA(At, 0, 0); PG8_STAGE(PG8_SA(1, 1), a1 + hstepA, voffA);
            PG8_WAIT_V(8); PG8_WAIT_L(0); PG8_BAR; PG8_MMA(0, 0, At, B0); PG8_MMA(0, 1, At, B1); PG8_BAR; PG8_SCHED;
            PG8_LDA(At, 0, 1); PG8_STAGE(PG8_SB(0, 0), b2, voffB); PG8_STAGE(PG8_SB(0, 1), b2 + hstepB, voffB); PG8_STAGE(PG8_SA(0, 0), a2, voffA);
            PG8_WAIT_V(8); PG8_WAIT_L(0); PG8_BAR; PG8_MMA(1, 0, At, B0); PG8_MMA(1, 1, At, B1); PG8_BAR; PG8_SCHED;
            PG8_LDB(B0, 1, 0); PG8_LDB(B1, 1, 1); PG8_SCHED; PG8_LDA(At, 1, 0); PG8_STAGE(PG8_SA(0, 1), a2 + hstepA, voffA);
            PG8_WAIT_V(8); PG8_WAIT_L(0); PG8_BAR; PG8_MMA(0, 0, At, B0); PG8_MMA(0, 1, At, B1); PG8_BAR; PG8_SCHED;
            PG8_LDA(At, 1, 1); PG8_STAGE(PG8_SB(1, 0), b3, voffB); PG8_STAGE(PG8_SB(1, 1), b3 + hstepB, voffB); PG8_STAGE(PG8_SA(1, 0), a3, voffA);
            PG8_WAIT_V(8); PG8_WAIT_L(0); PG8_BAR; PG8_MMA(1, 0, At, B0); PG8_MMA(1, 1, At, B1); PG8_BAR; PG8_SCHED;
        }
        if constexpr (ALIGN_EPI) { if (wr == 0) PG8_BAR; }
        E(acc, cur, wr, wc, fr, fq); S.done(cur);
        if (!has_next) break;
#pragma unroll
        for (int a = 0; a < 2; ++a)
#pragma unroll
            for (int b = 0; b < 2; ++b)
#pragma unroll
                for (int m = 0; m < 4; ++m)
#pragma unroll
                    for (int n = 0; n < 2; ++n) acc[a][b][m][n] = (f32x4){0.f, 0.f, 0.f, 0.f};
        cur = nxt; cA = nA; cB = nB; ++ui;
        if constexpr (ALIGN_EPI) { if (wr == 1) PG8_BAR; }
    }
    PG8_WAIT_V(0);
    if constexpr (!ALIGN_EPI) { if (wr == 0) PG8_BAR; }
    PG8_BAR;
#undef PG8_SA
#undef PG8_SB
#undef PG8_STAGE
#undef PG8_LDA
#undef PG8_LDB
#undef PG8_MMA
#undef PG8_WAIT_V
#undef PG8_WAIT_L
#undef PG8_BAR
#undef PG8_SCHED
}
}
using pg8::Unit;


struct EpiIn {
    static constexpr bool PERM = true;
    bf16_t* PR; bf16_t* PG; const float* rot; float* out;
    __device__ __forceinline__ void operator()(const f32x4 (&acc)[2][2][4][2], const Unit& u, int wr, int wc, int fr_, int fq_) const {
        int ln_; asm volatile("v_mbcnt_lo_u32_b32 %0, -1, 0\n\tv_mbcnt_hi_u32_b32 %0, -1, %0" : "=v"(ln_)); const int fr = ln_ & 15, fq = ln_ >> 4;
        const int pn = u.pn, rbase = u.pm * 256 + wr * 64 + fr;
        if (pn < 4) {
            const int head = (pn & 1) * 2 + (wc >> 1), j0 = 32 * (wc & 1) + 8 * fq;
            const float sc = pn >= 2 ? 0.08838834764831845f : 1.0f;
            bf16_t* dstb = PR + (pn >= 2 ? 512 : 0) + head * 128 + j0;
#pragma unroll
            for (int ai = 0; ai < 2; ++ai)
#pragma unroll
                for (int m = 0; m < 4; ++m) {
                    const int row = rbase + ai * 128 + m * 16;
                    int ridx = 0; if (row < MPROMPT) ridx = row % LP; else if (row < MREAL) ridx = LP + ((row - MPROMPT) & 3);
                    const f32x4* rp = (const f32x4*)(rot + (size_t)ridx * 128 + j0 * 2);
                    const f32x4 cs0 = rp[0], cs1 = rp[1], cs2 = rp[2], cs3 = rp[3];
                    const f32x4 a0 = acc[ai][0][m][0], a1 = acc[ai][0][m][1], b0 = acc[ai][1][m][0], b1 = acc[ai][1][m][1];
                    const float c[8] = {cs0[0], cs0[2], cs1[0], cs1[2], cs2[0], cs2[2], cs3[0], cs3[2]};
                    const float s[8] = {cs0[1], cs0[3], cs1[1], cs1[3], cs2[1], cs2[3], cs3[1], cs3[3]};
                    const float x1[8] = {a0[0], a0[1], a0[2], a0[3], a1[0], a1[1], a1[2], a1[3]};
                    const float x2[8] = {b0[0], b0[1], b0[2], b0[3], b1[0], b1[1], b1[2], b1[3]};
                    float o1[8], o2[8];
#pragma unroll
                    for (int i = 0; i < 8; ++i) { o1[i] = (x1[i] * c[i] - x2[i] * s[i]) * sc; o2[i] = (x1[i] * s[i] + x2[i] * c[i]) * sc; }
                    u32x4 w1, w2; w1.x = cvt_pk_bf16(o1[0], o1[1]); w1.y = cvt_pk_bf16(o1[2], o1[3]); w1.z = cvt_pk_bf16(o1[4], o1[5]); w1.w = cvt_pk_bf16(o1[6], o1[7]);
                    w2.x = cvt_pk_bf16(o2[0], o2[1]); w2.y = cvt_pk_bf16(o2[2], o2[3]); w2.z = cvt_pk_bf16(o2[4], o2[5]); w2.w = cvt_pk_bf16(o2[6], o2[7]);
                    bf16_t* rowp = dstb + (size_t)row * 2048;
                    *(u32x4*)(rowp) = w1; *(u32x4*)(rowp + 64) = w2;
                }
        } else {
            const bool act = (pn == 6 || pn == 7 || pn >= 14);
            const bool cst = (pn >= 8 && pn < 14);
            bf16_t* dbase = pn < 8 ? PR : PG;
            const int colt = (pn < 8 ? pn * 256 : pn * 256 - 2048) + wc * 32 + 8 * fq;
#pragma unroll
            for (int ai = 0; ai < 2; ++ai)
#pragma unroll
                for (int m = 0; m < 4; ++m) {
                    const int row = rbase + ai * 128 + m * 16;
                    bf16_t* rowp = dbase + (size_t)row * 2048 + colt;
                    float* cdst = nullptr;
                    if (cst && row < MREAL) { const RowInfo ri = rowinfo(row); if (ri.t >= ri.len - 3) cdst = out + (ri.samp ? O_SCQ : O_PCQ) + (size_t)(ri.idx * 3 + (ri.t - (ri.len - 3))) * GQKV + colt; }
#pragma unroll
                    for (int bj = 0; bj < 2; ++bj) {
                        f32x4 v0 = acc[ai][bj][m][0], v1 = acc[ai][bj][m][1];
                        if (cdst) { *(f32x4*)(cdst + bj * 128) = v0; *(f32x4*)(cdst + bj * 128 + 4) = v1; }
                        if (act) {
#pragma unroll
                            for (int i = 0; i < 4; ++i) { v0[i] = silu_f(v0[i]); v1[i] = silu_f(v1[i]); }
                        }
                        u32x4 w; w.x = cvt_pk_bf16(v0[0], v0[1]); w.y = cvt_pk_bf16(v0[2], v0[3]); w.z = cvt_pk_bf16(v1[0], v1[1]); w.w = cvt_pk_bf16(v1[2], v1[3]);
                        *(u32x4*)(rowp + bj * 128) = w;
                    }
                }
        }
    }
};

__device__ __forceinline__ const float* x_src_row(const float* xp, const float* xs, const float* meta, int g) {
    if (g < MPROMPT) { const int b = g / LP, t = g - b * LP; return t < 16 ? meta + (size_t)t * DM : xp + ((size_t)b * 2048 + (t - 16)) * DM; }
    return xs + (size_t)(g - MPROMPT) * DM;
}

struct EpiOut {
    static constexpr bool PERM = false;
    const float* xp; const float* xs; const float* meta; float* X2F; bf16_t* X2B; float* rsq;
    __device__ __forceinline__ void operator()(const f32x4 (&acc)[2][2][4][2], const Unit& u, int wr, int wc, int fr_, int fq_) const {
        int ln_; asm volatile("v_mbcnt_lo_u32_b32 %0, -1, 0\n\tv_mbcnt_hi_u32_b32 %0, -1, %0" : "=v"(ln_)); const int fr = ln_ & 15, fq = ln_ >> 4;
        const int rbase = u.pm * 256 + wr * 64 + fr, col0 = u.pn * 256 + wc * 32 + 4 * fq;
#pragma unroll
        for (int ai = 0; ai < 2; ++ai)
#pragma unroll
            for (int m = 0; m < 4; ++m) {
                const int row = rbase + ai * 128 + m * 16;
                const float* xr = row < MREAL ? x_src_row(xp, xs, meta, row) + col0 : nullptr;
                float* of = X2F + (size_t)row * DM + col0; bf16_t* ob = X2B + (size_t)row * DM + col0;
                float ss = 0.f;
#pragma unroll
                for (int bj = 0; bj < 2; ++bj)
#pragma unroll
                    for (int n = 0; n < 2; ++n) {
                        f32x4 v = acc[ai][bj][m][n];
                        if (xr) v += *(const f32x4*)(xr + bj * 128 + n * 16);
                        ss += (v[0] * v[0] + v[1] * v[1]) + (v[2] * v[2] + v[3] * v[3]);
                        *(f32x4*)(of + bj * 128 + n * 16) = v;
                        u32x2 w; w.x = cvt_pk_bf16(v[0], v[1]); w.y = cvt_pk_bf16(v[2], v[3]);
                        *(u32x2*)(ob + bj * 128 + n * 16) = w;
                    }
                ss += __shfl_xor(ss, 16); ss += __shfl_xor(ss, 32);
                if (fq == 0) rsq[(size_t)row * 16 + u.pn * 4 + wc] = ss;
            }
    }
};

struct EpiDown {
    static constexpr bool PERM = false;
    const float* X2F; float* out; float* rsq;
    __device__ __forceinline__ void operator()(const f32x4 (&acc)[2][2][4][2], const Unit& u, int wr, int wc, int fr_, int fq_) const {
        int ln_; asm volatile("v_mbcnt_lo_u32_b32 %0, -1, 0\n\tv_mbcnt_hi_u32_b32 %0, -1, %0" : "=v"(ln_)); const int fr = ln_ & 15, fq = ln_ >> 4;
        const int rbase = u.pm * 256 + wr * 64 + fr, col0 = u.pn * 256 + wc * 32 + 4 * fq;
#pragma unroll
        for (int ai = 0; ai < 2; ++ai)
#pragma unroll
            for (int m = 0; m < 4; ++m) {
                const int row = rbase + ai * 128 + m * 16;
                float* yr = nullptr;
                if (row < MPROMPT) { const int b = row / LP, t = row - b * LP; if (t >= 16) yr = out + O_YP + ((size_t)b * 2048 + (t - 16)) * DM + col0; }
                else if (row < MREAL) yr = out + O_YS + (size_t)(row - MPROMPT) * DM + col0;
                const float* xr = X2F + (size_t)row * DM + col0;
                float ss = 0.f;
#pragma unroll
                for (int bj = 0; bj < 2; ++bj)
#pragma unroll
                    for (int n = 0; n < 2; ++n) {
                        const f32x4 v = acc[ai][bj][m][n] + *(const f32x4*)(xr + bj * 128 + n * 16);
                        ss += (v[0] * v[0] + v[1] * v[1]) + (v[2] * v[2] + v[3] * v[3]);
                        if (yr) *(f32x4*)(yr + bj * 128 + n * 16) = v;
                    }
                ss += __shfl_xor(ss, 16); ss += __shfl_xor(ss, 32);
                if (fq == 0) rsq[(size_t)row * 16 + u.pn * 4 + wc] = ss;
            }
    }
};

struct EpiUp {
    static constexpr bool PERM = true;
    const float* rsq2; const float* cw; const float* stf; bf16_t* act; float* out;
    __device__ __forceinline__ void operator()(const f32x4 (&acc)[2][2][4][2], const Unit& u, int wr, int wc, int fr_, int fq_) const {
        int ln_; asm volatile("v_mbcnt_lo_u32_b32 %0, -1, 0\n\tv_mbcnt_hi_u32_b32 %0, -1, %0" : "=v"(ln_)); const int fr = ln_ & 15, fq = ln_ >> 4;
        const int colg = u.pn * 128 + wc * 32 + fq * 8;
#pragma unroll
        for (int ai = 0; ai < 2; ++ai) {
            const int g0 = u.pm * UP_TROWS + (2 * ai + wr) * 62 - 2 + 4 * fr;
            float rs[4];
#pragma unroll
            for (int m = 0; m < 4; ++m) {
                int g = g0 + m; g = g < 0 ? 0 : g;
                const f32x4* p = (const f32x4*)(rsq2 + (size_t)g * 16);
                const f32x4 s0 = p[0], s1 = p[1], s2 = p[2], s3 = p[3];
                const float s = ((s0[0] + s0[1]) + (s0[2] + s0[3])) + ((s1[0] + s1[1]) + (s1[2] + s1[3])) + ((s2[0] + s2[1]) + (s2[2] + s2[3])) + ((s3[0] + s3[1]) + (s3[2] + s3[3]));
                rs[m] = rsqrtf(s * (1.0f / DM) + EPS);
                asm volatile("" : "+v"(rs[m]));
                __builtin_amdgcn_sched_barrier(0);
            }
#pragma unroll
            for (int n = 0; n < 2; ++n) {
                const int col = colg + 4 * n;
                f32x4 w[2][3];
#pragma unroll
                for (int bj = 0; bj < 2; ++bj)
#pragma unroll
                    for (int k = 0; k < 3; ++k) w[bj][k] = *(const f32x4*)(cw + (size_t)k * NUP + bj * DFF + col);
#pragma unroll
                for (int m = 0; m < 4; ++m) {
                    const int g = g0 + m;
                    const bool vout = (4 * fr + m >= 2) && (g < MREAL);
                    const RowInfo ri = rowinfo(g < 0 ? 0 : g);
                    float y[2][4];
#pragma unroll
                    for (int bj = 0; bj < 2; ++bj) {
                        float cur[4], p1[4], p2[4];
#pragma unroll
                        for (int i = 0; i < 4; ++i) {
                            cur[i] = acc[ai][bj][m][n][i] * rs[m];
                            p1[i] = m >= 1 ? acc[ai][bj][m >= 1 ? m - 1 : 0][n][i] * rs[m >= 1 ? m - 1 : 0] : dpp_shr1(acc[ai][bj][3][n][i] * rs[3]);
                            p2[i] = m >= 2 ? acc[ai][bj][m >= 2 ? m - 2 : 0][n][i] * rs[m >= 2 ? m - 2 : 0] : dpp_shr1(acc[ai][bj][m == 0 ? 2 : 3][n][i] * rs[m == 0 ? 2 : 3]);
                        }
                        if (ri.t < 2) {
                            f32x4 S0 = {0.f, 0.f, 0.f, 0.f}, S1 = {0.f, 0.f, 0.f, 0.f};
                            if (ri.samp && ri.idx < NSB) { S0 = *(const f32x4*)(stf + (size_t)(ri.idx * 2 + 0) * NUP + bj * DFF + col); S1 = *(const f32x4*)(stf + (size_t)(ri.idx * 2 + 1) * NUP + bj * DFF + col); }
#pragma unroll
                            for (int i = 0; i < 4; ++i) { if (ri.t == 0) { p1[i] = S1[i]; p2[i] = S0[i]; } else { p2[i] = S1[i]; } }
                        }
                        if (vout && ri.t >= ri.len - 2) {
                            float* d = out + (ri.samp ? O_SCF : O_PCF) + (size_t)(ri.idx * 2 + (ri.t - (ri.len - 2))) * NUP + bj * DFF + col;
                            *(f32x4*)(d) = (f32x4){cur[0], cur[1], cur[2], cur[3]};
                        }
#pragma unroll
                        for (int i = 0; i < 4; ++i) y[bj][i] = w[bj][0][i] * p2[i] + w[bj][1][i] * p1[i] + w[bj][2][i] * cur[i];
                    }
                    if (vout) {
                        u32x2 pk; pk.x = cvt_pk_bf16(silu_f(y[0][0]) * y[1][0], silu_f(y[0][1]) * y[1][1]); pk.y = cvt_pk_bf16(silu_f(y[0][2]) * y[1][2], silu_f(y[0][3]) * y[1][3]);
                        *(u32x2*)(act + (size_t)g * DFF + col) = pk;
                    }
                    __builtin_amdgcn_sched_barrier(0);
                }
            }
        }
    }
};

#define XB_TMO      128
#define XB_XCNT(j)  (256  + 64 * (j))
#define XB_XSUB(j)  (1280 + 64 * (j))
#define XB_XGEN(j)  (2304 + 64 * (j))
#define XB_TOP      3328
#define XB_TOPGEN   3392
#define XCD_BAR_WORDS 3456
#define XB_SPIN_CAP (1u << 20)
__device__ __forceinline__ unsigned xb_ld(unsigned* p)              { return __hip_atomic_load(p, __ATOMIC_RELAXED, __HIP_MEMORY_SCOPE_AGENT); }
__device__ __forceinline__ unsigned xb_add(unsigned* p, unsigned v) { return __hip_atomic_fetch_add(p, v, __ATOMIC_RELAXED, __HIP_MEMORY_SCOPE_AGENT); }
__device__ __forceinline__ unsigned xb_xcc_id() { return (unsigned)__builtin_amdgcn_s_getreg((3 << 11) | 20) & 0xFu; }
#define XB_SPIN(cond, bar) do { unsigned _sp = 0; while (cond) { __builtin_amdgcn_s_sleep(1); \
    if ((++_sp & 255u) == 0u) { if (xb_ld(&(bar)[XB_TMO])) break; if (_sp > XB_SPIN_CAP) { atomicAdd(&(bar)[XB_TMO], 1u); break; } } } } while (0)
struct XcdBarrier { unsigned* bar; unsigned x; volatile LAS unsigned* st; };
__device__ __forceinline__ XcdBarrier xcd_barrier_post(unsigned* bar, volatile LAS unsigned* st) {
    XcdBarrier b; b.bar = bar; b.x = xb_xcc_id(); b.st = st;
    if (threadIdx.x == 0) (void)xb_add(&bar[XB_XCNT(b.x)], 1u);
    return b;
}
__device__ __forceinline__ void xcd_barrier_complete(unsigned* bar, unsigned x, unsigned& nloc, unsigned& nx) {
    const unsigned G = gridDim.x * gridDim.y * gridDim.z;
    unsigned sum, cnt, mine, sp = 0u;
    for (;;) {
        sum = 0u; cnt = 0u; mine = 0u;
#pragma unroll
        for (unsigned j = 0; j < 16; ++j) { const unsigned c = xb_ld(&bar[XB_XCNT(j)]); sum += c; cnt += (c > 0u) ? 1u : 0u; mine = (j == x) ? c : mine; }
        if (sum == G) break;
        __builtin_amdgcn_s_sleep(1);
        if ((++sp & 255u) == 0u) { if (xb_ld(&bar[XB_TMO])) break; if (sp > XB_SPIN_CAP) { atomicAdd(&bar[XB_TMO], 1u); break; } }
    }
    nloc = mine > 0u ? mine : 1u; nx = cnt > 0u ? cnt : 1u;
}
__device__ __forceinline__ void xcd_barrier(const XcdBarrier& b) {
    asm volatile("s_waitcnt vmcnt(0)" ::: "memory");
    __syncthreads();
    if (threadIdx.x == 0) {
        unsigned* bar = b.bar;
        __builtin_amdgcn_s_waitcnt(0);
        unsigned nloc = b.st[0], nx = b.st[1];
        if (nloc == 0u) { xcd_barrier_complete(bar, b.x, nloc, nx); b.st[0] = nloc; b.st[1] = nx; }
        const unsigned old = xb_add(&bar[XB_XSUB(b.x)], 1u);
        const unsigned gen = old / nloc;
        if (old + 1u == (gen + 1u) * nloc) {
            __builtin_amdgcn_fence(__ATOMIC_RELEASE, "agent");
            asm volatile("s_waitcnt vmcnt(0)" ::: "memory");
            const unsigned og = xb_add(&bar[XB_TOP], 1u);
            const unsigned tg = og / nx;
            if (og + 1u == (tg + 1u) * nx) xb_add(&bar[XB_TOPGEN], 1u);
            else XB_SPIN(xb_ld(&bar[XB_TOPGEN]) == tg, bar);
            __builtin_amdgcn_fence(__ATOMIC_ACQUIRE, "agent");
            xb_add(&bar[XB_XGEN(b.x)], 1u);
            asm volatile("s_waitcnt vmcnt(0)" ::: "memory");
        } else {
            XB_SPIN(xb_ld(&bar[XB_XGEN(b.x)]) == gen, bar);
            __builtin_amdgcn_fence(__ATOMIC_ACQUIRE, "agent");
            asm volatile("s_waitcnt vmcnt(0)" ::: "memory");
        }
    }
    __syncthreads();
}

struct Frame {
    LAS unsigned char* lds;
    int tid, lane, wave, G, blk;
    const float* in[20];
    float* out; unsigned char* ws;
};

__device__ __forceinline__ void p0_transpose_item(const float* W, int ldw, int K, bf16_t* WT, int n0, int srcn0, int k0, const float* kscale, LAS float* scr, int lane) {
#pragma unroll 8
    for (int i = 0; i < 32; ++i) { const int kk = 2 * i + (lane >> 5); float v = W[(size_t)(k0 + kk) * ldw + srcn0 + (lane & 31)]; if (kscale) v *= kscale[k0 + kk]; scr[kk * 33 + (lane & 31)] = v; }
    LDS_WAIT(); asm volatile("" ::: "memory");
    const int c = lane & 7;
#pragma unroll
    for (int j = 0; j < 4; ++j) { const int n = (lane >> 3) + 8 * j; const LAS float* s = scr + (8 * c) * 33 + n;
        u32x4 o; o.x = cvt_pk_bf16(s[0 * 33], s[1 * 33]); o.y = cvt_pk_bf16(s[2 * 33], s[3 * 33]); o.z = cvt_pk_bf16(s[4 * 33], s[5 * 33]); o.w = cvt_pk_bf16(s[6 * 33], s[7 * 33]);
        *(u32x4*)(WT + (size_t)(n0 + n) * K + k0 + 8 * c) = o; }
    LDS_WAIT(); asm volatile("" ::: "memory");
}
__device__ __forceinline__ int in_colmap(int n0) {
    const int pn = n0 >> 8;
    if (pn >= 4) return n0;
    const int c = n0 & 255, bj = c >> 7, cc = c & 127, hl = cc >> 6, j = cc & 63;
    return (pn >= 2 ? 512 : 0) + ((pn & 1) * 2 + hl) * 128 + bj * 64 + j;
}
__device__ __forceinline__ void p0_prologue(Frame& F) {
    const float* w_in = F.in[8]; const float* w_out = F.in[14]; const float* w_up = F.in[16]; const float* w_dn = F.in[18];
    bf16_t* WIN = (bf16_t*)(F.ws + WS_WIN); bf16_t* WOUT = (bf16_t*)(F.ws + WS_WOUT); bf16_t* WUP = (bf16_t*)(F.ws + WS_WUP); bf16_t* WDN = (bf16_t*)(F.ws + WS_WDN);
    LAS float* scr = (LAS float*)(F.lds + F.wave * 8448);
    LAS float* WX = (LAS float*)(F.lds + 69632);
    for (int i = F.tid; i < 1024 * 8; i += 512) WX[i] = w_in[(size_t)(i >> 3) * INW + NIN + (i & 7)];
    const int gw = F.blk * 8 + F.wave, NGW = F.G * 8;
    constexpr int I_IN = 16 * 128, I_OUT = 16 * 32, I_UP = 16 * 176, I_DN = 44 * 32, NIT = I_IN + I_OUT + I_UP + I_DN;
    for (int it = gw; it < NIT; it += NGW) {
        int r = it;
        if (r < I_IN) { const int kb = r / 128, nb = r % 128; p0_transpose_item(w_in, INW, 1024, WIN, nb * 32, in_colmap(nb * 32), kb * 64, nullptr, scr, F.lane); continue; } r -= I_IN;
        if (r < I_OUT) { const int kb = r / 32, nb = r % 32; p0_transpose_item(w_out, 1024, 1024, WOUT, nb * 32, nb * 32, kb * 64, nullptr, scr, F.lane); continue; } r -= I_OUT;
        if (r < I_UP) { const int kb = r / 176, nb = r % 176; const int n0 = nb * 32, pn = n0 >> 8, c = n0 & 255; p0_transpose_item(w_up, NUP, 1024, WUP, n0, (c >> 7) * DFF + pn * 128 + (c & 127), kb * 64, F.in[15], scr, F.lane); continue; } r -= I_UP;
        { const int kb = r / 32, nb = r % 32; p0_transpose_item(w_dn, 1024, DFF, WDN, nb * 32, nb * 32, kb * 64, nullptr, scr, F.lane); }
    }
    __syncthreads();
    bf16_t* H = (bf16_t*)(F.ws + WS_H); float* BG = (float*)(F.ws + WS_BG);
    const float* nm = F.in[7];
    for (int g = gw; g < MPAD; g += NGW) {
        unsigned long long* o8 = (unsigned long long*)(H + (size_t)g * DM) + F.lane;
        if (g >= MREAL) {
#pragma unroll
            for (int j = 0; j < 4; ++j) o8[64 * j] = 0ull;
            continue;
        }
        const f32x4* xr = (const f32x4*)x_src_row(F.in[0], F.in[1], F.in[6], g) + F.lane;
        const f32x4* nr = (const f32x4*)nm + F.lane;
        f32x4 v[4]; float ss = 0.f;
#pragma unroll
        for (int j = 0; j < 4; ++j) { v[j] = xr[64 * j]; ss += (v[j][0] * v[j][0] + v[j][1] * v[j][1]) + (v[j][2] * v[j][2] + v[j][3] * v[j][3]); }
        const float rstd = rsqrtf(wave_sum(ss) * (1.0f / DM) + EPS);
        float ex[8];
#pragma unroll
        for (int e = 0; e < 8; ++e) ex[e] = 0.f;
#pragma unroll
        for (int j = 0; j < 4; ++j) {
            const f32x4 n4 = nr[64 * j];
            v[j] = v[j] * rstd * n4;
            o8[64 * j] = (unsigned long long)cvt_pk_bf16(v[j][0], v[j][1]) | ((unsigned long long)cvt_pk_bf16(v[j][2], v[j][3]) << 32);
#pragma unroll
            for (int i = 0; i < 4; ++i) {
                const int k = 4 * (F.lane + 64 * j) + i;
                const f32x4 wa = *(const LAS f32x4*)(WX + k * 8), wb = *(const LAS f32x4*)(WX + k * 8 + 4);
                ex[0] += v[j][i] * wa[0]; ex[1] += v[j][i] * wa[1]; ex[2] += v[j][i] * wa[2]; ex[3] += v[j][i] * wa[3];
                ex[4] += v[j][i] * wb[0]; ex[5] += v[j][i] * wb[1]; ex[6] += v[j][i] * wb[2]; ex[7] += v[j][i] * wb[3];
            }
        }
#pragma unroll
        for (int e = 0; e < 8; ++e) ex[e] = wave_sum(ex[e]);
        if (F.lane < 4) {
            const int h = F.lane;
            const float gb = h == 0 ? ex[0] : h == 1 ? ex[1] : h == 2 ? ex[2] : ex[3];
            const float ga = h == 0 ? ex[4] : h == 1 ? ex[5] : h == 2 ? ex[6] : ex[7];
            const float beta = 1.0f / (1.0f + __expf(-gb));
            const float xx = ga + F.in[11][h];
            const float sp = xx > 20.f ? xx : log1pf(__expf(xx));
            BG[(size_t)g * 8 + h] = beta;
            BG[(size_t)g * 8 + 4 + h] = -__expf(F.in[10][h]) * sp;
        }
    }
    {
        bf16_t* PGX = (bf16_t*)(F.ws + WS_PGX); const float* stq = F.in[4];
        for (int e = F.blk * 512 + F.tid; e < 385 * GQKV; e += F.G * 512) PGX[e] = e < 384 * GQKV ? (bf16_t)(cvt_pk_bf16(stq[e], 0.f) & 0xffffu) : (bf16_t)0;
    }
    float* ROT = (float*)(F.ws + WS_ROT);
    for (int e = F.blk * 512 + F.tid; e < 2068 * 64; e += F.G * 512) {
        const int p = e >> 6, j = e & 63; const int pos = p < LP ? p : 16384 + (p - LP);
        double f = 1.0, b = 0.8659643233600653523531691834202299819398;
#pragma unroll
        for (int k = 0; k < 6; ++k) { if ((j >> k) & 1) f *= b; b *= b; }
        double rev = (double)pos * f * 0.15915494309189533576888376337251436203445964574046;
        rev -= floor(rev);
        const float rf = (float)rev;
        ROT[(size_t)e * 2] = __builtin_amdgcn_cosf(rf); ROT[(size_t)e * 2 + 1] = __builtin_amdgcn_sinf(rf);
    }
}

struct SeqD { int row0, len, samp, idx; };
__device__ __forceinline__ bf16x8 mk8(s16x4 lo, s16x4 hi) { return (bf16x8){lo[0], lo[1], lo[2], lo[3], hi[0], hi[1], hi[2], hi[3]}; }
__device__ __forceinline__ s16x4 ld_tr(LAS unsigned char* p) { return __builtin_bit_cast(s16x4, __builtin_amdgcn_ds_read_tr16_b64_v4i16((LAS s16x4*)p)); }
__device__ __forceinline__ s16x4 ld_b64(LAS unsigned char* p) { return *(LAS s16x4*)p; }
__device__ __forceinline__ s16x4 pk4(f32x4 v) { u32x2 w; w.x = cvt_pk_bf16(v[0], v[1]); w.y = cvt_pk_bf16(v[2], v[3]); return __builtin_bit_cast(s16x4, w); }

__device__ __forceinline__ void p2a_item(Frame& F, const SeqD sq, int h, int t0, int c, unsigned char* slot) {
    unsigned lbase = (unsigned)(uintptr_t)F.lds; int tid = F.tid;
    asm volatile("" : "+s"(lbase), "+v"(tid));
    LAS unsigned char* L = (LAS unsigned char*)(uintptr_t)lbase;
    LAS float* AM = (LAS float*)(L); LAS float* RHS = (LAS float*)(L + 53248);
    LAS float* GL = (LAS float*)(L + 16384); LAS float* CUM = GL + 64; LAS float* BETA = GL + 128;
    LAS unsigned char* QB = L + 20480; LAS unsigned char* KB = L + 36864;
    const float* BG = (const float*)(F.ws + WS_BG);
    const float* cgw = F.in[9];
    const int r = tid >> 3, cg = tid & 7, lane = tid & 63, w = __builtin_amdgcn_readfirstlane(tid >> 6), fr = lane & 15, fg = lane >> 4;
    const bool valid = r < c;
    const int grow = sq.row0 + t0 + r;
    float beta_r = 0.f, gdec = 0.f;
    if (valid) { beta_r = BG[(size_t)grow * 8 + h]; gdec = BG[(size_t)grow * 8 + 4 + h]; }
    if (cg == 0) GL[r] = gdec;
    LAS float* CW = (LAS float*)(L + 118784);
#pragma unroll
    for (int k = 0; k < 3; ++k) { const int e = tid + 512 * k, dt = e / 384, rem = e - dt * 384; CW[e] = cgw[(size_t)dt * GQKV + (rem >> 7) * 512 + h * 128 + (rem & 127)]; }
    __syncthreads();
    float cum = 0.f, cl = 0.f;
#pragma unroll 8
    for (int j = 0; j < 64; ++j) { const float gj = GL[j]; cl += gj; if (j <= r) cum += gj; }
    const float er = __expf(cum), frr = __expf(cl - cum);
    if (cg == 0) { CUM[r] = cum; BETA[r] = beta_r; }
    if (tid == 0) *(float*)(slot + 73728) = __expf(cl);
#pragma unroll 1
    for (int X = 0; X < 3; ++X) {
        const int colb = X * 512 + h * 128 + 16 * cg;
        float y[16];
#pragma unroll
        for (int i = 0; i < 16; ++i) y[i] = 0.f;
        u32x4 da[4], db[4];
#pragma unroll
        for (int dt = 0; dt < 4; ++dt) {
            const int tt = t0 + r - 3 + dt;
            const unsigned oz = (unsigned)(WS_PGX + ((size_t)384 * GQKV + colb) * 2);
            const unsigned opg = (unsigned)(WS_PG + ((size_t)(sq.row0 + (tt >= 0 ? tt : 0)) * 2048 + colb) * 2);
            const unsigned opx = (unsigned)(WS_PGX + ((size_t)(sq.idx * 3 + (tt < 0 ? 3 + tt : 0)) * GQKV + colb) * 2);
            const unsigned so = valid ? (tt >= 0 ? opg : (sq.samp ? opx : oz)) : oz;
            const u32x4* sp = (const u32x4*)(F.ws + so);
            da[dt] = sp[0]; db[dt] = sp[1];
        }
#pragma unroll
        for (int dt = 0; dt < 4; ++dt) {
            const u32x4 a = da[dt], b = db[dt];
            const float xv[16] = {bflo(a.x), bfhi(a.x), bflo(a.y), bfhi(a.y), bflo(a.z), bfhi(a.z), bflo(a.w), bfhi(a.w), bflo(b.x), bfhi(b.x), bflo(b.y), bfhi(b.y), bflo(b.z), bfhi(b.z), bflo(b.w), bfhi(b.w)};
            const LAS f32x4* wp = (const LAS f32x4*)(CW + dt * 384 + X * 128 + 16 * cg);
#pragma unroll
            for (int k = 0; k < 4; ++k) { const f32x4 wv = wp[k]; y[4 * k] += wv[0] * xv[4 * k]; y[4 * k + 1] += wv[1] * xv[4 * k + 1]; y[4 * k + 2] += wv[2] * xv[4 * k + 2]; y[4 * k + 3] += wv[3] * xv[4 * k + 3]; }
        }
        float ss = 0.f;
#pragma unroll
        for (int i = 0; i < 16; ++i) { y[i] = valid ? silu_f(y[i]) : 0.f; ss += y[i] * y[i]; }
        ss += __shfl_xor(ss, 1); ss += __shfl_xor(ss, 2); ss += __shfl_xor(ss, 4);
        const float nrm = X == 0 ? rsqrtf(ss + EPS) * 0.08838834764831845f : (X == 1 ? rsqrtf(ss + EPS) : 1.0f);
        u32x4 p0, p1;
        p0.x = cvt_pk_bf16(y[0] * nrm, y[1] * nrm); p0.y = cvt_pk_bf16(y[2] * nrm, y[3] * nrm); p0.z = cvt_pk_bf16(y[4] * nrm, y[5] * nrm); p0.w = cvt_pk_bf16(y[6] * nrm, y[7] * nrm);
        p1.x = cvt_pk_bf16(y[8] * nrm, y[9] * nrm); p1.y = cvt_pk_bf16(y[10] * nrm, y[11] * nrm); p1.z = cvt_pk_bf16(y[12] * nrm, y[13] * nrm); p1.w = cvt_pk_bf16(y[14] * nrm, y[15] * nrm);
        const float z[16] = {bflo(p0.x), bfhi(p0.x), bflo(p0.y), bfhi(p0.y), bflo(p0.z), bfhi(p0.z), bflo(p0.w), bfhi(p0.w), bflo(p1.x), bfhi(p1.x), bflo(p1.y), bfhi(p1.y), bflo(p1.z), bfhi(p1.z), bflo(p1.w), bfhi(p1.w)};
        if (X < 2) {
            LAS unsigned char* dstl = (X == 0 ? QB : KB) + r * 256;
            *(LAS u32x4*)(dstl + (((2 * cg) ^ (r & 15)) * 16)) = p0; *(LAS u32x4*)(dstl + (((2 * cg + 1) ^ (r & 15)) * 16)) = p1;
            const float sc = X == 0 ? er : frr;
            u32x4 d0, d1;
            d0.x = cvt_pk_bf16(z[0] * sc, z[1] * sc); d0.y = cvt_pk_bf16(z[2] * sc, z[3] * sc); d0.z = cvt_pk_bf16(z[4] * sc, z[5] * sc); d0.w = cvt_pk_bf16(z[6] * sc, z[7] * sc);
            d1.x = cvt_pk_bf16(z[8] * sc, z[9] * sc); d1.y = cvt_pk_bf16(z[10] * sc, z[11] * sc); d1.z = cvt_pk_bf16(z[12] * sc, z[13] * sc); d1.w = cvt_pk_bf16(z[14] * sc, z[15] * sc);
            u32x4* gd = (u32x4*)(slot + (X == 0 ? 16384 : 32768) + r * 256 + cg * 32); gd[0] = d0; gd[1] = d1;
        }
        if (X >= 1) {
            const float sc = X == 1 ? beta_r * er : beta_r;
            LAS float* rd = RHS + r * 256 + (X == 1 ? 128 : 0) + 16 * cg;
#pragma unroll
            for (int k = 0; k < 4; ++k) *(LAS f32x4*)(rd + 4 * k) = (f32x4){z[4 * k] * sc, z[4 * k + 1] * sc, z[4 * k + 2] * sc, z[4 * k + 3] * sc};
        }
    }
    __syncthreads();
    {
        bf16_t* QK = (bf16_t*)(slot + 49152);
#pragma unroll
        for (int rep = 0; rep < 2; ++rep) {
            const int idx = w + 8 * rep, it = idx >> 2, jt = idx & 3;
            const int jcol = 16 * jt + fr;
            if (it >= jt) {
                f32x4 akk = {0.f, 0.f, 0.f, 0.f}, aqk = {0.f, 0.f, 0.f, 0.f};
#pragma unroll
                for (int s = 0; s < 4; ++s) {
                    const int ri = 16 * it + fr, rj = 16 * jt + fr;
                    const bf16x8 bk = *(LAS bf16x8*)(KB + rj * 256 + (((4 * s + fg) ^ (rj & 15)) * 16));
                    const bf16x8 ak = *(LAS bf16x8*)(KB + ri * 256 + (((4 * s + fg) ^ (ri & 15)) * 16));
                    const bf16x8 aq = *(LAS bf16x8*)(QB + ri * 256 + (((4 * s + fg) ^ (ri & 15)) * 16));
                    akk = __builtin_amdgcn_mfma_f32_16x16x32_bf16(ak, bk, akk, 0, 0, 0);
                    aqk = __builtin_amdgcn_mfma_f32_16x16x32_bf16(aq, bk, aqk, 0, 0, 0);
                }
                const float cj = CUM[jcol];
#pragma unroll
                for (int rr = 0; rr < 4; ++rr) {
                    const int i_ = 16 * it + 4 * fg + rr;
                    const float dec = i_ >= jcol ? __expf(CUM[i_] - cj) : 0.f;
                    AM[i_ * 64 + jcol] = i_ > jcol ? BETA[i_] * akk[rr] * dec : 0.f;
                    QK[i_ * 64 + jcol] = (bf16_t)(cvt_pk_bf16(aqk[rr] * dec, 0.f) & 0xffffu);
                }
            } else {
#pragma unroll
                for (int rr = 0; rr < 4; ++rr) QK[(16 * it + 4 * fg + rr) * 64 + jcol] = 0;
            }
        }
    }
    __syncthreads();
    {
        const int col = tid >> 1, hh = tid & 1;
        unsigned amo = (unsigned)(uintptr_t)AM + hh * 16u, r0 = (unsigned)(uintptr_t)RHS + col * 4u + hh * 4096u, r1 = (unsigned)(uintptr_t)RHS + col * 4u - hh * 4096u;
        asm volatile("" : "+v"(amo), "+v"(r0), "+v"(r1));
        LAS unsigned char* amb = (LAS unsigned char*)(uintptr_t)amo; LAS unsigned char* rb0 = (LAS unsigned char*)(uintptr_t)r0; LAS unsigned char* rb1 = (LAS unsigned char*)(uintptr_t)r1;
        float xs[64];
#pragma unroll
        for (int k = 0; k < 64; ++k) xs[k] = (k & 4) ? *(LAS float*)(rb1 + k * 1024) : *(LAS float*)(rb0 + k * 1024);
#pragma unroll
        for (int i = 1; i < 64; ++i) {
            float a0 = 0.f, a1 = 0.f;
#pragma unroll
            for (int q = 0; q < 8; ++q) {
                if (8 * q < i) { const f32x4 cq = *(LAS f32x4*)(amb + i * 256 + q * 32); a0 += cq[0] * xs[8 * q]; a1 += cq[1] * xs[8 * q + 1]; a0 += cq[2] * xs[8 * q + 2]; a1 += cq[3] * xs[8 * q + 3]; }
            }
            float a = a0 + a1;
            a += __int_as_float(__builtin_amdgcn_update_dpp(0, __float_as_int(a), 0xB1, 0xf, 0xf, true));
            const float v = (hh ? xs[i ^ 4] : xs[i]) - a;
            xs[i] = hh ? xs[i] : v; xs[i ^ 4] = hh ? v : xs[i ^ 4];
            asm volatile("" ::: "memory");
        }
        u32x4* dst = (u32x4*)((col < 128 ? slot + 57344 + col * 128 : slot + (col - 128) * 128) + hh * 64);
#pragma unroll
        for (int k = 0; k < 4; ++k) {
            const int e = 8 * k;
            u32x4 o;
            o.x = cvt_pk_bf16(hh ? xs[(32 + e) ^ 4] : xs[e], hh ? xs[(33 + e) ^ 4] : xs[e + 1]); o.y = cvt_pk_bf16(hh ? xs[(34 + e) ^ 4] : xs[e + 2], hh ? xs[(35 + e) ^ 4] : xs[e + 3]);
            o.z = cvt_pk_bf16(hh ? xs[(36 + e) ^ 4] : xs[e + 4], hh ? xs[(37 + e) ^ 4] : xs[e + 5]); o.w = cvt_pk_bf16(hh ? xs[(38 + e) ^ 4] : xs[e + 6], hh ? xs[(39 + e) ^ 4] : xs[e + 7]);
            dst[k] = o;
        }
    }
    __syncthreads();
}

constexpr int OS_OFF = 57344, OS_PITCH = 132;
template <int MODE  >
__device__ __forceinline__ void scan_epilogue(Frame& F, const f32x4 (&o)[4], int h, int grow0, int c, const float* nw, const bf16_t* gbuf, bf16_t* mix) {
    LAS float* OS = (LAS float*)(F.lds + OS_OFF);
    const int lane = F.lane, w = F.wave, fr = lane & 15, fg = lane >> 4;
#pragma unroll
    for (int mt = 0; mt < 4; ++mt)
#pragma unroll
        for (int rr = 0; rr < 4; ++rr) OS[(16 * mt + 4 * fg + rr) * OS_PITCH + 16 * w + fr] = o[mt][rr];
    __syncthreads();
    const int r = F.tid >> 3, cg = F.tid & 7;
    f32x4 v[4];
#pragma unroll
    for (int k = 0; k < 4; ++k) v[k] = *(LAS f32x4*)(OS + r * OS_PITCH + 16 * cg + 4 * k);
    float rstd;
    if (MODE == 0) {
        float s = 0.f;
#pragma unroll
        for (int k = 0; k < 4; ++k) s += (v[k][0] + v[k][1]) + (v[k][2] + v[k][3]);
        s += __shfl_xor(s, 1); s += __shfl_xor(s, 2); s += __shfl_xor(s, 4);
        const float mu = s * (1.0f / 128.0f);
        float q = 0.f;
#pragma unroll
        for (int k = 0; k < 4; ++k) { v[k] = v[k] - mu; q += (v[k][0] * v[k][0] + v[k][1] * v[k][1]) + (v[k][2] * v[k][2] + v[k][3] * v[k][3]); }
        q += __shfl_xor(q, 1); q += __shfl_xor(q, 2); q += __shfl_xor(q, 4);
        rstd = rsqrtf(q * (1.0f / 128.0f) + EPS);
    } else {
        float q = 0.f;
#pragma unroll
        for (int k = 0; k < 4; ++k) q += (v[k][0] * v[k][0] + v[k][1] * v[k][1]) + (v[k][2] * v[k][2] + v[k][3] * v[k][3]);
        q += __shfl_xor(q, 1); q += __shfl_xor(q, 2); q += __shfl_xor(q, 4);
        rstd = rsqrtf(q * (1.0f / 128.0f) + EPS);
    }
    if (r < c) {
        const int grow = grow0 + r;
        const u32x4* gp = (const u32x4*)(gbuf + (size_t)grow * 2048 + 1536 + h * 128 + 16 * cg);
        const u32x4 ga = gp[0], gb = gp[1];
        const float gt[16] = {bflo(ga.x), bfhi(ga.x), bflo(ga.y), bfhi(ga.y), bflo(ga.z), bfhi(ga.z), bflo(ga.w), bfhi(ga.w), bflo(gb.x), bfhi(gb.x), bflo(gb.y), bfhi(gb.y), bflo(gb.z), bfhi(gb.z), bflo(gb.w), bfhi(gb.w)};
        const f32x4* np = (const f32x4*)(nw + (MODE == 0 ? h * 128 : 0) + 16 * cg);
        float y[16];
#pragma unroll
        for (int k = 0; k < 4; ++k) { const f32x4 n4 = np[k];
#pragma unroll
            for (int i = 0; i < 4; ++i) y[4 * k + i] = v[k][i] * rstd * n4[i] * gt[4 * k + i]; }
        u32x4 o0, o1;
        o0.x = cvt_pk_bf16(y[0], y[1]); o0.y = cvt_pk_bf16(y[2], y[3]); o0.z = cvt_pk_bf16(y[4], y[5]); o0.w = cvt_pk_bf16(y[6], y[7]);
        o1.x = cvt_pk_bf16(y[8], y[9]); o1.y = cvt_pk_bf16(y[10], y[11]); o1.z = cvt_pk_bf16(y[12], y[13]); o1.w = cvt_pk_bf16(y[14], y[15]);
        u32x4* mp = (u32x4*)(mix + (size_t)grow * DM + (MODE == 0 ? 0 : 512) + h * 128 + 16 * cg);
        mp[0] = o0; mp[1] = o1;
    }
}

__device__ __forceinline__ void make_sb(const f32x4 (&S)[8], bf16x8 (&Sb)[4]) {
#pragma unroll
    for (int s = 0; s < 4; ++s) Sb[s] = mk8(pk4(S[2 * s]), pk4(S[2 * s + 1]));
}

__device__ __forceinline__ void scan_gdn(Frame& F, const SeqD sq, int h, int nchunks, const unsigned char* slot0, const float* sinit, float* sfinal) {
    unsigned lbase = (unsigned)(uintptr_t)F.lds; int tid = F.tid;
    asm volatile("" : "+s"(lbase), "+v"(tid));
    LAS unsigned char* L = (LAS unsigned char*)(uintptr_t)lbase;
    const int lane = tid & 63, w = __builtin_amdgcn_readfirstlane(tid >> 6), fr = lane & 15, fg = lane >> 4;
    const bf16_t* PG = (const bf16_t*)(F.ws + WS_PG);
    bf16_t* mix = (bf16_t*)((unsigned char*)F.out + OS_MIX);
    f32x4 S[8]; bf16x8 Sb[4];
#pragma unroll
    for (int t = 0; t < 8; ++t) {
        if (sinit) { S[t] = (f32x4){sinit[(16 * t + 4 * fg + 0) * 128 + 16 * w + fr], sinit[(16 * t + 4 * fg + 1) * 128 + 16 * w + fr], sinit[(16 * t + 4 * fg + 2) * 128 + 16 * w + fr], sinit[(16 * t + 4 * fg + 3) * 128 + 16 * w + fr]}; }
        else S[t] = (f32x4){0.f, 0.f, 0.f, 0.f};
    }
    make_sb(S, Sb);
    for (int n = 0; n < nchunks; ++n) {
        const unsigned char* img = slot0 + (size_t)n * SLOT;
        int t0, c; if (sq.samp) { t0 = 0; c = 4; } else if (n == 0) { t0 = 0; c = 16; } else { t0 = 16 + 64 * (n - 1); c = 64; }
#pragma unroll
        for (int p = 0; p < 7; ++p) ((LAS u32x4*)L)[p * 512 + tid] = ((const u32x4*)img)[p * 512 + tid];
        const float cd = *(const float*)(img + 73728);
        f32x4 u[4];
#pragma unroll
        for (int mt = 0; mt < 4; ++mt) { const u32x2 uu = *(const u32x2*)(img + 57344 + ((16 * w + fr) * 64 + 16 * mt + 4 * fg) * 2); u[mt] = (f32x4){bflo(uu.x), bfhi(uu.x), bflo(uu.y), bfhi(uu.y)}; }
        __syncthreads();
        f32x4 wv[4];
#pragma unroll
        for (int mt = 0; mt < 4; ++mt) {
            f32x4 a = {0.f, 0.f, 0.f, 0.f};
#pragma unroll
            for (int s = 0; s < 4; ++s) {
                const s16x4 lo = ld_tr(L + (32 * s + 4 * fg + (fr >> 2)) * 128 + (16 * mt + 4 * (fr & 3)) * 2);
                const s16x4 hi = ld_tr(L + (32 * s + 16 + 4 * fg + (fr >> 2)) * 128 + (16 * mt + 4 * (fr & 3)) * 2);
                a = __builtin_amdgcn_mfma_f32_16x16x32_bf16(mk8(lo, hi), Sb[s], a, 0, 0, 0);
            }
            wv[mt] = u[mt] - a;
        }
        bf16x8 wb[2];
        wb[0] = mk8(pk4(wv[0]), pk4(wv[1])); wb[1] = mk8(pk4(wv[2]), pk4(wv[3]));
        f32x4 o[4];
#pragma unroll
        for (int mt = 0; mt < 4; ++mt) {
            f32x4 a = {0.f, 0.f, 0.f, 0.f};
#pragma unroll
            for (int s = 0; s < 4; ++s) {
                const s16x4 lo = ld_b64(L + 16384 + (16 * mt + fr) * 256 + (32 * s + 4 * fg) * 2);
                const s16x4 hi = ld_b64(L + 16384 + (16 * mt + fr) * 256 + (32 * s + 16 + 4 * fg) * 2);
                a = __builtin_amdgcn_mfma_f32_16x16x32_bf16(mk8(lo, hi), Sb[s], a, 0, 0, 0);
            }
#pragma unroll
            for (int s = 0; s < 2; ++s) {
                const s16x4 lo = ld_b64(L + 49152 + (16 * mt + fr) * 128 + (32 * s + 4 * fg) * 2);
                const s16x4 hi = ld_b64(L + 49152 + (16 * mt + fr) * 128 + (32 * s + 16 + 4 * fg) * 2);
                a = __builtin_amdgcn_mfma_f32_16x16x32_bf16(mk8(lo, hi), wb[s], a, 0, 0, 0);
            }
            o[mt] = a;
        }
#pragma unroll
        for (int t = 0; t < 8; ++t) {
            f32x4 a = S[t] * cd;
#pragma unroll
            for (int s = 0; s < 2; ++s) {
                const s16x4 lo = ld_tr(L + 32768 + (32 * s + 4 * fg + (fr >> 2)) * 256 + (16 * t + 4 * (fr & 3)) * 2);
                const s16x4 hi = ld_tr(L + 32768 + (32 * s + 16 + 4 * fg + (fr >> 2)) * 256 + (16 * t + 4 * (fr & 3)) * 2);
                a = __builtin_amdgcn_mfma_f32_16x16x32_bf16(mk8(lo, hi), wb[s], a, 0, 0, 0);
            }
            S[t] = a;
        }
        make_sb(S, Sb);
        scan_epilogue<1>(F, o, h, sq.row0 + t0, c, F.in[13], PG, mix);
    }
#pragma unroll
    for (int t = 0; t < 8; ++t)
#pragma unroll
        for (int rr = 0; rr < 4; ++rr) sfinal[(16 * t + 4 * fg + rr) * 128 + 16 * w + fr] = S[t][rr];
    __syncthreads();
}

__device__ __forceinline__ void scan_ret(Frame& F, const SeqD sq, int h, int nchunks, const float* sinit, float* sfinal) {
    unsigned lbase = (unsigned)(uintptr_t)F.lds; int tid = F.tid;
    asm volatile("" : "+s"(lbase), "+v"(tid));
    LAS unsigned char* L = (LAS unsigned char*)(uintptr_t)lbase;
    const int lane = tid & 63, w = __builtin_amdgcn_readfirstlane(tid >> 6), fr = lane & 15, fg = lane >> 4;
    const bf16_t* PR = (const bf16_t*)(F.ws + WS_PR);
    bf16_t* mix = (bf16_t*)((unsigned char*)F.out + OS_MIX);
    const float lg = h == 0 ? -0.04580368961312479f : h == 1 ? -0.02272007650008353f : h == 2 ? -0.011315313227834146f : -0.005646563141142063f;
    f32x4 S[8]; bf16x8 Sb[4];
#pragma unroll
    for (int t = 0; t < 8; ++t) {
        if (sinit) { S[t] = (f32x4){sinit[(16 * t + 4 * fg + 0) * 128 + 16 * w + fr], sinit[(16 * t + 4 * fg + 1) * 128 + 16 * w + fr], sinit[(16 * t + 4 * fg + 2) * 128 + 16 * w + fr], sinit[(16 * t + 4 * fg + 3) * 128 + 16 * w + fr]}; }
        else S[t] = (f32x4){0.f, 0.f, 0.f, 0.f};
    }
    make_sb(S, Sb);
    for (int n = 0; n < nchunks; ++n) {
        int t0, c; if (sq.samp) { t0 = 0; c = 4; } else if (n == 0) { t0 = 0; c = 16; } else { t0 = 16 + 64 * (n - 1); c = 64; }
        {
            const int r = tid >> 3, part = tid & 7;
            const u32x4 z = {0u, 0u, 0u, 0u};
#pragma unroll
            for (int X = 0; X < 3; ++X) {
                u32x4 a = z, b = z;
                if (r < c) { const u32x4* p = (const u32x4*)(PR + (size_t)(sq.row0 + t0 + r) * 2048 + X * 512 + h * 128 + 16 * part); a = p[0]; b = p[1]; }
                LAS u32x4* d = (LAS u32x4*)(L + X * 16384 + r * 256 + part * 32); d[0] = a; d[1] = b;
            }
        }
        __syncthreads();
#pragma unroll
        for (int rep = 0; rep < 2; ++rep) {
            const int idx = w + 8 * rep, it = idx >> 2, jt = idx & 3, jcol = 16 * jt + fr;
            LAS bf16_t* Pb = (LAS bf16_t*)(L + 49152);
            if (it >= jt) {
                f32x4 a = {0.f, 0.f, 0.f, 0.f};
#pragma unroll
                for (int s = 0; s < 4; ++s) {
                    const bf16x8 aq = *(LAS bf16x8*)(L + (16 * it + fr) * 256 + (32 * s + 8 * fg) * 2);
                    const bf16x8 bk = *(LAS bf16x8*)(L + 16384 + (16 * jt + fr) * 256 + (32 * s + 8 * fg) * 2);
                    a = __builtin_amdgcn_mfma_f32_16x16x32_bf16(aq, bk, a, 0, 0, 0);
                }
#pragma unroll
                for (int rr = 0; rr < 4; ++rr) {
                    const int i_ = 16 * it + 4 * fg + rr;
                    const float p = i_ >= jcol ? a[rr] * exp2f(lg * (float)(i_ - jcol)) : 0.f;
                    Pb[i_ * 64 + jcol] = (bf16_t)(cvt_pk_bf16(p, 0.f) & 0xffffu);
                }
            } else {
#pragma unroll
                for (int rr = 0; rr < 4; ++rr) Pb[(16 * it + 4 * fg + rr) * 64 + jcol] = 0;
            }
        }
        __syncthreads();
        s16x4 vlo[2], vhi[2];
#pragma unroll
        for (int s = 0; s < 2; ++s) {
            vlo[s] = ld_tr(L + 32768 + (32 * s + 8 * fg + (fr >> 2)) * 256 + (16 * w + 4 * (fr & 3)) * 2);
            vhi[s] = ld_tr(L + 32768 + (32 * s + 8 * fg + 4 + (fr >> 2)) * 256 + (16 * w + 4 * (fr & 3)) * 2);
        }
        f32x4 o[4];
#pragma unroll
        for (int mt = 0; mt < 4; ++mt) {
            f32x4 a1 = {0.f, 0.f, 0.f, 0.f}, a2 = {0.f, 0.f, 0.f, 0.f};
#pragma unroll
            for (int s = 0; s < 2; ++s) {
                const bf16x8 ap = *(LAS bf16x8*)(L + 49152 + (16 * mt + fr) * 128 + (32 * s + 8 * fg) * 2);
                a1 = __builtin_amdgcn_mfma_f32_16x16x32_bf16(ap, mk8(vlo[s], vhi[s]), a1, 0, 0, 0);
            }
#pragma unroll
            for (int s = 0; s < 4; ++s) {
                const s16x4 lo = ld_b64(L + (16 * mt + fr) * 256 + (32 * s + 4 * fg) * 2);
                const s16x4 hi = ld_b64(L + (16 * mt + fr) * 256 + (32 * s + 16 + 4 * fg) * 2);
                a2 = __builtin_amdgcn_mfma_f32_16x16x32_bf16(mk8(lo, hi), Sb[s], a2, 0, 0, 0);
            }
#pragma unroll
            for (int rr = 0; rr < 4; ++rr) o[mt][rr] = a1[rr] + exp2f(lg * (float)(16 * mt + 4 * fg + rr + 1)) * a2[rr];
        }
        bf16x8 vd[2];
#pragma unroll
        for (int s = 0; s < 2; ++s) {
            float f[8];
#pragma unroll
            for (int jj = 0; jj < 8; ++jj) { const int j = 32 * s + 8 * fg + jj; const int e = c - 1 - j; f[jj] = e >= 0 ? exp2f(lg * (float)e) : 0.f; }
            const u32x2 l2 = __builtin_bit_cast(u32x2, vlo[s]), h2 = __builtin_bit_cast(u32x2, vhi[s]);
            u32x2 lo, hi;
            lo.x = cvt_pk_bf16(bflo(l2.x) * f[0], bfhi(l2.x) * f[1]); lo.y = cvt_pk_bf16(bflo(l2.y) * f[2], bfhi(l2.y) * f[3]);
            hi.x = cvt_pk_bf16(bflo(h2.x) * f[4], bfhi(h2.x) * f[5]); hi.y = cvt_pk_bf16(bflo(h2.y) * f[6], bfhi(h2.y) * f[7]);
            vd[s] = mk8(__builtin_bit_cast(s16x4, lo), __builtin_bit_cast(s16x4, hi));
        }
        const float gc = exp2f(lg * (float)c);
#pragma unroll
        for (int t = 0; t < 8; ++t) {
            f32x4 a = S[t] * gc;
#pragma unroll
            for (int s = 0; s < 2; ++s) {
                const s16x4 lo = ld_tr(L + 16384 + (32 * s + 8 * fg + (fr >> 2)) * 256 + (16 * t + 4 * (fr & 3)) * 2);
                const s16x4 hi = ld_tr(L + 16384 + (32 * s + 8 * fg + 4 + (fr >> 2)) * 256 + (16 * t + 4 * (fr & 3)) * 2);
                a = __builtin_amdgcn_mfma_f32_16x16x32_bf16(mk8(lo, hi), vd[s], a, 0, 0, 0);
            }
            S[t] = a;
        }
        make_sb(S, Sb);
        scan_epilogue<0>(F, o, h, sq.row0 + t0, c, F.in[12], PR, mix);
    }
#pragma unroll
    for (int t = 0; t < 8; ++t)
#pragma unroll
        for (int rr = 0; rr < 4; ++rr) sfinal[(16 * t + 4 * fg + rr) * 128 + 16 * w + fr] = S[t][rr];
    __syncthreads();
}

struct Args { const float* in[20]; float* out; unsigned char* ws; int ph_lo, ph_hi, li, pad; };
constexpr int NPHASE = 8;

__global__ void __launch_bounds__(512, 2) mega_fwd(Args args) {
    extern __shared__ __attribute__((aligned(16))) unsigned char lds[];
    Frame F;
    F.lds = (LAS unsigned char*)lds;
    F.tid = threadIdx.x; F.lane = F.tid & 63; F.wave = __builtin_amdgcn_readfirstlane(F.tid >> 6);
    F.G = gridDim.x; F.blk = blockIdx.x;
#pragma unroll
    for (int i = 0; i < 20; ++i) F.in[i] = args.in[i];
    F.out = args.out; F.ws = args.ws;
    volatile LAS unsigned* MISC = (volatile LAS unsigned*)(F.lds + MISC_OFF);
    for (int u = F.tid; u < (LDS_BYTES - LDSCTL_OFF) / 4; u += 512) ((LAS unsigned*)(F.lds + LDSCTL_OFF))[u] = 0u;
    __syncthreads();
    unsigned* barw = (unsigned*)(F.ws + WS_CTL) + CW_BAR + args.li * XCD_BAR_WORDS;
    XcdBarrier bar; bar.bar = barw; bar.x = 0; bar.st = nullptr;
    if (MK_N_LAUNCHES == 1) bar = xcd_barrier_post(barw, MISC + 8);
    const int lo = args.ph_lo, hi = args.ph_hi;
#define IN(k) (lo <= (k) && (k) < hi)
#define SEAM(k) do { if (IN(k) && IN((k) + 1)) xcd_barrier(bar); } while (0)

    if (IN(0)) { p0_prologue(F); }
    SEAM(0);
    if (IN(1)) {
        pg8::Gemm g{(const bf16_t*)(F.ws + WS_H), (const bf16_t*)(F.ws + WS_WIN), 1024};
        pg8::StaticOrder S; S.init(MPAD / 256, NIN / 256, F.G, F.blk);
        EpiIn E{(bf16_t*)(F.ws + WS_PR), (bf16_t*)(F.ws + WS_PG), (const float*)(F.ws + WS_ROT), F.out};
        pg8::gemm_phase<EpiIn, pg8::StaticOrder, pg8::MapPlain>(F.lds, g, S, E);
    }
    SEAM(1);
#pragma unroll 1
    for (int ph = 2; ph <= 3; ++ph) {
        if (IN(ph)) {
            int it, iend, istep;
            if (ph == 2) { it = F.blk; iend = 1056; istep = F.G; }
            else if (F.blk < 64) { it = F.blk; iend = F.blk + 1; istep = 1; }
            else { it = F.blk; iend = 64 + 1024; istep = F.G - 64; }
#pragma unroll 1
            for (; it < iend; it += istep) {
                int kind, h, nch, t0 = 0, c = 4; SeqD sq; unsigned char* slot; const float* sinit = nullptr; float* sfinal = nullptr;
                if (ph == 2) {
                    const int bh = it / 33, n = it - bh * 33, b = bh >> 2; h = bh & 3; kind = 0; nch = 0;
                    sq = SeqD{b * LP, LP, 0, b}; t0 = n == 0 ? 0 : 16 + 64 * (n - 1); c = n == 0 ? 16 : 64;
                    slot = F.ws + WS_G2A + (size_t)it * SLOT;
                } else if (it < 64) {
                    const int bb = it & 31, b = bb >> 2; h = bb & 3; kind = it < 32 ? 1 : 2; nch = 33;
                    sq = SeqD{b * LP, LP, 0, b};
                    slot = F.ws + WS_G2A + (size_t)(bb * 33) * SLOT;
                    sfinal = F.out + (it < 32 ? O_PSG : O_PSR) + (size_t)bb * 16384;
                } else {
                    const int j = it - 64, rem = j & 511, sb = rem >> 2; h = rem & 3; kind = j < 512 ? 3 : 2; nch = 1;
                    sq = SeqD{MPROMPT + sb * 4, 4, 1, sb};
                    slot = (unsigned char*)F.out + OS_SCR + (size_t)F.blk * SLOT;
                    sinit = (j < 512 ? F.in[3] : F.in[2]) + (size_t)rem * 16384;
                    sfinal = F.out + (j < 512 ? O_SSG : O_SSR) + (size_t)rem * 16384;
                }
                if (kind == 0 || kind == 3) p2a_item(F, sq, h, t0, c, slot);
                if (kind == 3) {
                    __builtin_amdgcn_fence(__ATOMIC_RELEASE, "agent"); VM_WAIT(); __syncthreads();
                    __builtin_amdgcn_fence(__ATOMIC_ACQUIRE, "agent"); VM_WAIT(); __syncthreads();
                }
                if (kind == 1 || kind == 3) scan_gdn(F, sq, h, nch, slot, sinit, sfinal);
                if (kind == 2) scan_ret(F, sq, h, nch, sinit, sfinal);
            }
        }
        if (ph == 2) SEAM(2);
    }
    SEAM(3);
    if (IN(4)) {
        pg8::Gemm g{(const bf16_t*)((unsigned char*)F.out + OS_MIX), (const bf16_t*)(F.ws + WS_WOUT), 1024};
        pg8::StaticOrder S; S.init(MPAD / 256, 4, F.G, F.blk);
        EpiOut E{F.in[0], F.in[1], F.in[6], (float*)(F.ws + WS_X2F), (bf16_t*)(F.ws + WS_X2B), (float*)(F.ws + WS_RSQ2)};
        pg8::gemm_phase<EpiOut, pg8::StaticOrder, pg8::MapPlain>(F.lds, g, S, E);
    }
    SEAM(4);
    if (IN(5)) {
        pg8::Gemm g{(const bf16_t*)(F.ws + WS_X2B), (const bf16_t*)(F.ws + WS_WUP), 1024};
        pg8::StaticOrder S; S.init(UP_NM, NUP / 256, F.G, F.blk);
        EpiUp E{(const float*)(F.ws + WS_RSQ2), F.in[17], F.in[5], (bf16_t*)(F.ws + WS_ACT), F.out};
        pg8::gemm_phase<EpiUp, pg8::StaticOrder, pg8::MapUp>(F.lds, g, S, E);
    }
    SEAM(5);
    if (IN(6)) {
        pg8::Gemm g{(const bf16_t*)(F.ws + WS_ACT), (const bf16_t*)(F.ws + WS_WDN), DFF};
        pg8::StaticOrder S; S.init(MPAD / 256, 4, F.G, F.blk);
        EpiDown E{(const float*)(F.ws + WS_X2F), F.out, (float*)(F.ws + WS_RSQ3)};
        pg8::gemm_phase<EpiDown, pg8::StaticOrder, pg8::MapPlain>(F.lds, g, S, E);
    }
    SEAM(6);
    if (IN(7)) {
        const float* rsq = (const float*)(F.ws + WS_RSQ3); const float* nf = F.in[19];
        const int gw = F.blk * 8 + F.wave, NGW = F.G * 8;
        for (int q = gw; q < 16384 + 512; q += NGW) {
            int g; float* dst;
            if (q < 16384) { g = (q >> 11) * LP + 16 + (q & 2047); dst = F.out + O_YP + (size_t)q * DM; } else { g = MPROMPT + (q - 16384); dst = F.out + O_YS + (size_t)(q - 16384) * DM; }
            float s = F.lane < 16 ? rsq[(size_t)g * 16 + F.lane] : 0.f;
            s = wave_sum(s);
            const float rstd = rsqrtf(s * (1.0f / DM) + EPS);
            f32x4* p = (f32x4*)dst + F.lane; const f32x4* np = (const f32x4*)nf + F.lane;
#pragma unroll
            for (int j = 0; j < 4; ++j) { f32x4 v = p[64 * j]; v = v * rstd * np[64 * j]; p[64 * j] = v; }
        }
    }
#undef IN
#undef SEAM
}

extern "C" void kernel_launch(void* const* d_in, const int* in_sizes, int n_in, void* d_out, int out_size, void* d_ws, size_t ws_size, hipStream_t stream) {
    static int grid = 0;
    if (grid == 0) {
        if (n_in != 20 || (size_t)out_size != O_TOTAL || ws_size < WS_END) { fprintf(stderr, "kernel_launch: unexpected shapes (n_in %d, out %d, ws %zu); nothing launched\n", n_in, out_size, ws_size); grid = -1; return; }
        int dev = 0, cus = 0;
        if (hipGetDevice(&dev) != hipSuccess || hipDeviceGetAttribute(&cus, hipDeviceAttributeMultiprocessorCount, dev) != hipSuccess) { grid = -1; return; }
        if (hipFuncSetAttribute((const void*)mega_fwd, hipFuncAttributeMaxDynamicSharedMemorySize, LDS_BYTES) != hipSuccess) { fprintf(stderr, "kernel_launch: hipFuncSetAttribute failed\n"); grid = -1; return; }
        (void)hipGetLastError();
        grid = cus;
        if (grid < 128 || (grid & 7)) { fprintf(stderr, "kernel_launch: unexpected CU count %d\n", cus); }
    }
    if (grid < 0) return;
    if (hipMemsetAsync((char*)d_ws + WS_CTL, 0, CTL_ZERO_BYTES, stream) != hipSuccess) return;
    Args a{};
    for (int i = 0; i < 20; ++i) a.in[i] = (const float*)d_in[i];
    a.out = (float*)d_out; a.ws = (unsigned char*)d_ws;
#if MK_N_LAUNCHES == 1
    a.ph_lo = 0; a.ph_hi = NPHASE; a.li = 0;
    hipLaunchKernelGGL(mega_fwd, dim3(grid), dim3(512), LDS_BYTES, stream, a);
#else
    for (int li = 0; li < NPHASE; ++li) { a.ph_lo = li; a.ph_hi = li + 1; a.li = 0; hipLaunchKernelGGL(mega_fwd, dim3(grid), dim3(512), LDS_BYTES, stream, a); }
#endif
}
```

```cpp
#include <hip/hip_runtime.h>
#include <cstdio>
#include <cstdint>

#ifndef MK_REPEAT
#define MK_REPEAT 0
#endif
#ifndef MK_N_LAUNCHES
#define MK_N_LAUNCHES 1
#endif

#define LAS __attribute__((address_space(3)))
typedef unsigned short bf16_t;
typedef short bf16x8 __attribute__((ext_vector_type(8)));
typedef short s16x4 __attribute__((ext_vector_type(4)));
typedef float f32x4 __attribute__((ext_vector_type(4)));
typedef unsigned u32x4 __attribute__((ext_vector_type(4)));
typedef unsigned u32x2 __attribute__((ext_vector_type(2)));

constexpr int DM = 1024, LP = 2064, NBATCH = 8, MPROMPT = NBATCH * LP  , NSB = 128, MSAMP = 512, MREAL = MPROMPT + MSAMP  , MPAD = 17152  ;
constexpr int NIN = 4096, INW = 4104, DFF = 2816, NUP = 5632, GQKV = 1536;
constexpr int UP_TROWS = 248, UP_NM = 69;
constexpr float EPS = 1e-6f;
constexpr size_t O_YP = 0, O_YS = 16777216, O_PSR = 17301504, O_PSG = 17825792, O_PCQ = 18350080, O_PCF = 18386944, O_SSR = 18477056, O_SSG = 26865664, O_SCQ = 35254272, O_SCF = 35844096, O_TOTAL = 37285888;
constexpr size_t MiB = 1u << 20;
constexpr size_t WS_CTL = 0, CTL_ZERO_BYTES = 1 * MiB;
constexpr size_t WS_WIN = 1 * MiB, WS_WOUT = 9 * MiB, WS_WUP = 11 * MiB, WS_WDN = 22 * MiB, WS_ROT = 28 * MiB, WS_BG = 30 * MiB, WS_RSQ2 = 31 * MiB, WS_RSQ3 = 32 * MiB + 512 * 1024;
constexpr size_t WS_PGX = 34 * MiB;
constexpr size_t WS_BIG = 36 * MiB;
constexpr size_t WS_PR = WS_BIG, WS_PG = WS_BIG + 67 * MiB, WS_G2A = WS_BIG + 134 * MiB, WS_H = WS_G2A;
constexpr size_t WS_X2F = WS_BIG, WS_X2B = WS_BIG + 67 * MiB, WS_ACT = WS_BIG + 101 * MiB;
constexpr size_t SLOT = 73984;
constexpr size_t WS_END = 256 * MiB;
static_assert(WS_G2A + 1056 * SLOT <= WS_END && WS_ACT + (size_t)MPAD * DFF * 2 <= WS_END, "ws map");
constexpr size_t OS_MIX = 0, OS_SCR = 34 * MiB;
static_assert(OS_SCR + 256 * SLOT <= 64 * MiB, "d_out scratch");
constexpr int CW_BAR = 4096;
constexpr int RING_BYTES = 131072, LDSCTL_OFF = RING_BYTES, MISC_OFF = LDSCTL_OFF + 320, LDS_BYTES = 147456;

#define LDS_WAIT() asm volatile("s_waitcnt lgkmcnt(0)" ::: "memory")
#define VM_WAIT() asm volatile("s_waitcnt vmcnt(0)" ::: "memory")

__device__ __forceinline__ unsigned cvt_pk_bf16(float lo, float hi) { unsigned r; asm volatile("v_cvt_pk_bf16_f32 %0, %1, %2" : "=v"(r) : "v"(lo), "v"(hi)); return r; }
__device__ __forceinline__ float bflo(unsigned w) { return __uint_as_float(w << 16); }
__device__ __forceinline__ float bfhi(unsigned w) { return __uint_as_float(w & 0xffff0000u); }
__device__ __forceinline__ float bfround(float x) { return bflo(cvt_pk_bf16(x, 0.f)); }
__device__ __forceinline__ float silu_f(float y) { return y * __builtin_amdgcn_rcpf(1.0f + __expf(-y)); }
__device__ __forceinline__ float wave_sum(float v) {
#pragma unroll
    for (int o = 1; o < 64; o <<= 1) v += __shfl_xor(v, o);
    return v;
}
__device__ __forceinline__ float dpp_shr1(float x) { return __int_as_float(__builtin_amdgcn_update_dpp(0, __float_as_int(x), 0x111, 0xf, 0xf, true)); }

struct RowInfo { int t, len, idx, samp; };
__device__ __forceinline__ RowInfo rowinfo(int g) {
    RowInfo r;
    if (g < MPROMPT) { r.idx = g / LP; r.t = g - r.idx * LP; r.len = LP; r.samp = 0; }
    else { const int s = g - MPROMPT; r.idx = s >> 2; r.t = s & 3; r.len = 4; r.samp = 1; }
    return r;
}

namespace pg8 {
constexpr int BM = 256, BK = 64, HALF = 128, HTB = HALF * BK * 2, STAGE_BYTES = 8 * HTB, NXCD = 8, WGM = 8;
__host__ __device__ __forceinline__ int lds_byte(int r, int c) { const int st = (r >> 4) * 2 + (c >> 5), rr = r & 15, cc = c & 31, ob = rr * 64 + cc * 2; return st * 1024 + (ob ^ (((ob >> 9) & 1) << 5)); }
__host__ __device__ __forceinline__ void stage_rc(int b, int& R, int& C) { const int st = b / 1024, sb = b % 1024, swz = sb ^ (((sb >> 9) & 1) << 5); R = (st >> 1) * 16 + swz / 64; C = (st & 1) * 32 + (swz % 64) / 2; }
__host__ __device__ __forceinline__ int perm32(int rho) { const int n = rho >> 4, i = rho & 15; return 8 * (i >> 2) + 4 * n + (i & 3); }
struct Unit { int pm, pn; };
struct Gemm { const bf16_t* A; const bf16_t* Bt; int K; };
struct StaticOrder {
    int nM, nN, nwg, G, c;
    __host__ __device__ void init(int nM_, int nN_, int G_, int c_) { nM = nM_; nN = nN_; nwg = nM * nN; G = G_; c = c_; }
    __host__ __device__ bool next(int i, Unit& u) const {
        const long L = (long)i * G + c; if (L >= nwg) return false;
        int wgid = (int)L; { const int q = nwg / NXCD, r = nwg % NXCD, xcd = wgid % NXCD, off = wgid / NXCD; wgid = (xcd < r ? xcd * (q + 1) : r * (q + 1) + (xcd - r) * q) + off; }
        const int nig = WGM * nN, gid = wgid / nig, fm = gid * WGM, gsz = (nM - fm) < WGM ? (nM - fm) : WGM;
        u.pm = fm + ((wgid % nig) % gsz); u.pn = (wgid % nig) / gsz; return true;
    }
    __device__ __forceinline__ void a_ready(const Unit&) const {}
    __device__ __forceinline__ void done(const Unit&) const {}
};
struct MapPlain { static constexpr int HROWS = 128, TROWS = 256; static __device__ __forceinline__ int row(int R) { return R; } };
struct MapUp { static constexpr int HROWS = 124, TROWS = UP_TROWS; static __device__ __forceinline__ int row(int R) { return 62 * (R >> 6) - 2 + 4 * (R & 15) + ((R >> 4) & 3); } };

template <class Epi, class Sched, class AMap, bool ALIGN_EPI = true>
__device__ __forceinline__ void gemm_phase(LAS unsigned char* lds, const Gemm g, const Sched& S, const Epi& E) {
    const int tid = threadIdx.x, wid = __builtin_amdgcn_readfirstlane(tid >> 6), lane = tid & 63, wr = wid >> 2, wc = wid & 3, fr = lane & 15, fq = lane >> 4;
    const int K = g.K, nt = K / BK;
    int voffA[2], voffB[2];
#pragma unroll
    for (int i = 0; i < 2; ++i) { int R, C; stage_rc(tid * 16 + i * 8192, R, C); const int Rb = Epi::PERM ? ((R & ~31) + perm32(R & 31)) : R;
        voffA[i] = (AMap::row(R) * K + C) * 2; voffB[i] = (Rb * K + C) * 2; }
    const size_t kstep = (size_t)(BK * 2);
    const size_t hstepA = (size_t)AMap::HROWS * K * 2, tstepA = (size_t)AMap::TROWS * K * 2;
    const size_t hstepB = (size_t)HALF * K * 2, tstepB = 2 * hstepB;
    const unsigned ldsw = (unsigned)wid * 1024u;
    const int aoff = lds_byte(wr * 64 + fr, fq * 8), boff = lds_byte(wc * 32 + fr, fq * 8);
#define PG8_SA(b, h) (((b) * 2 + (h)) * HTB)
#define PG8_SB(b, h) ((4 + (b) * 2 + (h)) * HTB)
#define PG8_STAGE(bufoff, gbase, voff) do { _Pragma("unroll") for (int _i = 0; _i < 2; ++_i) \
        __builtin_amdgcn_global_load_lds((const unsigned*)((const char*)(gbase) + (voff)[_i]), (LAS unsigned*)(lds + (bufoff) + ldsw + _i * 8192), 16, 0, 0); } while (0)
#define PG8_LDA(dst, b, h) do { _Pragma("unroll") for (int m = 0; m < 4; ++m) _Pragma("unroll") for (int k = 0; k < 2; ++k) dst[m][k] = *(const LAS bf16x8*)(lds + PG8_SA(b, h) + aoff + m * 2048 + k * 1024); } while (0)
#define PG8_LDB(dst, b, h) do { _Pragma("unroll") for (int n = 0; n < 2; ++n) _Pragma("unroll") for (int k = 0; k < 2; ++k) dst[n][k] = *(const LAS bf16x8*)(lds + PG8_SB(b, h) + boff + n * 2048 + k * 1024); } while (0)
#define PG8_MMA(ai, bj, At, Bt) do { __builtin_amdgcn_s_setprio(1); _Pragma("unroll") for (int m = 0; m < 4; ++m) _Pragma("unroll") for (int n = 0; n < 2; ++n) _Pragma("unroll") for (int k = 0; k < 2; ++k) \
        acc[ai][bj][m][n] = __builtin_amdgcn_mfma_f32_16x16x32_bf16(Bt[n][k], At[m][k], acc[ai][bj][m][n], 0, 0, 0); __builtin_amdgcn_s_setprio(0); } while (0)
#define PG8_WAIT_V(n) asm volatile("s_waitcnt vmcnt(" #n ")" ::: "memory")
#define PG8_WAIT_L(n) asm volatile("s_waitcnt lgkmcnt(" #n ")" ::: "memory")
#define PG8_BAR __builtin_amdgcn_s_barrier()
#define PG8_SCHED __builtin_amdgcn_sched_barrier(0)
    Unit cur, nxt; int ui = 0;
    if (!S.next(0, cur)) return;
    f32x4 acc[2][2][4][2];
#pragma unroll
    for (int a = 0; a < 2; ++a)
#pragma unroll
        for (int b = 0; b < 2; ++b)
#pragma unroll
            for (int m = 0; m < 4; ++m)
#pragma unroll
                for (int n = 0; n < 2; ++n) acc[a][b][m][n] = (f32x4){0.f, 0.f, 0.f, 0.f};
    bf16x8 At[4][2], B0[2][2], B1[2][2];
    const char* cA = (const char*)g.A + (size_t)cur.pm * tstepA; const char* cB = (const char*)g.Bt + (size_t)cur.pn * tstepB;
    S.a_ready(cur);
    PG8_STAGE(PG8_SB(0, 0), cB, voffB); PG8_STAGE(PG8_SB(0, 1), cB + hstepB, voffB); PG8_STAGE(PG8_SA(0, 0), cA, voffA); PG8_STAGE(PG8_SA(0, 1), cA + hstepA, voffA);
    if (wr == 1) PG8_BAR;
    PG8_WAIT_V(2); PG8_BAR;
    PG8_STAGE(PG8_SB(1, 0), cB + kstep, voffB); PG8_STAGE(PG8_SA(1, 0), cA + kstep, voffA); PG8_STAGE(PG8_SB(1, 1), cB + hstepB + kstep, voffB);
    PG8_WAIT_V(6); PG8_BAR;
    for (;;) {
        const bool has_next = S.next(ui + 1, nxt);
        const char* nA = has_next ? (const char*)g.A + (size_t)nxt.pm * tstepA : cA; const char* nB = has_next ? (const char*)g.Bt + (size_t)nxt.pn * tstepB : cB;
        for (int t = 0; t < nt; t += 2) {
            const bool last = (t == nt - 2);
            const char* a1 = cA + (size_t)(t + 1) * kstep;
            const char* a2 = last ? nA : cA + (size_t)(t + 2) * kstep; const char* b2 = last ? nB : cB + (size_t)(t + 2) * kstep;
            const char* a3 = a2 + kstep; const char* b3 = b2 + kstep;
            if (last && has_next) S.a_ready(nxt);
            PG8_LDB(B0, 0, 0); PG8_LDB(B1, 0, 1); PG8_SCHED; PG8_LDA(At, 0, 0); PG8_STAGE(PG8_SA(1, 1), a1 + hstepA, voffA);
            PG8_WAIT_V(8); PG8_WAIT_L(0); PG8_BAR; PG8_MMA(0, 0, At, B0); PG8_MMA(0, 1, At, B1); PG8_BAR; PG8_SCHED;
            PG8_LDA(At, 0, 1); PG8_STAGE(PG8_SB(0, 0), b2, voffB); PG8_STAGE(PG8_SB(0, 1), b2 + hstepB, voffB); PG8_STAGE(PG8_SA(0, 0), a2, voffA);
            PG8_WAIT_V(8); PG8_WAIT_L(0); PG8_BAR; PG8_MMA(1, 0, At, B0); PG8_MMA(1, 1, At, B1); PG8_BAR; PG8_SCHED;
            PG8_LDB(B0, 1, 0); PG8_LDB(B1, 1, 1); PG8_SCHED; PG8_LDA(At, 1, 0); PG8_STAGE(PG8_SA(0, 1), a2 + hstepA, voffA);
            PG8_WAIT_V(8); PG8_WAIT_L(0); PG8_BAR; PG8_MMA(0, 0, At, B0); PG8_MMA(0, 1, At, B1); PG8_BAR; PG8_SCHED;
            PG8_LDA(At, 1, 1); PG8_STAGE(PG8_SB(1, 0), b3, voffB); PG8_STAGE(PG8_SB(1, 1), b3 + hstepB, voffB); PG8_STAGE(PG8_SA(1, 0), a3, voffA);
            PG8_WAIT_V(8); PG8_WAIT_L(0); PG8_BAR; PG8_MMA(1, 0, At, B0); PG8_MMA(1, 1, At, B1); PG8_BAR; PG8_SCHED;
        }
        if constexpr (ALIGN_EPI) { if (wr == 0) PG8_BAR; }
        E(acc, cur, wr, wc, fr, fq); S.done(cur);
        if (!has_next) break;
#pragma unroll
        for (int a = 0; a < 2; ++a)
#pragma unroll
            for (int b = 0; b < 2; ++b)
#pragma unroll
                for (int m = 0; m < 4; ++m)
#pragma unroll
                    for (int n = 0; n < 2; ++n) acc[a][b][m][n] = (f32x4){0.f, 0.f, 0.f, 0.f};
        cur = nxt; cA = nA; cB = nB; ++ui;
        if constexpr (ALIGN_EPI) { if (wr == 1) PG8_BAR; }
    }
    PG8_WAIT_V(0);
    if constexpr (!ALIGN_EPI) { if (wr == 0) PG8_BAR; }
    PG8_BAR;
#undef PG8_SA
#undef PG8_SB
#undef PG8_STAGE
#undef PG8_LDA
#undef PG8_LDB
#undef PG8_MMA
#undef PG8_WAIT_V
#undef PG8_WAIT_L
#undef PG8_BAR
#undef PG8_SCHED
}
}
using pg8::Unit;


struct EpiIn {
    static constexpr bool PERM = true;
    bf16_t* PR; bf16_t* PG; const float* rot; float* out;
    __device__ __forceinline__ void operator()(const f32x4 (&acc)[2][2][4][2], const Unit& u, int wr, int wc, int fr_, int fq_) const {
        int ln_; asm volatile("v_mbcnt_lo_u32_b32 %0, -1, 0\n\tv_mbcnt_hi_u32_b32 %0, -1, %0" : "=v"(ln_)); const int fr = ln_ & 15, fq = ln_ >> 4;
        const int pn = u.pn, rbase = u.pm * 256 + wr * 64 + fr;
        if (pn < 4) {
            const int head = (pn & 1) * 2 + (wc >> 1), j0 = 32 * (wc & 1) + 8 * fq;
            const float sc = pn >= 2 ? 0.08838834764831845f : 1.0f;
            bf16_t* dstb = PR + (pn >= 2 ? 512 : 0) + head * 128 + j0;
#pragma unroll
            for (int ai = 0; ai < 2; ++ai)
#pragma unroll
                for (int m = 0; m < 4; ++m) {
                    const int row = rbase + ai * 128 + m * 16;
                    int ridx = 0; if (row < MPROMPT) ridx = row % LP; else if (row < MREAL) ridx = LP + ((row - MPROMPT) & 3);
                    const f32x4* rp = (const f32x4*)(rot + (size_t)ridx * 128 + j0 * 2);
                    const f32x4 cs0 = rp[0], cs1 = rp[1], cs2 = rp[2], cs3 = rp[3];
                    const f32x4 a0 = acc[ai][0][m][0], a1 = acc[ai][0][m][1], b0 = acc[ai][1][m][0], b1 = acc[ai][1][m][1];
                    const float c[8] = {cs0[0], cs0[2], cs1[0], cs1[2], cs2[0], cs2[2], cs3[0], cs3[2]};
                    const float s[8] = {cs0[1], cs0[3], cs1[1], cs1[3], cs2[1], cs2[3], cs3[1], cs3[3]};
                    const float x1[8] = {a0[0], a0[1], a0[2], a0[3], a1[0], a1[1], a1[2], a1[3]};
                    const float x2[8] = {b0[0], b0[1], b0[2], b0[3], b1[0], b1[1], b1[2], b1[3]};
                    float o1[8], o2[8];
#pragma unroll
                    for (int i = 0; i < 8; ++i) { o1[i] = (x1[i] * c[i] - x2[i] * s[i]) * sc; o2[i] = (x1[i] * s[i] + x2[i] * c[i]) * sc; }
                    u32x4 w1, w2; w1.x = cvt_pk_bf16(o1[0], o1[1]); w1.y = cvt_pk_bf16(o1[2], o1[3]); w1.z = cvt_pk_bf16(o1[4], o1[5]); w1.w = cvt_pk_bf16(o1[6], o1[7]);
                    w2.x = cvt_pk_bf16(o2[0], o2[1]); w2.y = cvt_pk_bf16(o2[2], o2[3]); w2.z = cvt_pk_bf16(o2[4], o2[5]); w2.w = cvt_pk_bf16(o2[6], o2[7]);
                    bf16_t* rowp = dstb + (size_t)row * 2048;
                    *(u32x4*)(rowp) = w1; *(u32x4*)(rowp + 64) = w2;
                }
        } else {
            const bool act = (pn == 6 || pn == 7 || pn >= 14);
            const bool cst = (pn >= 8 && pn < 14);
            bf16_t* dbase = pn < 8 ? PR : PG;
            const int colt = (pn < 8 ? pn * 256 : pn * 256 - 2048) + wc * 32 + 8 * fq;
#pragma unroll
            for (int ai = 0; ai < 2; ++ai)
#pragma unroll
                for (int m = 0; m < 4; ++m) {
                    const int row = rbase + ai * 128 + m * 16;
                    bf16_t* rowp = dbase + (size_t)row * 2048 + colt;
                    float* cdst = nullptr;
                    if (cst && row < MREAL) { const RowInfo ri = rowinfo(row); if (ri.t >= ri.len - 3) cdst = out + (ri.samp ? O_SCQ : O_PCQ) + (size_t)(ri.idx * 3 + (ri.t - (ri.len - 3))) * GQKV + colt; }
#pragma unroll
                    for (int bj = 0; bj < 2; ++bj) {
                        f32x4 v0 = acc[ai][bj][m][0], v1 = acc[ai][bj][m][1];
                        if (cdst) { *(f32x4*)(cdst + bj * 128) = v0; *(f32x4*)(cdst + bj * 128 + 4) = v1; }
                        if (act) {
#pragma unroll
                            for (int i = 0; i < 4; ++i) { v0[i] = silu_f(v0[i]); v1[i] = silu_f(v1[i]); }
                        }
                        u32x4 w; w.x = cvt_pk_bf16(v0[0], v0[1]); w.y = cvt_pk_bf16(v0[2], v0[3]); w.z = cvt_pk_bf16(v1[0], v1[1]); w.w = cvt_pk_bf16(v1[2], v1[3]);
                        *(u32x4*)(rowp + bj * 128) = w;
                    }
                }
        }
    }
};

__device__ __forceinline__ const float* x_src_row(const float* xp, const float* xs, const float* meta, int g) {
    if (g < MPROMPT) { const int b = g / LP, t = g - b * LP; return t < 16 ? meta + (size_t)t * DM : xp + ((size_t)b * 2048 + (t - 16)) * DM; }
    return xs + (size_t)(g - MPROMPT) * DM;
}

struct EpiOut {
    static constexpr bool PERM = false;
    const float* xp; const float* xs; const float* meta; float* X2F; bf16_t* X2B; float* rsq;
    __device__ __forceinline__ void operator()(const f32x4 (&acc)[2][2][4][2], const Unit& u, int wr, int wc, int fr_, int fq_) const {
        int ln_; asm volatile("v_mbcnt_lo_u32_b32 %0, -1, 0\n\tv_mbcnt_hi_u32_b32 %0, -1, %0" : "=v"(ln_)); const int fr = ln_ & 15, fq = ln_ >> 4;
        const int rbase = u.pm * 256 + wr * 64 + fr, col0 = u.pn * 256 + wc * 32 + 4 * fq;
#pragma unroll
        for (int ai = 0; ai < 2; ++ai)
#pragma unroll
            for (int m = 0; m < 4; ++m) {
                const int row = rbase + ai * 128 + m * 16;
                const float* xr = row < MREAL ? x_src_row(xp, xs, meta, row) + col0 : nullptr;
                float* of = X2F + (size_t)row * DM + col0; bf16_t* ob = X2B + (size_t)row * DM + col0;
                float ss = 0.f;
#pragma unroll
                for (int bj = 0; bj < 2; ++bj)
#pragma unroll
                    for (int n = 0; n < 2; ++n) {
                        f32x4 v = acc[ai][bj][m][n];
                        if (xr) v += *(const f32x4*)(xr + bj * 128 + n * 16);
                        ss += (v[0] * v[0] + v[1] * v[1]) + (v[2] * v[2] + v[3] * v[3]);
                        *(f32x4*)(of + bj * 128 + n * 16) = v;
                        u32x2 w; w.x = cvt_pk_bf16(v[0], v[1]); w.y = cvt_pk_bf16(v[2], v[3]);
                        *(u32x2*)(ob + bj * 128 + n * 16) = w;
                    }
                ss += __shfl_xor(ss, 16); ss += __shfl_xor(ss, 32);
                if (fq == 0) rsq[(size_t)row * 16 + u.pn * 4 + wc] = ss;
            }
    }
};

struct EpiDown {
    static constexpr bool PERM = false;
    const float* X2F; float* out; float* rsq;
    __device__ __forceinline__ void operator()(const f32x4 (&acc)[2][2][4][2], const Unit& u, int wr, int wc, int fr_, int fq_) const {
        int ln_; asm volatile("v_mbcnt_lo_u32_b32 %0, -1, 0\n\tv_mbcnt_hi_u32_b32 %0, -1, %0" : "=v"(ln_)); const int fr = ln_ & 15, fq = ln_ >> 4;
        const int rbase = u.pm * 256 + wr * 64 + fr, col0 = u.pn * 256 + wc * 32 + 4 * fq;
#pragma unroll
        for (int ai = 0; ai < 2; ++ai)
#pragma unroll
            for (int m = 0; m < 4; ++m) {
                const int row = rbase + ai * 128 + m * 16;
                float* yr = nullptr;
                if (row < MPROMPT) { const int b = row / LP, t = row - b * LP; if (t >= 16) yr = out + O_YP + ((size_t)b * 2048 + (t - 16)) * DM + col0; }
                else if (row < MREAL) yr = out + O_YS + (size_t)(row - MPROMPT) * DM + col0;
                const float* xr = X2F + (size_t)row * DM + col0;
                float ss = 0.f;
#pragma unroll
                for (int bj = 0; bj < 2; ++bj)
#pragma unroll
                    for (int n = 0; n < 2; ++n) {
                        const f32x4 v = acc[ai][bj][m][n] + *(const f32x4*)(xr + bj * 128 + n * 16);
                        ss += (v[0] * v[0] + v[1] * v[1]) + (v[2] * v[2] + v[3] * v[3]);
                        if (yr) *(f32x4*)(yr + bj * 128 + n * 16) = v;
                    }
                ss += __shfl_xor(ss, 16); ss += __shfl_xor(ss, 32);
                if (fq == 0) rsq[(size_t)row * 16 + u.pn * 4 + wc] = ss;
            }
    }
};

struct EpiUp {
    static constexpr bool PERM = true;
    const float* rsq2; const float* cw; const float* stf; bf16_t* act; float* out;
    __device__ __forceinline__ void operator()(const f32x4 (&acc)[2][2][4][2], const Unit& u, int wr, int wc, int fr_, int fq_) const {
        int ln_; asm volatile("v_mbcnt_lo_u32_b32 %0, -1, 0\n\tv_mbcnt_hi_u32_b32 %0, -1, %0" : "=v"(ln_)); const int fr = ln_ & 15, fq = ln_ >> 4;
        const int colg = u.pn * 128 + wc * 32 + fq * 8;
#pragma unroll
        for (int ai = 0; ai < 2; ++ai) {
            const int g0 = u.pm * UP_TROWS + (2 * ai + wr) * 62 - 2 + 4 * fr;
            float rs[4];
#pragma unroll
            for (int m = 0; m < 4; ++m) {
                int g = g0 + m; g = g < 0 ? 0 : g;
                const f32x4* p = (const f32x4*)(rsq2 + (size_t)g * 16);
                const f32x4 s0 = p[0], s1 = p[1], s2 = p[2], s3 = p[3];
                const float s = ((s0[0] + s0[1]) + (s0[2] + s0[3])) + ((s1[0] + s1[1]) + (s1[2] + s1[3])) + ((s2[0] + s2[1]) + (s2[2] + s2[3])) + ((s3[0] + s3[1]) + (s3[2] + s3[3]));
                rs[m] = rsqrtf(s * (1.0f / DM) + EPS);
                asm volatile("" : "+v"(rs[m]));
                __builtin_amdgcn_sched_barrier(0);
            }
#pragma unroll
            for (int n = 0; n < 2; ++n) {
                const int col = colg + 4 * n;
                f32x4 w[2][3];
#pragma unroll
                for (int bj = 0; bj < 2; ++bj)
#pragma unroll
                    for (int k = 0; k < 3; ++k) w[bj][k] = *(const f32x4*)(cw + (size_t)k * NUP + bj * DFF + col);
#pragma unroll
                for (int m = 0; m < 4; ++m) {
                    const int g = g0 + m;
                    const bool vout = (4 * fr + m >= 2) && (g < MREAL);
                    const RowInfo ri = rowinfo(g < 0 ? 0 : g);
                    float y[2][4];
#pragma unroll
                    for (int bj = 0; bj < 2; ++bj) {
                        float cur[4], p1[4], p2[4];
#pragma unroll
                        for (int i = 0; i < 4; ++i) {
                            cur[i] = acc[ai][bj][m][n][i] * rs[m];
                            p1[i] = m >= 1 ? acc[ai][bj][m >= 1 ? m - 1 : 0][n][i] * rs[m >= 1 ? m - 1 : 0] : dpp_shr1(acc[ai][bj][3][n][i] * rs[3]);
                            p2[i] = m >= 2 ? acc[ai][bj][m >= 2 ? m - 2 : 0][n][i] * rs[m >= 2 ? m - 2 : 0] : dpp_shr1(acc[ai][bj][m == 0 ? 2 : 3][n][i] * rs[m == 0 ? 2 : 3]);
                        }
                        if (ri.t < 2) {
                            f32x4 S0 = {0.f, 0.f, 0.f, 0.f}, S1 = {0.f, 0.f, 0.f, 0.f};
                            if (ri.samp && ri.idx < NSB) { S0 = *(const f32x4*)(stf + (size_t)(ri.idx * 2 + 0) * NUP + bj * DFF + col); S1 = *(const f32x4*)(stf + (size_t)(ri.idx * 2 + 1) * NUP + bj * DFF + col); }
#pragma unroll
                            for (int i = 0; i < 4; ++i) { if (ri.t == 0) { p1[i] = S1[i]; p2[i] = S0[i]; } else { p2[i] = S1[i]; } }
                        }
                        if (vout && ri.t >= ri.len - 2) {
                            float* d = out + (ri.samp ? O_SCF : O_PCF) + (size_t)(ri.idx * 2 + (ri.t - (ri.len - 2))) * NUP + bj * DFF + col;
                            *(f32x4*)(d) = (f32x4){cur[0], cur[1], cur[2], cur[3]};
                        }
#pragma unroll
                        for (int i = 0; i < 4; ++i) y[bj][i] = w[bj][0][i] * p2[i] + w[bj][1][i] * p1[i] + w[bj][2][i] * cur[i];
                    }
                    if (vout) {
                        u32x2 pk; pk.x = cvt_pk_bf16(silu_f(y[0][0]) * y[1][0], silu_f(y[0][1]) * y[1][1]); pk.y = cvt_pk_bf16(silu_f(y[0][2]) * y[1][2], silu_f(y[0][3]) * y[1][3]);
                        *(u32x2*)(act + (size_t)g * DFF + col) = pk;
                    }
                    __builtin_amdgcn_sched_barrier(0);
                }
            }
        }
    }
};

#define XB_TMO      128
#define XB_XCNT(j)  (256  + 64 * (j))
#define XB_XSUB(j)  (1280 + 64 * (j))
#define XB_XGEN(j)  (2304 + 64 * (j))
#define XB_TOP      3328
#define XB_TOPGEN   3392
#define XCD_BAR_WORDS 3456
#define XB_SPIN_CAP (1u << 20)
__device__ __forceinline__ unsigned xb_ld(unsigned* p)              { return __hip_atomic_load(p, __ATOMIC_RELAXED, __HIP_MEMORY_SCOPE_AGENT); }
__device__ __forceinline__ unsigned xb_add(unsigned* p, unsigned v) { return __hip_atomic_fetch_add(p, v, __ATOMIC_RELAXED, __HIP_MEMORY_SCOPE_AGENT); }
__device__ __forceinline__ unsigned xb_xcc_id() { return (unsigned)__builtin_amdgcn_s_getreg((3 << 11) | 20) & 0xFu; }
#define XB_SPIN(cond, bar) do { unsigned _sp = 0; while (cond) { __builtin_amdgcn_s_sleep(1); \
    if ((++_sp & 255u) == 0u) { if (xb_ld(&(bar)[XB_TMO])) break; if (_sp > XB_SPIN_CAP) { atomicAdd(&(bar)[XB_TMO], 1u); break; } } } } while (0)
struct XcdBarrier { unsigned* bar; unsigned x; volatile LAS unsigned* st; };
__device__ __forceinline__ XcdBarrier xcd_barrier_post(unsigned* bar, volatile LAS unsigned* st) {
    XcdBarrier b; b.bar = bar; b.x = xb_xcc_id(); b.st = st;
    if (threadIdx.x == 0) (void)xb_add(&bar[XB_XCNT(b.x)], 1u);
    return b;
}
__device__ __forceinline__ void xcd_barrier_complete(unsigned* bar, unsigned x, unsigned& nloc, unsigned& nx) {
    const unsigned G = gridDim.x * gridDim.y * gridDim.z;
    unsigned sum, cnt, mine, sp = 0u;
    for (;;) {
        sum = 0u; cnt = 0u; mine = 0u;
#pragma unroll
        for (unsigned j = 0; j < 16; ++j) { const unsigned c = xb_ld(&bar[XB_XCNT(j)]); sum += c; cnt += (c > 0u) ? 1u : 0u; mine = (j == x) ? c : mine; }
        if (sum == G) break;
        __builtin_amdgcn_s_sleep(1);
        if ((++sp & 255u) == 0u) { if (xb_ld(&bar[XB_TMO])) break; if (sp > XB_SPIN_CAP) { atomicAdd(&bar[XB_TMO], 1u); break; } }
    }
    nloc = mine > 0u ? mine : 1u; nx = cnt > 0u ? cnt : 1u;
}
__device__ __forceinline__ void xcd_barrier(const XcdBarrier& b) {
    asm volatile("s_waitcnt vmcnt(0)" ::: "memory");
    __syncthreads();
    if (threadIdx.x == 0) {
        unsigned* bar = b.bar;
        __builtin_amdgcn_s_waitcnt(0);
        unsigned nloc = b.st[0], nx = b.st[1];
        if (nloc == 0u) { xcd_barrier_complete(bar, b.x, nloc, nx); b.st[0] = nloc; b.st[1] = nx; }
        const unsigned old = xb_add(&bar[XB_XSUB(b.x)], 1u);
        const unsigned gen = old / nloc;
        if (old + 1u == (gen + 1u) * nloc) {
            __builtin_amdgcn_fence(__ATOMIC_RELEASE, "agent");
            asm volatile("s_waitcnt vmcnt(0)" ::: "memory");
            const unsigned og = xb_add(&bar[XB_TOP], 1u);
            const unsigned tg = og / nx;
            if (og + 1u == (tg + 1u) * nx) xb_add(&bar[XB_TOPGEN], 1u);
            else XB_SPIN(xb_ld(&bar[XB_TOPGEN]) == tg, bar);
            __builtin_amdgcn_fence(__ATOMIC_ACQUIRE, "agent");
            xb_add(&bar[XB_XGEN(b.x)], 1u);
            asm volatile("s_waitcnt vmcnt(0)" ::: "memory");
        } else {
            XB_SPIN(xb_ld(&bar[XB_XGEN(b.x)]) == gen, bar);
            __builtin_amdgcn_fence(__ATOMIC_ACQUIRE, "agent");
            asm volatile("s_waitcnt vmcnt(0)" ::: "memory");
        }
    }
    __syncthreads();
}

struct Frame {
    LAS unsigned char* lds;
    int tid, lane, wave, G, blk;
    const float* in[20];
    float* out; unsigned char* ws;
};

__device__ __forceinline__ void p0_transpose_item(const float* W, int ldw, int K, bf16_t* WT, int n0, int srcn0, int k0, const float* kscale, LAS float* scr, int lane) {
#pragma unroll 8
    for (int i = 0; i < 32; ++i) { const int kk = 2 * i + (lane >> 5); float v = W[(size_t)(k0 + kk) * ldw + srcn0 + (lane & 31)]; if (kscale) v *= kscale[k0 + kk]; scr[kk * 33 + (lane & 31)] = v; }
    LDS_WAIT(); asm volatile("" ::: "memory");
    const int c = lane & 7;
#pragma unroll
    for (int j = 0; j < 4; ++j) { const int n = (lane >> 3) + 8 * j; const LAS float* s = scr + (8 * c) * 33 + n;
        u32x4 o; o.x = cvt_pk_bf16(s[0 * 33], s[1 * 33]); o.y = cvt_pk_bf16(s[2 * 33], s[3 * 33]); o.z = cvt_pk_bf16(s[4 * 33], s[5 * 33]); o.w = cvt_pk_bf16(s[6 * 33], s[7 * 33]);
        *(u32x4*)(WT + (size_t)(n0 + n) * K + k0 + 8 * c) = o; }
    LDS_WAIT(); asm volatile("" ::: "memory");
}
__device__ __forceinline__ int in_colmap(int n0) {
    const int pn = n0 >> 8;
    if (pn >= 4) return n0;
    const int c = n0 & 255, bj = c >> 7, cc = c & 127, hl = cc >> 6, j = cc & 63;
    return (pn >= 2 ? 512 : 0) + ((pn & 1) * 2 + hl) * 128 + bj * 64 + j;
}
__device__ __forceinline__ void p0_prologue(Frame& F) {
    const float* w_in = F.in[8]; const float* w_out = F.in[14]; const float* w_up = F.in[16]; const float* w_dn = F.in[18];
    bf16_t* WIN = (bf16_t*)(F.ws + WS_WIN); bf16_t* WOUT = (bf16_t*)(F.ws + WS_WOUT); bf16_t* WUP = (bf16_t*)(F.ws + WS_WUP); bf16_t* WDN = (bf16_t*)(F.ws + WS_WDN);
    LAS float* scr = (LAS float*)(F.lds + F.wave * 8448);
    LAS float* WX = (LAS float*)(F.lds + 69632);
    for (int i = F.tid; i < 1024 * 8; i += 512) WX[i] = w_in[(size_t)(i >> 3) * INW + NIN + (i & 7)];
    const int gw = F.blk * 8 + F.wave, NGW = F.G * 8;
    constexpr int I_IN = 16 * 128, I_OUT = 16 * 32, I_UP = 16 * 176, I_DN = 44 * 32, NIT = I_IN + I_OUT + I_UP + I_DN;
    for (int it = gw; it < NIT; it += NGW) {
        int r = it;
        if (r < I_IN) { const int kb = r / 128, nb = r % 128; p0_transpose_item(w_in, INW, 1024, WIN, nb * 32, in_colmap(nb * 32), kb * 64, nullptr, scr, F.lane); continue; } r -= I_IN;
        if (r < I_OUT) { const int kb = r / 32, nb = r % 32; p0_transpose_item(w_out, 1024, 1024, WOUT, nb * 32, nb * 32, kb * 64, nullptr, scr, F.lane); continue; } r -= I_OUT;
        if (r < I_UP) { const int kb = r / 176, nb = r % 176; const int n0 = nb * 32, pn = n0 >> 8, c = n0 & 255; p0_transpose_item(w_up, NUP, 1024, WUP, n0, (c >> 7) * DFF + pn * 128 + (c & 127), kb * 64, F.in[15], scr, F.lane); continue; } r -= I_UP;
        { const int kb = r / 32, nb = r % 32; p0_transpose_item(w_dn, 1024, DFF, WDN, nb * 32, nb * 32, kb * 64, nullptr, scr, F.lane); }
    }
    __syncthreads();
    bf16_t* H = (bf16_t*)(F.ws + WS_H); float* BG = (float*)(F.ws + WS_BG);
    const float* nm = F.in[7];
    for (int g = gw; g < MPAD; g += NGW) {
        unsigned long long* o8 = (unsigned long long*)(H + (size_t)g * DM) + F.lane;
        if (g >= MREAL) {
#pragma unroll
            for (int j = 0; j < 4; ++j) o8[64 * j] = 0ull;
            continue;
        }
        const f32x4* xr = (const f32x4*)x_src_row(F.in[0], F.in[1], F.in[6], g) + F.lane;
        const f32x4* nr = (const f32x4*)nm + F.lane;
        f32x4 v[4]; float ss = 0.f;
#pragma unroll
        for (int j = 0; j < 4; ++j) { v[j] = xr[64 * j]; ss += (v[j][0] * v[j][0] + v[j][1] * v[j][1]) + (v[j][2] * v[j][2] + v[j][3] * v[j][3]); }
        const float rstd = rsqrtf(wave_sum(ss) * (1.0f / DM) + EPS);
        float ex[8];
#pragma unroll
        for (int e = 0; e < 8; ++e) ex[e] = 0.f;
#pragma unroll
        for (int j = 0; j < 4; ++j) {
            const f32x4 n4 = nr[64 * j];
            v[j] = v[j] * rstd * n4;
            o8[64 * j] = (unsigned long long)cvt_pk_bf16(v[j][0], v[j][1]) | ((unsigned long long)cvt_pk_bf16(v[j][2], v[j][3]) << 32);
#pragma unroll
            for (int i = 0; i < 4; ++i) {
                const int k = 4 * (F.lane + 64 * j) + i;
                const f32x4 wa = *(const LAS f32x4*)(WX + k * 8), wb = *(const LAS f32x4*)(WX + k * 8 + 4);
                ex[0] += v[j][i] * wa[0]; ex[1] += v[j][i] * wa[1]; ex[2] += v[j][i] * wa[2]; ex[3] += v[j][i] * wa[3];
                ex[4] += v[j][i] * wb[0]; ex[5] += v[j][i] * wb[1]; ex[6] += v[j][i] * wb[2]; ex[7] += v[j][i] * wb[3];
            }
        }
#pragma unroll
        for (int e = 0; e < 8; ++e) ex[e] = wave_sum(ex[e]);
        if (F.lane < 4) {
            const int h = F.lane;
            const float gb = h == 0 ? ex[0] : h == 1 ? ex[1] : h == 2 ? ex[2] : ex[3];
            const float ga = h == 0 ? ex[4] : h == 1 ? ex[5] : h == 2 ? ex[6] : ex[7];
            const float beta = 1.0f / (1.0f + __expf(-gb));
            const float xx = ga + F.in[11][h];
            const float sp = xx > 20.f ? xx : log1pf(__expf(xx));
            BG[(size_t)g * 8 + h] = beta;
            BG[(size_t)g * 8 + 4 + h] = -__expf(F.in[10][h]) * sp;
        }
    }
    {
        bf16_t* PGX = (bf16_t*)(F.ws + WS_PGX); const float* stq = F.in[4];
        for (int e = F.blk * 512 + F.tid; e < 385 * GQKV; e += F.G * 512) PGX[e] = e < 384 * GQKV ? (bf16_t)(cvt_pk_bf16(stq[e], 0.f) & 0xffffu) : (bf16_t)0;
    }
    float* ROT = (float*)(F.ws + WS_ROT);
    for (int e = F.blk * 512 + F.tid; e < 2068 * 64; e += F.G * 512) {
        const int p = e >> 6, j = e & 63; const int pos = p < LP ? p : 16384 + (p - LP);
        double f = 1.0, b = 0.8659643233600653523531691834202299819398;
#pragma unroll
        for (int k = 0; k < 6; ++k) { if ((j >> k) & 1) f *= b; b *= b; }
        double rev = (double)pos * f * 0.15915494309189533576888376337251436203445964574046;
        rev -= floor(rev);
        const float rf = (float)rev;
        ROT[(size_t)e * 2] = __builtin_amdgcn_cosf(rf); ROT[(size_t)e * 2 + 1] = __builtin_amdgcn_sinf(rf);
    }
}

struct SeqD { int row0, len, samp, idx; };
__device__ __forceinline__ bf16x8 mk8(s16x4 lo, s16x4 hi) { return (bf16x8){lo[0], lo[1], lo[2], lo[3], hi[0], hi[1], hi[2], hi[3]}; }
__device__ __forceinline__ s16x4 ld_tr(LAS unsigned char* p) { return __builtin_bit_cast(s16x4, __builtin_amdgcn_ds_read_tr16_b64_v4i16((LAS s16x4*)p)); }
__device__ __forceinline__ s16x4 ld_b64(LAS unsigned char* p) { return *(LAS s16x4*)p; }
__device__ __forceinline__ s16x4 pk4(f32x4 v) { u32x2 w; w.x = cvt_pk_bf16(v[0], v[1]); w.y = cvt_pk_bf16(v[2], v[3]); return __builtin_bit_cast(s16x4, w); }

__device__ __forceinline__ void p2a_item(Frame& F, const SeqD sq, int h, int t0, int c, unsigned char* slot) {
    unsigned lbase = (unsigned)(uintptr_t)F.lds; int tid = F.tid;
    asm volatile("" : "+s"(lbase), "+v"(tid));
    LAS unsigned char* L = (LAS unsigned char*)(uintptr_t)lbase;
    LAS float* AM = (LAS float*)(L); LAS float* RHS = (LAS float*)(L + 53248);
    LAS float* GL = (LAS float*)(L + 16384); LAS float* CUM = GL + 64; LAS float* BETA = GL + 128;
    LAS unsigned char* QB = L + 20480; LAS unsigned char* KB = L + 36864;
    const float* BG = (const float*)(F.ws + WS_BG);
    const float* cgw = F.in[9];
    const int r = tid >> 3, cg = tid & 7, lane = tid & 63, w = __builtin_amdgcn_readfirstlane(tid >> 6), fr = lane & 15, fg = lane >> 4;
    const bool valid = r < c;
    const int grow = sq.row0 + t0 + r;
    float beta_r = 0.f, gdec = 0.f;
    if (valid) { beta_r = BG[(size_t)grow * 8 + h]; gdec = BG[(size_t)grow * 8 + 4 + h]; }
    if (cg == 0) GL[r] = gdec;
    LAS float* CW = (LAS float*)(L + 118784);
#pragma unroll
    for (int k = 0; k < 3; ++k) { const int e = tid + 512 * k, dt = e / 384, rem = e - dt * 384; CW[e] = cgw[(size_t)dt * GQKV + (rem >> 7) * 512 + h * 128 + (rem & 127)]; }
    __syncthreads();
    float cum = 0.f, cl = 0.f;
#pragma unroll 8
    for (int j = 0; j < 64; ++j) { const float gj = GL[j]; cl += gj; if (j <= r) cum += gj; }
    const float er = __expf(cum), frr = __expf(cl - cum);
    if (cg == 0) { CUM[r] = cum; BETA[r] = beta_r; }
    if (tid == 0) *(float*)(slot + 73728) = __expf(cl);
#pragma unroll 1
    for (int X = 0; X < 3; ++X) {
        const int colb = X * 512 + h * 128 + 16 * cg;
        float y[16];
#pragma unroll
        for (int i = 0; i < 16; ++i) y[i] = 0.f;
        u32x4 da[4], db[4];
#pragma unroll
        for (int dt = 0; dt < 4; ++dt) {
            const int tt = t0 + r - 3 + dt;
            const unsigned oz = (unsigned)(WS_PGX + ((size_t)384 * GQKV + colb) * 2);
            const unsigned opg = (unsigned)(WS_PG + ((size_t)(sq.row0 + (tt >= 0 ? tt : 0)) * 2048 + colb) * 2);
            const unsigned opx = (unsigned)(WS_PGX + ((size_t)(sq.idx * 3 + (tt < 0 ? 3 + tt : 0)) * GQKV + colb) * 2);
            const unsigned so = valid ? (tt >= 0 ? opg : (sq.samp ? opx : oz)) : oz;
            const u32x4* sp = (const u32x4*)(F.ws + so);
            da[dt] = sp[0]; db[dt] = sp[1];
        }
#pragma unroll
        for (int dt = 0; dt < 4; ++dt) {
            const u32x4 a = da[dt], b = db[dt];
            const float xv[16] = {bflo(a.x), bfhi(a.x), bflo(a.y), bfhi(a.y), bflo(a.z), bfhi(a.z), bflo(a.w), bfhi(a.w), bflo(b.x), bfhi(b.x), bflo(b.y), bfhi(b.y), bflo(b.z), bfhi(b.z), bflo(b.w), bfhi(b.w)};
            const LAS f32x4* wp = (const LAS f32x4*)(CW + dt * 384 + X * 128 + 16 * cg);
#pragma unroll
            for (int k = 0; k < 4; ++k) { const f32x4 wv = wp[k]; y[4 * k] += wv[0] * xv[4 * k]; y[4 * k + 1] += wv[1] * xv[4 * k + 1]; y[4 * k + 2] += wv[2] * xv[4 * k + 2]; y[4 * k + 3] += wv[3] * xv[4 * k + 3]; }
        }
        float ss = 0.f;
#pragma unroll
        for (int i = 0; i < 16; ++i) { y[i] = valid ? silu_f(y[i]) : 0.f; ss += y[i] * y[i]; }
        ss += __shfl_xor(ss, 1); ss += __shfl_xor(ss, 2); ss += __shfl_xor(ss, 4);
        const float nrm = X == 0 ? rsqrtf(ss + EPS) * 0.08838834764831845f : (X == 1 ? rsqrtf(ss + EPS) : 1.0f);
        u32x4 p0, p1;
        p0.x = cvt_pk_bf16(y[0] * nrm, y[1] * nrm); p0.y = cvt_pk_bf16(y[2] * nrm, y[3] * nrm); p0.z = cvt_pk_bf16(y[4] * nrm, y[5] * nrm); p0.w = cvt_pk_bf16(y[6] * nrm, y[7] * nrm);
        p1.x = cvt_pk_bf16(y[8] * nrm, y[9] * nrm); p1.y = cvt_pk_bf16(y[10] * nrm, y[11] * nrm); p1.z = cvt_pk_bf16(y[12] * nrm, y[13] * nrm); p1.w = cvt_pk_bf16(y[14] * nrm, y[15] * nrm);
        const float z[16] = {bflo(p0.x), bfhi(p0.x), bflo(p0.y), bfhi(p0.y), bflo(p0.z), bfhi(p0.z), bflo(p0.w), bfhi(p0.w), bflo(p1.x), bfhi(p1.x), bflo(p1.y), bfhi(p1.y), bflo(p1.z), bfhi(p1.z), bflo(p1.w), bfhi(p1.w)};
        if (X < 2) {
            LAS unsigned char* dstl = (X == 0 ? QB : KB) + r * 256;
            *(LAS u32x4*)(dstl + (((2 * cg) ^ (r & 15)) * 16)) = p0; *(LAS u32x4*)(dstl + (((2 * cg + 1) ^ (r & 15)) * 16)) = p1;
            const float sc = X == 0 ? er : frr;
            u32x4 d0, d1;
            d0.x = cvt_pk_bf16(z[0] * sc, z[1] * sc); d0.y = cvt_pk_bf16(z[2] * sc, z[3] * sc); d0.z = cvt_pk_bf16(z[4] * sc, z[5] * sc); d0.w = cvt_pk_bf16(z[6] * sc, z[7] * sc);
            d1.x = cvt_pk_bf16(z[8] * sc, z[9] * sc); d1.y = cvt_pk_bf16(z[10] * sc, z[11] * sc); d1.z = cvt_pk_bf16(z[12] * sc, z[13] * sc); d1.w = cvt_pk_bf16(z[14] * sc, z[15] * sc);
            if (X == 0) { *(u32x4*)(slot + 16384 + r * 256 + (((2 * cg) ^ (r & 15)) * 16)) = d0; *(u32x4*)(slot + 16384 + r * 256 + (((2 * cg + 1) ^ (r & 15)) * 16)) = d1; }
            else { u32x4* gd = (u32x4*)(slot + 32768 + r * 256 + ((cg ^ (r & 7)) * 32)); gd[0] = d0; gd[1] = d1; }
        }
        if (X >= 1) {
            const float sc = X == 1 ? beta_r * er : beta_r;
            LAS float* rd = RHS + r * 256 + (X == 1 ? 128 : 0) + 16 * cg;
#pragma unroll
            for (int k = 0; k < 4; ++k) *(LAS f32x4*)(rd + 4 * k) = (f32x4){z[4 * k] * sc, z[4 * k + 1] * sc, z[4 * k + 2] * sc, z[4 * k + 3] * sc};
        }
    }
    __syncthreads();
    {
        bf16_t* QK = (bf16_t*)(slot + 49152);
#pragma unroll
        for (int rep = 0; rep < 2; ++rep) {
            const int idx = w + 8 * rep, it = idx >> 2, jt = idx & 3;
            const int jcol = 16 * jt + fr;
            if (it >= jt) {
                f32x4 akk = {0.f, 0.f, 0.f, 0.f}, aqk = {0.f, 0.f, 0.f, 0.f};
#pragma unroll
                for (int s = 0; s < 4; ++s) {
                    const int ri = 16 * it + fr, rj = 16 * jt + fr;
                    const bf16x8 bk = *(LAS bf16x8*)(KB + rj * 256 + (((4 * s + fg) ^ (rj & 15)) * 16));
                    const bf16x8 ak = *(LAS bf16x8*)(KB + ri * 256 + (((4 * s + fg) ^ (ri & 15)) * 16));
                    const bf16x8 aq = *(LAS bf16x8*)(QB + ri * 256 + (((4 * s + fg) ^ (ri & 15)) * 16));
                    akk = __builtin_amdgcn_mfma_f32_16x16x32_bf16(ak, bk, akk, 0, 0, 0);
                    aqk = __builtin_amdgcn_mfma_f32_16x16x32_bf16(aq, bk, aqk, 0, 0, 0);
                }
                const float cj = CUM[jcol];
#pragma unroll
                for (int rr = 0; rr < 4; ++rr) {
                    const int i_ = 16 * it + 4 * fg + rr;
                    const float dec = i_ >= jcol ? __expf(CUM[i_] - cj) : 0.f;
                    AM[i_ * 64 + jcol] = i_ > jcol ? BETA[i_] * akk[rr] * dec : 0.f;
                    QK[i_ * 64 + ((((jcol >> 3) ^ ((i_ >> 1) & 7)) << 3) | (jcol & 7))] = (bf16_t)(cvt_pk_bf16(aqk[rr] * dec, 0.f) & 0xffffu);
                }
            } else {
#pragma unroll
                for (int rr = 0; rr < 4; ++rr) { const int i_ = 16 * it + 4 * fg + rr; QK[i_ * 64 + ((((jcol >> 3) ^ ((i_ >> 1) & 7)) << 3) | (jcol & 7))] = 0; }
            }
        }
    }
    __syncthreads();
    {
        const int col = tid >> 1, hh = tid & 1;
        unsigned amo = (unsigned)(uintptr_t)AM + hh * 16u, r0 = (unsigned)(uintptr_t)RHS + col * 4u + hh * 4096u, r1 = (unsigned)(uintptr_t)RHS + col * 4u - hh * 4096u;
        asm volatile("" : "+v"(amo), "+v"(r0), "+v"(r1));
        LAS unsigned char* amb = (LAS unsigned char*)(uintptr_t)amo; LAS unsigned char* rb0 = (LAS unsigned char*)(uintptr_t)r0; LAS unsigned char* rb1 = (LAS unsigned char*)(uintptr_t)r1;
        float xs[64];
#pragma unroll
        for (int k = 0; k < 64; ++k) xs[k] = (k & 4) ? *(LAS float*)(rb1 + k * 1024) : *(LAS float*)(rb0 + k * 1024);
#pragma unroll
        for (int i = 1; i < 64; ++i) {
            float a0 = 0.f, a1 = 0.f;
#pragma unroll
            for (int q = 0; q < 8; ++q) {
                if (8 * q < i) { const f32x4 cq = *(LAS f32x4*)(amb + i * 256 + q * 32); a0 += cq[0] * xs[8 * q]; a1 += cq[1] * xs[8 * q + 1]; a0 += cq[2] * xs[8 * q + 2]; a1 += cq[3] * xs[8 * q + 3]; }
            }
            float a = a0 + a1;
            a += __int_as_float(__builtin_amdgcn_update_dpp(0, __float_as_int(a), 0xB1, 0xf, 0xf, true));
            const float v = (hh ? xs[i ^ 4] : xs[i]) - a;
            xs[i] = hh ? xs[i] : v; xs[i ^ 4] = hh ? v : xs[i ^ 4];
            asm volatile("" ::: "memory");
        }
        unsigned char* rowp = col < 128 ? slot + 57344 + col * 128 : slot + (col - 128) * 128;
        const int wsw = col < 128 ? 0 : (((col - 128) >> 1) & 3);
#pragma unroll
        for (int k = 0; k < 4; ++k) {
            u32x4* dst = (u32x4*)(rowp + (((2 * hh + (k >> 1)) ^ wsw) * 32) + (k & 1) * 16);
            const int e = 8 * k;
            u32x4 o;
            o.x = cvt_pk_bf16(hh ? xs[(32 + e) ^ 4] : xs[e], hh ? xs[(33 + e) ^ 4] : xs[e + 1]); o.y = cvt_pk_bf16(hh ? xs[(34 + e) ^ 4] : xs[e + 2], hh ? xs[(35 + e) ^ 4] : xs[e + 3]);
            o.z = cvt_pk_bf16(hh ? xs[(36 + e) ^ 4] : xs[e + 4], hh ? xs[(37 + e) ^ 4] : xs[e + 5]); o.w = cvt_pk_bf16(hh ? xs[(38 + e) ^ 4] : xs[e + 6], hh ? xs[(39 + e) ^ 4] : xs[e + 7]);
            *dst = o;
        }
    }
    __syncthreads();
}

constexpr int OS_PITCH = 132;
__device__ __forceinline__ void os_write(LAS unsigned char* OSb, const f32x4 (&o)[4], int w, int fr, int fg) {
    LAS float* OS = (LAS float*)OSb;
#pragma unroll
    for (int mt = 0; mt < 4; ++mt)
#pragma unroll
        for (int rr = 0; rr < 4; ++rr) OS[(16 * mt + 4 * fg + rr) * OS_PITCH + 16 * w + fr] = o[mt][rr];
}
template <int MODE  >
__device__ __forceinline__ void os_finish(LAS unsigned char* OSb, int tid, int h, int grow0, int c, const f32x4 (&nwv)[4], u32x4 ga, u32x4 gb, bf16_t* mix) {
    LAS float* OS = (LAS float*)OSb;
    const int r = tid >> 3, cg = tid & 7;
    f32x4 v[4];
#pragma unroll
    for (int k = 0; k < 4; ++k) v[k] = *(LAS f32x4*)(OS + r * OS_PITCH + 16 * cg + 4 * k);
    float rstd;
    if (MODE == 0) {
        float s = 0.f;
#pragma unroll
        for (int k = 0; k < 4; ++k) s += (v[k][0] + v[k][1]) + (v[k][2] + v[k][3]);
        s += __shfl_xor(s, 1); s += __shfl_xor(s, 2); s += __shfl_xor(s, 4);
        const float mu = s * (1.0f / 128.0f);
        float q = 0.f;
#pragma unroll
        for (int k = 0; k < 4; ++k) { v[k] = v[k] - mu; q += (v[k][0] * v[k][0] + v[k][1] * v[k][1]) + (v[k][2] * v[k][2] + v[k][3] * v[k][3]); }
        q += __shfl_xor(q, 1); q += __shfl_xor(q, 2); q += __shfl_xor(q, 4);
        rstd = rsqrtf(q * (1.0f / 128.0f) + EPS);
    } else {
        float q = 0.f;
#pragma unroll
        for (int k = 0; k < 4; ++k) q += (v[k][0] * v[k][0] + v[k][1] * v[k][1]) + (v[k][2] * v[k][2] + v[k][3] * v[k][3]);
        q += __shfl_xor(q, 1); q += __shfl_xor(q, 2); q += __shfl_xor(q, 4);
        rstd = rsqrtf(q * (1.0f / 128.0f) + EPS);
    }
    if (r < c) {
        const float gt[16] = {bflo(ga.x), bfhi(ga.x), bflo(ga.y), bfhi(ga.y), bflo(ga.z), bfhi(ga.z), bflo(ga.w), bfhi(ga.w), bflo(gb.x), bfhi(gb.x), bflo(gb.y), bfhi(gb.y), bflo(gb.z), bfhi(gb.z), bflo(gb.w), bfhi(gb.w)};
        float y[16];
#pragma unroll
        for (int k = 0; k < 4; ++k)
#pragma unroll
            for (int i = 0; i < 4; ++i) y[4 * k + i] = v[k][i] * rstd * nwv[k][i] * gt[4 * k + i];
        u32x4 o0, o1;
        o0.x = cvt_pk_bf16(y[0], y[1]); o0.y = cvt_pk_bf16(y[2], y[3]); o0.z = cvt_pk_bf16(y[4], y[5]); o0.w = cvt_pk_bf16(y[6], y[7]);
        o1.x = cvt_pk_bf16(y[8], y[9]); o1.y = cvt_pk_bf16(y[10], y[11]); o1.z = cvt_pk_bf16(y[12], y[13]); o1.w = cvt_pk_bf16(y[14], y[15]);
        u32x4* mp = (u32x4*)(mix + (size_t)(grow0 + r) * DM + (MODE == 0 ? 0 : 512) + h * 128 + 16 * cg);
        mp[0] = o0; mp[1] = o1;
    }
}

__device__ __forceinline__ void make_sb(const f32x4 (&S)[8], bf16x8 (&Sb)[4]) {
#pragma unroll
    for (int s = 0; s < 4; ++s) Sb[s] = mk8(pk4(S[2 * s]), pk4(S[2 * s + 1]));
}
__device__ __forceinline__ void chunk_of(const SeqD& sq, int n, int& t0, int& c) { if (sq.samp) { t0 = 0; c = 4; } else if (n == 0) { t0 = 0; c = 16; } else { t0 = 16 + 64 * (n - 1); c = 64; } }
constexpr int SCAN_BUF = 57344;

__device__ __forceinline__ void scan_gdn(Frame& F, const SeqD sq, int h, int nchunks, const unsigned char* slot0, const float* sinit, float* sfinal) {
    unsigned lbase = (unsigned)(uintptr_t)F.lds; int tid = F.tid;
    asm volatile("" : "+s"(lbase), "+v"(tid));
    LAS unsigned char* L = (LAS unsigned char*)(uintptr_t)lbase;
    const int lane = tid & 63, w = __builtin_amdgcn_readfirstlane(tid >> 6), fr = lane & 15, fg = lane >> 4;
    const bf16_t* PG = (const bf16_t*)(F.ws + WS_PG);
    bf16_t* mix = (bf16_t*)((unsigned char*)F.out + OS_MIX);
    f32x4 nwv[4];
#pragma unroll
    for (int k = 0; k < 4; ++k) nwv[k] = *(const f32x4*)(F.in[13] + 16 * (tid & 7) + 4 * k);
    f32x4 S[8]; bf16x8 Sb[4];
#pragma unroll
    for (int t = 0; t < 8; ++t) {
        if (sinit) { S[t] = (f32x4){sinit[(16 * t + 4 * fg + 0) * 128 + 16 * w + fr], sinit[(16 * t + 4 * fg + 1) * 128 + 16 * w + fr], sinit[(16 * t + 4 * fg + 2) * 128 + 16 * w + fr], sinit[(16 * t + 4 * fg + 3) * 128 + 16 * w + fr]}; }
        else S[t] = (f32x4){0.f, 0.f, 0.f, 0.f};
    }
    make_sb(S, Sb);
    const int uoff = 57344 + ((16 * w + fr) * 64 + 4 * fg) * 2;
    u32x4 R[7]; u32x2 ur[4];
#pragma unroll
    for (int p = 0; p < 7; ++p) R[p] = ((const u32x4*)slot0)[p * 512 + tid];
#pragma unroll
    for (int mt = 0; mt < 4; ++mt) ur[mt] = *(const u32x2*)(slot0 + uoff + 32 * mt);
#pragma unroll
    for (int p = 0; p < 7; ++p) ((LAS u32x4*)L)[p * 512 + tid] = R[p];
    __syncthreads();
    for (int n = 0; n < nchunks; ++n) {
        const unsigned char* img = slot0 + (size_t)n * SLOT;
        LAS unsigned char* Bc = L + (n & 1) * SCAN_BUF; LAS unsigned char* Bn = L + ((n & 1) ^ 1) * SCAN_BUF;
        int lane_ = lane; asm volatile("" : "+v"(lane_));
        const int fr = lane_ & 15, fg = lane_ >> 4;
        int t0, c; chunk_of(sq, n, t0, c);
        const float cd = *(const float*)(img + 73728);
        const bool more = n + 1 < nchunks;
        f32x4 u[4];
#pragma unroll
        for (int mt = 0; mt < 4; ++mt) u[mt] = (f32x4){bflo(ur[mt].x), bfhi(ur[mt].x), bflo(ur[mt].y), bfhi(ur[mt].y)};
        if (more) {
#pragma unroll
            for (int p = 0; p < 7; ++p) R[p] = ((const u32x4*)(img + SLOT))[p * 512 + tid];
#pragma unroll
            for (int mt = 0; mt < 4; ++mt) ur[mt] = *(const u32x2*)(img + SLOT + uoff + 32 * mt);
        }
        u32x4 ga = {0u, 0u, 0u, 0u}, gb = ga;
        if ((tid >> 3) < c) { const u32x4* gp = (const u32x4*)(PG + (size_t)(sq.row0 + t0 + (tid >> 3)) * 2048 + 1536 + h * 128 + 16 * (tid & 7)); ga = gp[0]; gb = gp[1]; }
        f32x4 wv[4];
#pragma unroll
        for (int mt = 0; mt < 4; ++mt) {
            f32x4 a = {0.f, 0.f, 0.f, 0.f};
#pragma unroll
            for (int s = 0; s < 4; ++s) {
                const int r0 = 32 * s + 4 * fg + (fr >> 2), r1 = r0 + 16;
                const s16x4 lo = ld_tr(Bc + r0 * 128 + ((mt ^ ((r0 >> 1) & 3)) * 32) + (fr & 3) * 8);
                const s16x4 hi = ld_tr(Bc + r1 * 128 + ((mt ^ ((r1 >> 1) & 3)) * 32) + (fr & 3) * 8);
                a = __builtin_amdgcn_mfma_f32_16x16x32_bf16(mk8(lo, hi), Sb[s], a, 0, 0, 0);
            }
            wv[mt] = u[mt] - a;
        }
        bf16x8 wb[2];
        wb[0] = mk8(pk4(wv[0]), pk4(wv[1])); wb[1] = mk8(pk4(wv[2]), pk4(wv[3]));
        f32x4 o[4];
#pragma unroll
        for (int mt = 0; mt < 4; ++mt) {
            f32x4 a = {0.f, 0.f, 0.f, 0.f};
            const int row = 16 * mt + fr;
#pragma unroll
            for (int s = 0; s < 4; ++s) {
                const s16x4 lo = ld_b64(Bc + 16384 + row * 256 + (((4 * s + (fg >> 1)) ^ fr) * 16) + (fg & 1) * 8);
                const s16x4 hi = ld_b64(Bc + 16384 + row * 256 + (((4 * s + 2 + (fg >> 1)) ^ fr) * 16) + (fg & 1) * 8);
                a = __builtin_amdgcn_mfma_f32_16x16x32_bf16(mk8(lo, hi), Sb[s], a, 0, 0, 0);
            }
#pragma unroll
            for (int s = 0; s < 2; ++s) {
                const s16x4 lo = ld_b64(Bc + 49152 + row * 128 + (((4 * s + (fg >> 1)) ^ ((row >> 1) & 7)) * 16) + (fg & 1) * 8);
                const s16x4 hi = ld_b64(Bc + 49152 + row * 128 + (((4 * s + 2 + (fg >> 1)) ^ ((row >> 1) & 7)) * 16) + (fg & 1) * 8);
                a = __builtin_amdgcn_mfma_f32_16x16x32_bf16(mk8(lo, hi), wb[s], a, 0, 0, 0);
            }
            o[mt] = a;
        }
#pragma unroll
        for (int t = 0; t < 8; ++t) {
            f32x4 a = S[t] * cd;
#pragma unroll
            for (int s = 0; s < 2; ++s) {
                const int r0 = 32 * s + 4 * fg + (fr >> 2), r1 = r0 + 16;
                const s16x4 lo = ld_tr(Bc + 32768 + r0 * 256 + ((t ^ (r0 & 7)) * 32) + (fr & 3) * 8);
                const s16x4 hi = ld_tr(Bc + 32768 + r1 * 256 + ((t ^ (r1 & 7)) * 32) + (fr & 3) * 8);
                a = __builtin_amdgcn_mfma_f32_16x16x32_bf16(mk8(lo, hi), wb[s], a, 0, 0, 0);
            }
            S[t] = a;
        }
        make_sb(S, Sb);
        __syncthreads();
        os_write(Bc, o, w, fr, fg);
        if (more) {
#pragma unroll
            for (int p = 0; p < 7; ++p) ((LAS u32x4*)Bn)[p * 512 + tid] = R[p];
        }
        __syncthreads();
        os_finish<1>(Bc, tid, h, sq.row0 + t0, c, nwv, ga, gb, mix);
    }
#pragma unroll
    for (int t = 0; t < 8; ++t)
#pragma unroll
        for (int rr = 0; rr < 4; ++rr) sfinal[(16 * t + 4 * fg + rr) * 128 + 16 * w + fr] = S[t][rr];
    __syncthreads();
}

__device__ __forceinline__ int swb(int row) { return ((row & 3) << 2) | ((row >> 2) & 3); }
__device__ __forceinline__ void scan_ret(Frame& F, const SeqD sq, int h, int nchunks, const float* sinit, float* sfinal) {
    unsigned lbase = (unsigned)(uintptr_t)F.lds; int tid = F.tid;
    asm volatile("" : "+s"(lbase), "+v"(tid));
    LAS unsigned char* L = (LAS unsigned char*)(uintptr_t)lbase;
    const int lane = tid & 63, w = __builtin_amdgcn_readfirstlane(tid >> 6), fr = lane & 15, fg = lane >> 4;
    const bf16_t* PR = (const bf16_t*)(F.ws + WS_PR);
    bf16_t* mix = (bf16_t*)((unsigned char*)F.out + OS_MIX);
    const float lg = h == 0 ? -0.04580368961312479f : h == 1 ? -0.02272007650008353f : h == 2 ? -0.011315313227834146f : -0.005646563141142063f;
    f32x4 nwv[4];
#pragma unroll
    for (int k = 0; k < 4; ++k) nwv[k] = *(const f32x4*)(F.in[12] + h * 128 + 16 * (tid & 7) + 4 * k);
    f32x4 S[8]; bf16x8 Sb[4];
#pragma unroll
    for (int t = 0; t < 8; ++t) {
        if (sinit) { S[t] = (f32x4){sinit[(16 * t + 4 * fg + 0) * 128 + 16 * w + fr], sinit[(16 * t + 4 * fg + 1) * 128 + 16 * w + fr], sinit[(16 * t + 4 * fg + 2) * 128 + 16 * w + fr], sinit[(16 * t + 4 * fg + 3) * 128 + 16 * w + fr]}; }
        else S[t] = (f32x4){0.f, 0.f, 0.f, 0.f};
    }
    make_sb(S, Sb);
    const int lr = tid >> 3, lpart = tid & 7;
    const int lsw = swb(lr);
    u32x4 RQ[6];
    {
        int t0, c; chunk_of(sq, 0, t0, c);
#pragma unroll
        for (int X = 0; X < 3; ++X) { RQ[2 * X] = (u32x4){0u, 0u, 0u, 0u}; RQ[2 * X + 1] = RQ[2 * X];
            if (lr < c) { const u32x4* p = (const u32x4*)(PR + (size_t)(sq.row0 + t0 + lr) * 2048 + X * 512 + h * 128 + 16 * lpart); RQ[2 * X] = p[0]; RQ[2 * X + 1] = p[1]; } }
#pragma unroll
        for (int X = 0; X < 3; ++X) { *(LAS u32x4*)(L + X * 16384 + lr * 256 + (((2 * lpart) ^ lsw) * 16)) = RQ[2 * X]; *(LAS u32x4*)(L + X * 16384 + lr * 256 + (((2 * lpart + 1) ^ lsw) * 16)) = RQ[2 * X + 1]; }
    }
    __syncthreads();
    for (int n = 0; n < nchunks; ++n) {
        LAS unsigned char* Bc = L + (n & 1) * SCAN_BUF; LAS unsigned char* Bn = L + ((n & 1) ^ 1) * SCAN_BUF;
        int lane_ = lane; asm volatile("" : "+v"(lane_));
        const int fr = lane_ & 15, fg = lane_ >> 4, swr = swb(fr);
        int t0, c; chunk_of(sq, n, t0, c);
        const bool more = n + 1 < nchunks;
        if (more) {
            int t1, c1; chunk_of(sq, n + 1, t1, c1);
#pragma unroll
            for (int X = 0; X < 3; ++X) { RQ[2 * X] = (u32x4){0u, 0u, 0u, 0u}; RQ[2 * X + 1] = RQ[2 * X];
                if (lr < c1) { const u32x4* p = (const u32x4*)(PR + (size_t)(sq.row0 + t1 + lr) * 2048 + X * 512 + h * 128 + 16 * lpart); RQ[2 * X] = p[0]; RQ[2 * X + 1] = p[1]; } }
        }
        u32x4 ga = {0u, 0u, 0u, 0u}, gb = ga;
        if (lr < c) { const u32x4* gp = (const u32x4*)(PR + (size_t)(sq.row0 + t0 + lr) * 2048 + 1536 + h * 128 + 16 * lpart); ga = gp[0]; gb = gp[1]; }
#pragma unroll
        for (int rep = 0; rep < 2; ++rep) {
            const int idx = w + 8 * rep, it = idx >> 2, jt = idx & 3, jcol = 16 * jt + fr;
            LAS bf16_t* Pb = (LAS bf16_t*)(Bc + 49152);
            f32x4 a = {0.f, 0.f, 0.f, 0.f};
            if (it >= jt) {
#pragma unroll
                for (int s = 0; s < 4; ++s) {
                    const bf16x8 aq = *(LAS bf16x8*)(Bc + (16 * it + fr) * 256 + (((4 * s + fg) ^ swr) * 16));
                    const bf16x8 bk = *(LAS bf16x8*)(Bc + 16384 + (16 * jt + fr) * 256 + (((4 * s + fg) ^ swr) * 16));
                    a = __builtin_amdgcn_mfma_f32_16x16x32_bf16(aq, bk, a, 0, 0, 0);
                }
            }
#pragma unroll
            for (int rr = 0; rr < 4; ++rr) {
                const int i_ = 16 * it + 4 * fg + rr;
                const float p = (it >= jt && i_ >= jcol) ? a[rr] * exp2f(lg * (float)(i_ - jcol)) : 0.f;
                Pb[i_ * 64 + ((((jcol >> 3) ^ ((i_ >> 1) & 7)) << 3) | (jcol & 7))] = (bf16_t)(cvt_pk_bf16(p, 0.f) & 0xffffu);
            }
        }
        __syncthreads();
        s16x4 vlo[2], vhi[2];
#pragma unroll
        for (int s = 0; s < 2; ++s) {
            const int r0 = 32 * s + 8 * fg + (fr >> 2), r1 = r0 + 4;
            vlo[s] = ld_tr(Bc + 32768 + r0 * 256 + (((2 * w + ((fr & 3) >> 1)) ^ swb(r0)) * 16) + (fr & 1) * 8);
            vhi[s] = ld_tr(Bc + 32768 + r1 * 256 + (((2 * w + ((fr & 3) >> 1)) ^ swb(r1)) * 16) + (fr & 1) * 8);
        }
        f32x4 o[4];
#pragma unroll
        for (int mt = 0; mt < 4; ++mt) {
            f32x4 a1 = {0.f, 0.f, 0.f, 0.f}, a2 = {0.f, 0.f, 0.f, 0.f};
            const int row = 16 * mt + fr;
#pragma unroll
            for (int s = 0; s < 2; ++s) {
                const bf16x8 ap = *(LAS bf16x8*)(Bc + 49152 + row * 128 + (((4 * s + fg) ^ ((row >> 1) & 7)) * 16));
                a1 = __builtin_amdgcn_mfma_f32_16x16x32_bf16(ap, mk8(vlo[s], vhi[s]), a1, 0, 0, 0);
            }
#pragma unroll
            for (int s = 0; s < 4; ++s) {
                const s16x4 lo = ld_b64(Bc + row * 256 + (((4 * s + (fg >> 1)) ^ swr) * 16) + (fg & 1) * 8);
                const s16x4 hi = ld_b64(Bc + row * 256 + (((4 * s + 2 + (fg >> 1)) ^ swr) * 16) + (fg & 1) * 8);
                a2 = __builtin_amdgcn_mfma_f32_16x16x32_bf16(mk8(lo, hi), Sb[s], a2, 0, 0, 0);
            }
#pragma unroll
            for (int rr = 0; rr < 4; ++rr) o[mt][rr] = a1[rr] + exp2f(lg * (float)(16 * mt + 4 * fg + rr + 1)) * a2[rr];
        }
        bf16x8 vd[2];
#pragma unroll
        for (int s = 0; s < 2; ++s) {
            float f[8];
#pragma unroll
            for (int jj = 0; jj < 8; ++jj) { const int j = 32 * s + 8 * fg + jj; const int e = c - 1 - j; f[jj] = e >= 0 ? exp2f(lg * (float)e) : 0.f; }
            const u32x2 l2 = __builtin_bit_cast(u32x2, vlo[s]), h2 = __builtin_bit_cast(u32x2, vhi[s]);
            u32x2 lo, hi;
            lo.x = cvt_pk_bf16(bflo(l2.x) * f[0], bfhi(l2.x) * f[1]); lo.y = cvt_pk_bf16(bflo(l2.y) * f[2], bfhi(l2.y) * f[3]);
            hi.x = cvt_pk_bf16(bflo(h2.x) * f[4], bfhi(h2.x) * f[5]); hi.y = cvt_pk_bf16(bflo(h2.y) * f[6], bfhi(h2.y) * f[7]);
            vd[s] = mk8(__builtin_bit_cast(s16x4, lo), __builtin_bit_cast(s16x4, hi));
        }
        const float gc = exp2f(lg * (float)c);
#pragma unroll
        for (int t = 0; t < 8; ++t) {
            f32x4 a = S[t] * gc;
#pragma unroll
            for (int s = 0; s < 2; ++s) {
                const int r0 = 32 * s + 8 * fg + (fr >> 2), r1 = r0 + 4;
                const s16x4 lo = ld_tr(Bc + 16384 + r0 * 256 + (((2 * t + ((fr & 3) >> 1)) ^ swb(r0)) * 16) + (fr & 1) * 8);
                const s16x4 hi = ld_tr(Bc + 16384 + r1 * 256 + (((2 * t + ((fr & 3) >> 1)) ^ swb(r1)) * 16) + (fr & 1) * 8);
                a = __builtin_amdgcn_mfma_f32_16x16x32_bf16(mk8(lo, hi), vd[s], a, 0, 0, 0);
            }
            S[t] = a;
        }
        make_sb(S, Sb);
        __syncthreads();
        os_write(Bc, o, w, fr, fg);
        if (more) {
#pragma unroll
            for (int X = 0; X < 3; ++X) { *(LAS u32x4*)(Bn + X * 16384 + lr * 256 + (((2 * lpart) ^ lsw) * 16)) = RQ[2 * X]; *(LAS u32x4*)(Bn + X * 16384 + lr * 256 + (((2 * lpart + 1) ^ lsw) * 16)) = RQ[2 * X + 1]; }
        }
        __syncthreads();
        os_finish<0>(Bc, tid, h, sq.row0 + t0, c, nwv, ga, gb, mix);
    }
#pragma unroll
    for (int t = 0; t < 8; ++t)
#pragma unroll
        for (int rr = 0; rr < 4; ++rr) sfinal[(16 * t + 4 * fg + rr) * 128 + 16 * w + fr] = S[t][rr];
    __syncthreads();
}

struct Args { const float* in[20]; float* out; unsigned char* ws; int ph_lo, ph_hi, li, pad; };
constexpr int NPHASE = 8;

__global__ void __launch_bounds__(512, 2) mega_fwd(Args args) {
    extern __shared__ __attribute__((aligned(16))) unsigned char lds[];
    Frame F;
    F.lds = (LAS unsigned char*)lds;
    F.tid = threadIdx.x; F.lane = F.tid & 63; F.wave = __builtin_amdgcn_readfirstlane(F.tid >> 6);
    F.G = gridDim.x; F.blk = blockIdx.x;
#pragma unroll
    for (int i = 0; i < 20; ++i) F.in[i] = args.in[i];
    F.out = args.out; F.ws = args.ws;
    volatile LAS unsigned* MISC = (volatile LAS unsigned*)(F.lds + MISC_OFF);
    for (int u = F.tid; u < (LDS_BYTES - LDSCTL_OFF) / 4; u += 512) ((LAS unsigned*)(F.lds + LDSCTL_OFF))[u] = 0u;
    __syncthreads();
    unsigned* barw = (unsigned*)(F.ws + WS_CTL) + CW_BAR + args.li * XCD_BAR_WORDS;
    XcdBarrier bar; bar.bar = barw; bar.x = 0; bar.st = nullptr;
    if (MK_N_LAUNCHES == 1) bar = xcd_barrier_post(barw, MISC + 8);
    const int lo = args.ph_lo, hi = args.ph_hi;
#define IN(k) (lo <= (k) && (k) < hi)
#define SEAM(k) do { if (IN(k) && IN((k) + 1)) xcd_barrier(bar); } while (0)

    for (int rep = 0; rep < 1 + (MK_REPEAT & 1); ++rep) { if (rep) xcd_barrier(bar); if (IN(0)) { p0_prologue(F); } }
    SEAM(0);
    for (int rep = 0; rep < 1 + ((MK_REPEAT >> 1) & 1); ++rep) { if (rep) xcd_barrier(bar);
    if (IN(1)) {
        pg8::Gemm g{(const bf16_t*)(F.ws + WS_H), (const bf16_t*)(F.ws + WS_WIN), 1024};
        pg8::StaticOrder S; S.init(MPAD / 256, NIN / 256, F.G, F.blk);
        EpiIn E{(bf16_t*)(F.ws + WS_PR), (bf16_t*)(F.ws + WS_PG), (const float*)(F.ws + WS_ROT), F.out};
        pg8::gemm_phase<EpiIn, pg8::StaticOrder, pg8::MapPlain>(F.lds, g, S, E);
    } }
    SEAM(1);
#pragma unroll 1
    for (int phx = 0; phx < 2 + ((MK_REPEAT >> 2) & 1) + ((MK_REPEAT >> 3) & 1); ++phx) {
        const int ph = phx < 1 + ((MK_REPEAT >> 2) & 1) ? 2 : 3;
        if (phx > 0 && IN(2) && IN(3)) xcd_barrier(bar);
        if (IN(ph)) {
            int it, iend, istep;
            if (ph == 2) { it = F.blk; iend = 1056; istep = F.G; }
            else if (F.blk < 64) { it = F.blk; iend = F.blk + 1; istep = 1; }
            else { it = F.blk; iend = 64 + 1024; istep = F.G - 64; }
#pragma unroll 1
            for (; it < iend; it += istep) {
                int kind, h, nch, t0 = 0, c = 4; SeqD sq; unsigned char* slot; const float* sinit = nullptr; float* sfinal = nullptr;
                if (ph == 2) {
                    const int bh = it / 33, n = it - bh * 33, b = bh >> 2; h = bh & 3; kind = 0; nch = 0;
                    sq = SeqD{b * LP, LP, 0, b}; t0 = n == 0 ? 0 : 16 + 64 * (n - 1); c = n == 0 ? 16 : 64;
                    slot = F.ws + WS_G2A + (size_t)it * SLOT;
                } else if (it < 64) {
                    const int bb = it & 31, b = bb >> 2; h = bb & 3; kind = it < 32 ? 1 : 2; nch = 33;
                    sq = SeqD{b * LP, LP, 0, b};
                    slot = F.ws + WS_G2A + (size_t)(bb * 33) * SLOT;
                    sfinal = F.out + (it < 32 ? O_PSG : O_PSR) + (size_t)bb * 16384;
                } else {
                    const int j = it - 64, rem = j & 511, sb = rem >> 2; h = rem & 3; kind = j < 512 ? 3 : 2; nch = 1;
                    sq = SeqD{MPROMPT + sb * 4, 4, 1, sb};
                    slot = (unsigned char*)F.out + OS_SCR + (size_t)F.blk * SLOT;
                    sinit = (j < 512 ? F.in[3] : F.in[2]) + (size_t)rem * 16384;
                    sfinal = F.out + (j < 512 ? O_SSG : O_SSR) + (size_t)rem * 16384;
                }
                if (kind == 0 || kind == 3) p2a_item(F, sq, h, t0, c, slot);
                if (kind == 3) {
                    __builtin_amdgcn_fence(__ATOMIC_RELEASE, "agent"); VM_WAIT(); __syncthreads();
                    __builtin_amdgcn_fence(__ATOMIC_ACQUIRE, "agent"); VM_WAIT(); __syncthreads();
                }
                if (kind == 1 || kind == 3) scan_gdn(F, sq, h, nch, slot, sinit, sfinal);
                if (kind == 2) scan_ret(F, sq, h, nch, sinit, sfinal);
            }
        }
    }
    SEAM(3);
    for (int rep = 0; rep < 1 + ((MK_REPEAT >> 4) & 1); ++rep) { if (rep) xcd_barrier(bar);
    if (IN(4)) {
        pg8::Gemm g{(const bf16_t*)((unsigned char*)F.out + OS_MIX), (const bf16_t*)(F.ws + WS_WOUT), 1024};
        pg8::StaticOrder S; S.init(MPAD / 256, 4, F.G, F.blk);
        EpiOut E{F.in[0], F.in[1], F.in[6], (float*)(F.ws + WS_X2F), (bf16_t*)(F.ws + WS_X2B), (float*)(F.ws + WS_RSQ2)};
        pg8::gemm_phase<EpiOut, pg8::StaticOrder, pg8::MapPlain>(F.lds, g, S, E);
    } }
    SEAM(4);
    for (int rep = 0; rep < 1 + ((MK_REPEAT >> 5) & 1); ++rep) { if (rep) xcd_barrier(bar);
    if (IN(5)) {
        pg8::Gemm g{(const bf16_t*)(F.ws + WS_X2B), (const bf16_t*)(F.ws + WS_WUP), 1024};
        pg8::StaticOrder S; S.init(UP_NM, NUP / 256, F.G, F.blk);
        EpiUp E{(const float*)(F.ws + WS_RSQ2), F.in[17], F.in[5], (bf16_t*)(F.ws + WS_ACT), F.out};
        pg8::gemm_phase<EpiUp, pg8::StaticOrder, pg8::MapUp>(F.lds, g, S, E);
    } }
    SEAM(5);
    for (int rep = 0; rep < 1 + ((MK_REPEAT >> 6) & 1); ++rep) { if (rep) xcd_barrier(bar);
    if (IN(6)) {
        pg8::Gemm g{(const bf16_t*)(F.ws + WS_ACT), (const bf16_t*)(F.ws + WS_WDN), DFF};
        pg8::StaticOrder S; S.init(MPAD / 256, 4, F.G, F.blk);
        EpiDown E{(const float*)(F.ws + WS_X2F), F.out, (float*)(F.ws + WS_RSQ3)};
        pg8::gemm_phase<EpiDown, pg8::StaticOrder, pg8::MapPlain>(F.lds, g, S, E);
    } }
    SEAM(6);
    if (IN(7)) {
        const float* rsq = (const float*)(F.ws + WS_RSQ3); const float* nf = F.in[19];
        const int gw = F.blk * 8 + F.wave, NGW = F.G * 8;
        for (int q = gw; q < 16384 + 512; q += NGW) {
            int g; float* dst;
            if (q < 16384) { g = (q >> 11) * LP + 16 + (q & 2047); dst = F.out + O_YP + (size_t)q * DM; } else { g = MPROMPT + (q - 16384); dst = F.out + O_YS + (size_t)(q - 16384) * DM; }
            float s = F.lane < 16 ? rsq[(size_t)g * 16 + F.lane] : 0.f;
            s = wave_sum(s);
            const float rstd = rsqrtf(s * (1.0f / DM) + EPS);
            f32x4* p = (f32x4*)dst + F.lane; const f32x4* np = (const f32x4*)nf + F.lane;
#pragma unroll
            for (int j = 0; j < 4; ++j) { f32x4 v = p[64 * j]; v = v * rstd * np[64 * j]; p[64 * j] = v; }
        }
    }
#undef IN
#undef SEAM
}

extern "C" void kernel_launch(void* const* d_in, const int* in_sizes, int n_in, void* d_out, int out_size, void* d_ws, size_t ws_size, hipStream_t stream) {
    static int grid = 0;
    if (grid == 0) {
        if (n_in != 20 || (size_t)out_size != O_TOTAL || ws_size < WS_END) { fprintf(stderr, "kernel_launch: unexpected shapes (n_in %d, out %d, ws %zu); nothing launched\n", n_in, out_size, ws_size); grid = -1; return; }
        int dev = 0, cus = 0;
        if (hipGetDevice(&dev) != hipSuccess || hipDeviceGetAttribute(&cus, hipDeviceAttributeMultiprocessorCount, dev) != hipSuccess) { grid = -1; return; }
        if (hipFuncSetAttribute((const void*)mega_fwd, hipFuncAttributeMaxDynamicSharedMemorySize, LDS_BYTES) != hipSuccess) { fprintf(stderr, "kernel_launch: hipFuncSetAttribute failed\n"); grid = -1; return; }
        (void)hipGetLastError();
        grid = cus;
        if (grid < 128 || (grid & 7)) { fprintf(stderr, "kernel_launch: unexpected CU count %d\n", cus); }
    }
    if (grid < 0) return;
    if (hipMemsetAsync((char*)d_ws + WS_CTL, 0, CTL_ZERO_BYTES, stream) != hipSuccess) return;
    Args a{};
    for (int i = 0; i < 20; ++i) a.in[i] = (const float*)d_in[i];
    a.out = (float*)d_out; a.ws = (unsigned char*)d_ws;
#if MK_N_LAUNCHES == 1
    a.ph_lo = 0; a.ph_hi = NPHASE; a.li = 0;
    hipLaunchKernelGGL(mega_fwd, dim3(grid), dim3(512), LDS_BYTES, stream, a);
#else
    for (int li = 0; li < NPHASE; ++li) { a.ph_lo = li; a.ph_hi = li + 1; a.li = 0; hipLaunchKernelGGL(mega_fwd, dim3(grid), dim3(512), LDS_BYTES, stream, a); }
#endif
}
```

```cpp
#include <hip/hip_runtime.h>
#include <cstdio>
#include <cstdint>

#ifndef MK_REPEAT
#define MK_REPEAT 0
#endif
#ifndef MK_TPROBE
#define MK_TPROBE 0
#endif
#ifndef MK_TSCALE
#define MK_TSCALE 2e-7f
#endif
#ifndef MK_N_LAUNCHES
#define MK_N_LAUNCHES 1
#endif

#define LAS __attribute__((address_space(3)))
typedef unsigned short bf16_t;
typedef short bf16x8 __attribute__((ext_vector_type(8)));
typedef short s16x4 __attribute__((ext_vector_type(4)));
typedef float f32x4 __attribute__((ext_vector_type(4)));
typedef unsigned u32x4 __attribute__((ext_vector_type(4)));
typedef unsigned u32x2 __attribute__((ext_vector_type(2)));

constexpr int DM = 1024, LP = 2064, NBATCH = 8, MPROMPT = NBATCH * LP  , NSB = 128, MSAMP = 512, MREAL = MPROMPT + MSAMP  , MPAD = 17152  ;
constexpr int NIN = 4096, INW = 4104, DFF = 2816, NUP = 5632, GQKV = 1536;
constexpr int UP_TROWS = 248, UP_NM = 69;
constexpr float EPS = 1e-6f;
constexpr size_t O_YP = 0, O_YS = 16777216, O_PSR = 17301504, O_PSG = 17825792, O_PCQ = 18350080, O_PCF = 18386944, O_SSR = 18477056, O_SSG = 26865664, O_SCQ = 35254272, O_SCF = 35844096, O_TOTAL = 37285888;
constexpr size_t MiB = 1u << 20;
constexpr size_t WS_CTL = 0, CTL_ZERO_BYTES = 1 * MiB;
constexpr size_t WS_WIN = 1 * MiB, WS_WOUT = 9 * MiB, WS_WUP = 11 * MiB, WS_WDN = 22 * MiB, WS_ROT = 28 * MiB, WS_BG = 30 * MiB, WS_RSQ2 = 31 * MiB, WS_RSQ3 = 32 * MiB + 512 * 1024;
constexpr size_t WS_PGX = 34 * MiB;
constexpr size_t WS_BIG = 36 * MiB;
constexpr size_t WS_PR = WS_BIG, WS_PG = WS_BIG + 67 * MiB, WS_G2A = WS_BIG + 134 * MiB, WS_H = WS_G2A;
constexpr size_t WS_X2F = WS_BIG, WS_X2B = WS_BIG + 67 * MiB, WS_ACT = WS_BIG + 101 * MiB;
constexpr size_t SLOT = 73984;
constexpr size_t WS_END = 256 * MiB;
static_assert(WS_G2A + 1056 * SLOT <= WS_END && WS_ACT + (size_t)MPAD * DFF * 2 <= WS_END, "ws map");
constexpr size_t OS_MIX = 0, OS_SCR = 34 * MiB;
static_assert(OS_SCR + 256 * SLOT <= 64 * MiB, "d_out scratch");
constexpr int CW_BAR = 4096, CW_TS = 16384;
constexpr int RING_BYTES = 131072, LDSCTL_OFF = RING_BYTES, MISC_OFF = LDSCTL_OFF + 320, LDS_BYTES = 147456;

#define LDS_WAIT() asm volatile("s_waitcnt lgkmcnt(0)" ::: "memory")
#define VM_WAIT() asm volatile("s_waitcnt vmcnt(0)" ::: "memory")

__device__ __forceinline__ unsigned cvt_pk_bf16(float lo, float hi) { unsigned r; asm volatile("v_cvt_pk_bf16_f32 %0, %1, %2" : "=v"(r) : "v"(lo), "v"(hi)); return r; }
__device__ __forceinline__ float bflo(unsigned w) { return __uint_as_float(w << 16); }
__device__ __forceinline__ float bfhi(unsigned w) { return __uint_as_float(w & 0xffff0000u); }
__device__ __forceinline__ float bfround(float x) { return bflo(cvt_pk_bf16(x, 0.f)); }
__device__ __forceinline__ float silu_f(float y) { return y * __builtin_amdgcn_rcpf(1.0f + __expf(-y)); }
__device__ __forceinline__ float wave_sum(float v) {
#pragma unroll
    for (int o = 1; o < 64; o <<= 1) v += __shfl_xor(v, o);
    return v;
}
__device__ __forceinline__ float dpp_shr1(float x) { return __int_as_float(__builtin_amdgcn_update_dpp(0, __float_as_int(x), 0x111, 0xf, 0xf, true)); }

struct RowInfo { int t, len, idx, samp; };
__device__ __forceinline__ RowInfo rowinfo(int g) {
    RowInfo r;
    if (g < MPROMPT) { r.idx = g / LP; r.t = g - r.idx * LP; r.len = LP; r.samp = 0; }
    else { const int s = g - MPROMPT; r.idx = s >> 2; r.t = s & 3; r.len = 4; r.samp = 1; }
    return r;
}

namespace pg8 {
constexpr int BM = 256, BK = 64, HALF = 128, HTB = HALF * BK * 2, STAGE_BYTES = 8 * HTB, NXCD = 8, WGM = 8;
__host__ __device__ __forceinline__ int lds_byte(int r, int c) { const int st = (r >> 4) * 2 + (c >> 5), rr = r & 15, cc = c & 31, ob = rr * 64 + cc * 2; return st * 1024 + (ob ^ (((ob >> 9) & 1) << 5)); }
__host__ __device__ __forceinline__ void stage_rc(int b, int& R, int& C) { const int st = b / 1024, sb = b % 1024, swz = sb ^ (((sb >> 9) & 1) << 5); R = (st >> 1) * 16 + swz / 64; C = (st & 1) * 32 + (swz % 64) / 2; }
__host__ __device__ __forceinline__ int perm32(int rho) { const int n = rho >> 4, i = rho & 15; return 8 * (i >> 2) + 4 * n + (i & 3); }
struct Unit { int pm, pn; };
struct Gemm { const bf16_t* A; const bf16_t* Bt; int K; };
struct StaticOrder {
    int nM, nN, nwg, G, c;
    __host__ __device__ void init(int nM_, int nN_, int G_, int c_) { nM = nM_; nN = nN_; nwg = nM * nN; G = G_; c = c_; }
    __host__ __device__ bool next(int i, Unit& u) const {
        const long L = (long)i * G + c; if (L >= nwg) return false;
        int wgid = (int)L; { const int q = nwg / NXCD, r = nwg % NXCD, xcd = wgid % NXCD, off = wgid / NXCD; wgid = (xcd < r ? xcd * (q + 1) : r * (q + 1) + (xcd - r) * q) + off; }
        const int nig = WGM * nN, gid = wgid / nig, fm = gid * WGM, gsz = (nM - fm) < WGM ? (nM - fm) : WGM;
        u.pm = fm + ((wgid % nig) % gsz); u.pn = (wgid % nig) / gsz; return true;
    }
    __device__ __forceinline__ void a_ready(const Unit&) const {}
    __device__ __forceinline__ void done(const Unit&) const {}
};
struct MapPlain { static constexpr int HROWS = 128, TROWS = 256; static __device__ __forceinline__ int row(int R) { return R; } };
struct MapUp { static constexpr int HROWS = 124, TROWS = UP_TROWS; static __device__ __forceinline__ int row(int R) { return 62 * (R >> 6) - 2 + 4 * (R & 15) + ((R >> 4) & 3); } };

template <class Epi, class Sched, class AMap, bool ALIGN_EPI = true>
__device__ __forceinline__ void gemm_phase(LAS unsigned char* lds, const Gemm g, const Sched& S, const Epi& E) {
    const int tid = threadIdx.x, wid = __builtin_amdgcn_readfirstlane(tid >> 6), lane = tid & 63, wr = wid >> 2, wc = wid & 3, fr = lane & 15, fq = lane >> 4;
    const int K = g.K, nt = K / BK;
    int voffA[2], voffB[2];
#pragma unroll
    for (int i = 0; i < 2; ++i) { int R, C; stage_rc(tid * 16 + i * 8192, R, C); const int Rb = Epi::PERM ? ((R & ~31) + perm32(R & 31)) : R;
        voffA[i] = (AMap::row(R) * K + C) * 2; voffB[i] = (Rb * K + C) * 2; }
    const size_t kstep = (size_t)(BK * 2);
    const size_t hstepA = (size_t)AMap::HROWS * K * 2, tstepA = (size_t)AMap::TROWS * K * 2;
    const size_t hstepB = (size_t)HALF * K * 2, tstepB = 2 * hstepB;
    const unsigned ldsw = (unsigned)wid * 1024u;
    const int aoff = lds_byte(wr * 64 + fr, fq * 8), boff = lds_byte(wc * 32 + fr, fq * 8);
#define PG8_SA(b, h) (((b) * 2 + (h)) * HTB)
#define PG8_SB(b, h) ((4 + (b) * 2 + (h)) * HTB)
#define PG8_STAGE(bufoff, gbase, voff) do { _Pragma("unroll") for (int _i = 0; _i < 2; ++_i) \
        __builtin_amdgcn_global_load_lds((const unsigned*)((const char*)(gbase) + (voff)[_i]), (LAS unsigned*)(lds + (bufoff) + ldsw + _i * 8192), 16, 0, 0); } while (0)
#define PG8_LDA(dst, b, h) do { _Pragma("unroll") for (int m = 0; m < 4; ++m) _Pragma("unroll") for (int k = 0; k < 2; ++k) dst[m][k] = *(const LAS bf16x8*)(lds + PG8_SA(b, h) + aoff + m * 2048 + k * 1024); } while (0)
#define PG8_LDB(dst, b, h) do { _Pragma("unroll") for (int n = 0; n < 2; ++n) _Pragma("unroll") for (int k = 0; k < 2; ++k) dst[n][k] = *(const LAS bf16x8*)(lds + PG8_SB(b, h) + boff + n * 2048 + k * 1024); } while (0)
#define PG8_MMA(ai, bj, At, Bt) do { __builtin_amdgcn_s_setprio(1); _Pragma("unroll") for (int m = 0; m < 4; ++m) _Pragma("unroll") for (int n = 0; n < 2; ++n) _Pragma("unroll") for (int k = 0; k < 2; ++k) \
        acc[ai][bj][m][n] = __builtin_amdgcn_mfma_f32_16x16x32_bf16(Bt[n][k], At[m][k], acc[ai][bj][m][n], 0, 0, 0); __builtin_amdgcn_s_setprio(0); } while (0)
#define PG8_WAIT_V(n) asm volatile("s_waitcnt vmcnt(" #n ")" ::: "memory")
#define PG8_WAIT_L(n) asm volatile("s_waitcnt lgkmcnt(" #n ")" ::: "memory")
#define PG8_BAR __builtin_amdgcn_s_barrier()
#define PG8_SCHED __builtin_amdgcn_sched_barrier(0)
    Unit cur, nxt; int ui = 0;
    if (!S.next(0, cur)) return;
    f32x4 acc[2][2][4][2];
#pragma unroll
    for (int a = 0; a < 2; ++a)
#pragma unroll
        for (int b = 0; b < 2; ++b)
#pragma unroll
            for (int m = 0; m < 4; ++m)
#pragma unroll
                for (int n = 0; n < 2; ++n) acc[a][b][m][n] = (f32x4){0.f, 0.f, 0.f, 0.f};
    bf16x8 At[4][2], B0[2][2], B1[2][2];
    const char* cA = (const char*)g.A + (size_t)cur.pm * tstepA; const char* cB = (const char*)g.Bt + (size_t)cur.pn * tstepB;
    S.a_ready(cur);
    PG8_STAGE(PG8_SB(0, 0), cB, voffB); PG8_STAGE(PG8_SB(0, 1), cB + hstepB, voffB); PG8_STAGE(PG8_SA(0, 0), cA, voffA); PG8_STAGE(PG8_SA(0, 1), cA + hstepA, voffA);
    if (wr == 1) PG8_BAR;
    PG8_WAIT_V(2); PG8_BAR;
    PG8_STAGE(PG8_SB(1, 0), cB + kstep, voffB); PG8_STAGE(PG8_SA(1, 0), cA + kstep, voffA); PG8_STAGE(PG8_SB(1, 1), cB + hstepB + kstep, voffB);
    PG8_WAIT_V(6); PG8_BAR;
    for (;;) {
        const bool has_next = S.next(ui + 1, nxt);
        const char* nA = has_next ? (const char*)g.A + (size_t)nxt.pm * tstepA : cA; const char* nB = has_next ? (const char*)g.Bt + (size_t)nxt.pn * tstepB : cB;
        for (int t = 0; t < nt; t += 2) {
            const bool last = (t == nt - 2);
            const char* a1 = cA + (size_t)(t + 1) * kstep;
            const char* a2 = last ? nA : cA + (size_t)(t + 2) * kstep; const char* b2 = last ? nB : cB + (size_t)(t + 2) * kstep;
            const char* a3 = a2 + kstep; const char* b3 = b2 + kstep;
            if (last && has_next) S.a_ready(nxt);
            PG8_LDB(B0, 0, 0); PG8_LDB(B1, 0, 1); PG8_SCHED; PG8_LDA(At, 0, 0); PG8_STAGE(PG8_SA(1, 1), a1 + hstepA, voffA);
            PG8_WAIT_V(8); PG8_WAIT_L(0); PG8_BAR; PG8_MMA(0, 0, At, B0); PG8_MMA(0, 1, At, B1); PG8_BAR; PG8_SCHED;
            PG8_LDA(At, 0, 1); PG8_STAGE(PG8_SB(0, 0), b2, voffB); PG8_STAGE(PG8_SB(0, 1), b2 + hstepB, voffB); PG8_STAGE(PG8_SA(0, 0), a2, voffA);
            PG8_WAIT_V(8); PG8_WAIT_L(0); PG8_BAR; PG8_MMA(1, 0, At, B0); PG8_MMA(1, 1, At, B1); PG8_BAR; PG8_SCHED;
            PG8_LDB(B0, 1, 0); PG8_LDB(B1, 1, 1); PG8_SCHED; PG8_LDA(At, 1, 0); PG8_STAGE(PG8_SA(0, 1), a2 + hstepA, voffA);
            PG8_WAIT_V(8); PG8_WAIT_L(0); PG8_BAR; PG8_MMA(0, 0, At, B0); PG8_MMA(0, 1, At, B1); PG8_BAR; PG8_SCHED;
            PG8_LDA(At, 1, 1); PG8_STAGE(PG8_SB(1, 0), b3, voffB); PG8_STAGE(PG8_SB(1, 1), b3 + hstepB, voffB); PG8_STAGE(PG8_SA(1, 0), a3, voffA);
            PG8_WAIT_V(8); PG8_WAIT_L(0); PG8_BAR; PG8_MMA(1, 0, At, B0); PG8_MMA(1, 1, At, B1); PG8_BAR; PG8_SCHED;
        }
        if constexpr (ALIGN_EPI) { if (wr == 0) PG8_BAR; }
        E(acc, cur, wr, wc, fr, fq); S.done(cur);
        if (!has_next) break;
#pragma unroll
        for (int a = 0; a < 2; ++a)
#pragma unroll
            for (int b = 0; b < 2; ++b)
#pragma unroll
                for (int m = 0; m < 4; ++m)
#pragma unroll
                    for (int n = 0; n < 2; ++n) acc[a][b][m][n] = (f32x4){0.f, 0.f, 0.f, 0.f};
        cur = nxt; cA = nA; cB = nB; ++ui;
        if constexpr (ALIGN_EPI) { if (wr == 1) PG8_BAR; }
    }
    PG8_WAIT_V(0);
    if constexpr (!ALIGN_EPI) { if (wr == 0) PG8_BAR; }
    PG8_BAR;
#undef PG8_SA
#undef PG8_SB
#undef PG8_STAGE
#undef PG8_LDA
#undef PG8_LDB
#undef PG8_MMA
#undef PG8_WAIT_V
#undef PG8_WAIT_L
#undef PG8_BAR
#undef PG8_SCHED
}
}
using pg8::Unit;


struct EpiIn {
    static constexpr bool PERM = true;
    bf16_t* PR; bf16_t* PG; const float* rot; float* out;
    __device__ __forceinline__ void operator()(const f32x4 (&acc)[2][2][4][2], const Unit& u, int wr, int wc, int fr_, int fq_) const {
        int ln_; asm volatile("v_mbcnt_lo_u32_b32 %0, -1, 0\n\tv_mbcnt_hi_u32_b32 %0, -1, %0" : "=v"(ln_)); const int fr = ln_ & 15, fq = ln_ >> 4;
        const int pn = u.pn, rbase = u.pm * 256 + wr * 64 + fr;
        if (pn < 4) {
            const int head = (pn & 1) * 2 + (wc >> 1), j0 = 32 * (wc & 1) + 8 * fq;
            const float sc = pn >= 2 ? 0.08838834764831845f : 1.0f;
            bf16_t* dstb = PR + (pn >= 2 ? 512 : 0) + head * 128 + j0;
#pragma unroll
            for (int ai = 0; ai < 2; ++ai)
#pragma unroll
                for (int m = 0; m < 4; ++m) {
                    const int row = rbase + ai * 128 + m * 16;
                    int ridx = 0; if (row < MPROMPT) ridx = row % LP; else if (row < MREAL) ridx = LP + ((row - MPROMPT) & 3);
                    const f32x4* rp = (const f32x4*)(rot + (size_t)ridx * 128 + j0 * 2);
                    const f32x4 cs0 = rp[0], cs1 = rp[1], cs2 = rp[2], cs3 = rp[3];
                    const f32x4 a0 = acc[ai][0][m][0], a1 = acc[ai][0][m][1], b0 = acc[ai][1][m][0], b1 = acc[ai][1][m][1];
                    const float c[8] = {cs0[0], cs0[2], cs1[0], cs1[2], cs2[0], cs2[2], cs3[0], cs3[2]};
                    const float s[8] = {cs0[1], cs0[3], cs1[1], cs1[3], cs2[1], cs2[3], cs3[1], cs3[3]};
                    const float x1[8] = {a0[0], a0[1], a0[2], a0[3], a1[0], a1[1], a1[2], a1[3]};
                    const float x2[8] = {b0[0], b0[1], b0[2], b0[3], b1[0], b1[1], b1[2], b1[3]};
                    float o1[8], o2[8];
#pragma unroll
                    for (int i = 0; i < 8; ++i) { o1[i] = (x1[i] * c[i] - x2[i] * s[i]) * sc; o2[i] = (x1[i] * s[i] + x2[i] * c[i]) * sc; }
                    u32x4 w1, w2; w1.x = cvt_pk_bf16(o1[0], o1[1]); w1.y = cvt_pk_bf16(o1[2], o1[3]); w1.z = cvt_pk_bf16(o1[4], o1[5]); w1.w = cvt_pk_bf16(o1[6], o1[7]);
                    w2.x = cvt_pk_bf16(o2[0], o2[1]); w2.y = cvt_pk_bf16(o2[2], o2[3]); w2.z = cvt_pk_bf16(o2[4], o2[5]); w2.w = cvt_pk_bf16(o2[6], o2[7]);
                    bf16_t* rowp = dstb + (size_t)row * 2048;
                    *(u32x4*)(rowp) = w1; *(u32x4*)(rowp + 64) = w2;
                }
        } else {
            const bool act = (pn == 6 || pn == 7 || pn >= 14);
            const bool cst = (pn >= 8 && pn < 14);
            bf16_t* dbase = pn < 8 ? PR : PG;
            const int colt = (pn < 8 ? pn * 256 : pn * 256 - 2048) + wc * 32 + 8 * fq;
#pragma unroll
            for (int ai = 0; ai < 2; ++ai)
#pragma unroll
                for (int m = 0; m < 4; ++m) {
                    const int row = rbase + ai * 128 + m * 16;
                    bf16_t* rowp = dbase + (size_t)row * 2048 + colt;
                    float* cdst = nullptr;
                    if (cst && row < MREAL) { const RowInfo ri = rowinfo(row); if (ri.t >= ri.len - 3) cdst = out + (ri.samp ? O_SCQ : O_PCQ) + (size_t)(ri.idx * 3 + (ri.t - (ri.len - 3))) * GQKV + colt; }
#pragma unroll
                    for (int bj = 0; bj < 2; ++bj) {
                        f32x4 v0 = acc[ai][bj][m][0], v1 = acc[ai][bj][m][1];
                        if (cdst) { *(f32x4*)(cdst + bj * 128) = v0; *(f32x4*)(cdst + bj * 128 + 4) = v1; }
                        if (act) {
#pragma unroll
                            for (int i = 0; i < 4; ++i) { v0[i] = silu_f(v0[i]); v1[i] = silu_f(v1[i]); }
                        }
                        u32x4 w; w.x = cvt_pk_bf16(v0[0], v0[1]); w.y = cvt_pk_bf16(v0[2], v0[3]); w.z = cvt_pk_bf16(v1[0], v1[1]); w.w = cvt_pk_bf16(v1[2], v1[3]);
                        *(u32x4*)(rowp + bj * 128) = w;
                    }
                }
        }
    }
};

__device__ __forceinline__ const float* x_src_row(const float* xp, const float* xs, const float* meta, int g) {
    if (g < MPROMPT) { const int b = g / LP, t = g - b * LP; return t < 16 ? meta + (size_t)t * DM : xp + ((size_t)b * 2048 + (t - 16)) * DM; }
    return xs + (size_t)(g - MPROMPT) * DM;
}

struct EpiOut {
    static constexpr bool PERM = false;
    const float* xp; const float* xs; const float* meta; bf16_t* X2B; float* rsq;
    __device__ __forceinline__ void operator()(const f32x4 (&acc)[2][2][4][2], const Unit& u, int wr, int wc, int fr_, int fq_) const {
        int ln_; asm volatile("v_mbcnt_lo_u32_b32 %0, -1, 0\n\tv_mbcnt_hi_u32_b32 %0, -1, %0" : "=v"(ln_)); const int fr = ln_ & 15, fq = ln_ >> 4;
        const int rbase = u.pm * 256 + wr * 64 + fr, col0 = u.pn * 256 + wc * 32 + 4 * fq;
#pragma unroll
        for (int ai = 0; ai < 2; ++ai)
#pragma unroll
            for (int m = 0; m < 4; ++m) {
                const int row = rbase + ai * 128 + m * 16;
                const float* xr = row < MREAL ? x_src_row(xp, xs, meta, row) + col0 : nullptr;
                bf16_t* ob = X2B + (size_t)row * DM + col0;
                float ss = 0.f;
#pragma unroll
                for (int bj = 0; bj < 2; ++bj)
#pragma unroll
                    for (int n = 0; n < 2; ++n) {
                        f32x4 v = acc[ai][bj][m][n];
                        if (xr) v += *(const f32x4*)(xr + bj * 128 + n * 16);
                        ss += (v[0] * v[0] + v[1] * v[1]) + (v[2] * v[2] + v[3] * v[3]);
                        u32x2 w; w.x = cvt_pk_bf16(v[0], v[1]); w.y = cvt_pk_bf16(v[2], v[3]);
                        *(u32x2*)(ob + bj * 128 + n * 16) = w;
                    }
                ss += __shfl_xor(ss, 16); ss += __shfl_xor(ss, 32);
                if (fq == 0) rsq[(size_t)row * 16 + u.pn * 4 + wc] = ss;
            }
    }
};

struct EpiDown {
    static constexpr bool PERM = false;
    const bf16_t* X2B; float* out; float* rsq;
    __device__ __forceinline__ void operator()(const f32x4 (&acc)[2][2][4][2], const Unit& u, int wr, int wc, int fr_, int fq_) const {
        int ln_; asm volatile("v_mbcnt_lo_u32_b32 %0, -1, 0\n\tv_mbcnt_hi_u32_b32 %0, -1, %0" : "=v"(ln_)); const int fr = ln_ & 15, fq = ln_ >> 4;
        const int rbase = u.pm * 256 + wr * 64 + fr, col0 = u.pn * 256 + wc * 32 + 4 * fq;
#pragma unroll
        for (int ai = 0; ai < 2; ++ai)
#pragma unroll
            for (int m = 0; m < 4; ++m) {
                const int row = rbase + ai * 128 + m * 16;
                float* yr = nullptr;
                if (row < MPROMPT) { const int b = row / LP, t = row - b * LP; if (t >= 16) yr = out + O_YP + ((size_t)b * 2048 + (t - 16)) * DM + col0; }
                else if (row < MREAL) yr = out + O_YS + (size_t)(row - MPROMPT) * DM + col0;
                const bf16_t* xr = X2B + (size_t)row * DM + col0;
                float ss = 0.f;
#pragma unroll
                for (int bj = 0; bj < 2; ++bj)
#pragma unroll
                    for (int n = 0; n < 2; ++n) {
                        const u32x2 xb = *(const u32x2*)(xr + bj * 128 + n * 16);
                        const f32x4 v = acc[ai][bj][m][n] + (f32x4){bflo(xb.x), bfhi(xb.x), bflo(xb.y), bfhi(xb.y)};
                        ss += (v[0] * v[0] + v[1] * v[1]) + (v[2] * v[2] + v[3] * v[3]);
                        if (yr) *(f32x4*)(yr + bj * 128 + n * 16) = v;
                    }
                ss += __shfl_xor(ss, 16); ss += __shfl_xor(ss, 32);
                if (fq == 0) rsq[(size_t)row * 16 + u.pn * 4 + wc] = ss;
            }
    }
};

struct EpiUp {
    static constexpr bool PERM = true;
    const float* rsq2; const float* cw; const float* stf; bf16_t* act; float* out;
    __device__ __forceinline__ void operator()(const f32x4 (&acc)[2][2][4][2], const Unit& u, int wr, int wc, int fr_, int fq_) const {
        int ln_; asm volatile("v_mbcnt_lo_u32_b32 %0, -1, 0\n\tv_mbcnt_hi_u32_b32 %0, -1, %0" : "=v"(ln_)); const int fr = ln_ & 15, fq = ln_ >> 4;
        const int colg = u.pn * 128 + wc * 32 + fq * 8;
#pragma unroll
        for (int ai = 0; ai < 2; ++ai) {
            const int g0 = u.pm * UP_TROWS + (2 * ai + wr) * 62 - 2 + 4 * fr;
            float rs[4];
#pragma unroll
            for (int m = 0; m < 4; ++m) {
                int g = g0 + m; g = g < 0 ? 0 : g;
                const f32x4* p = (const f32x4*)(rsq2 + (size_t)g * 16);
                const f32x4 s0 = p[0], s1 = p[1], s2 = p[2], s3 = p[3];
                const float s = ((s0[0] + s0[1]) + (s0[2] + s0[3])) + ((s1[0] + s1[1]) + (s1[2] + s1[3])) + ((s2[0] + s2[1]) + (s2[2] + s2[3])) + ((s3[0] + s3[1]) + (s3[2] + s3[3]));
                rs[m] = rsqrtf(s * (1.0f / DM) + EPS);
                asm volatile("" : "+v"(rs[m]));
                __builtin_amdgcn_sched_barrier(0);
            }
#pragma unroll
            for (int n = 0; n < 2; ++n) {
                const int col = colg + 4 * n;
                f32x4 w[2][3];
#pragma unroll
                for (int bj = 0; bj < 2; ++bj)
#pragma unroll
                    for (int k = 0; k < 3; ++k) w[bj][k] = *(const f32x4*)(cw + (size_t)k * NUP + bj * DFF + col);
#pragma unroll
                for (int m = 0; m < 4; ++m) {
                    const int g = g0 + m;
                    const bool vout = (4 * fr + m >= 2) && (g < MREAL);
                    const RowInfo ri = rowinfo(g < 0 ? 0 : g);
                    float y[2][4];
#pragma unroll
                    for (int bj = 0; bj < 2; ++bj) {
                        float cur[4], p1[4], p2[4];
#pragma unroll
                        for (int i = 0; i < 4; ++i) {
                            cur[i] = acc[ai][bj][m][n][i] * rs[m];
                            p1[i] = m >= 1 ? acc[ai][bj][m >= 1 ? m - 1 : 0][n][i] * rs[m >= 1 ? m - 1 : 0] : dpp_shr1(acc[ai][bj][3][n][i] * rs[3]);
                            p2[i] = m >= 2 ? acc[ai][bj][m >= 2 ? m - 2 : 0][n][i] * rs[m >= 2 ? m - 2 : 0] : dpp_shr1(acc[ai][bj][m == 0 ? 2 : 3][n][i] * rs[m == 0 ? 2 : 3]);
                        }
                        if (ri.t < 2) {
                            f32x4 S0 = {0.f, 0.f, 0.f, 0.f}, S1 = {0.f, 0.f, 0.f, 0.f};
                            if (ri.samp && ri.idx < NSB) { S0 = *(const f32x4*)(stf + (size_t)(ri.idx * 2 + 0) * NUP + bj * DFF + col); S1 = *(const f32x4*)(stf + (size_t)(ri.idx * 2 + 1) * NUP + bj * DFF + col); }
#pragma unroll
                            for (int i = 0; i < 4; ++i) { if (ri.t == 0) { p1[i] = S1[i]; p2[i] = S0[i]; } else { p2[i] = S1[i]; } }
                        }
                        if (vout && ri.t >= ri.len - 2) {
                            float* d = out + (ri.samp ? O_SCF : O_PCF) + (size_t)(ri.idx * 2 + (ri.t - (ri.len - 2))) * NUP + bj * DFF + col;
                            *(f32x4*)(d) = (f32x4){cur[0], cur[1], cur[2], cur[3]};
                        }
#pragma unroll
                        for (int i = 0; i < 4; ++i) y[bj][i] = w[bj][0][i] * p2[i] + w[bj][1][i] * p1[i] + w[bj][2][i] * cur[i];
                    }
                    if (vout) {
                        u32x2 pk; pk.x = cvt_pk_bf16(silu_f(y[0][0]) * y[1][0], silu_f(y[0][1]) * y[1][1]); pk.y = cvt_pk_bf16(silu_f(y[0][2]) * y[1][2], silu_f(y[0][3]) * y[1][3]);
                        *(u32x2*)(act + (size_t)g * DFF + col) = pk;
                    }
                    __builtin_amdgcn_sched_barrier(0);
                }
            }
        }
    }
};

#define XB_TMO      128
#define XB_XCNT(j)  (256  + 64 * (j))
#define XB_XSUB(j)  (1280 + 64 * (j))
#define XB_XGEN(j)  (2304 + 64 * (j))
#define XB_TOP      3328
#define XB_TOPGEN   3392
#define XCD_BAR_WORDS 3456
#define XB_SPIN_CAP (1u << 20)
__device__ __forceinline__ unsigned xb_ld(unsigned* p)              { return __hip_atomic_load(p, __ATOMIC_RELAXED, __HIP_MEMORY_SCOPE_AGENT); }
__device__ __forceinline__ unsigned xb_add(unsigned* p, unsigned v) { return __hip_atomic_fetch_add(p, v, __ATOMIC_RELAXED, __HIP_MEMORY_SCOPE_AGENT); }
__device__ __forceinline__ unsigned xb_xcc_id() { return (unsigned)__builtin_amdgcn_s_getreg((3 << 11) | 20) & 0xFu; }
#define XB_SPIN(cond, bar) do { unsigned _sp = 0; while (cond) { __builtin_amdgcn_s_sleep(1); \
    if ((++_sp & 255u) == 0u) { if (xb_ld(&(bar)[XB_TMO])) break; if (_sp > XB_SPIN_CAP) { atomicAdd(&(bar)[XB_TMO], 1u); break; } } } } while (0)
struct XcdBarrier { unsigned* bar; unsigned x; volatile LAS unsigned* st; };
__device__ __forceinline__ XcdBarrier xcd_barrier_post(unsigned* bar, volatile LAS unsigned* st) {
    XcdBarrier b; b.bar = bar; b.x = xb_xcc_id(); b.st = st;
    if (threadIdx.x == 0) (void)xb_add(&bar[XB_XCNT(b.x)], 1u);
    return b;
}
__device__ __forceinline__ void xcd_barrier_complete(unsigned* bar, unsigned x, unsigned& nloc, unsigned& nx) {
    const unsigned G = gridDim.x * gridDim.y * gridDim.z;
    unsigned sum, cnt, mine, sp = 0u;
    for (;;) {
        sum = 0u; cnt = 0u; mine = 0u;
#pragma unroll
        for (unsigned j = 0; j < 16; ++j) { const unsigned c = xb_ld(&bar[XB_XCNT(j)]); sum += c; cnt += (c > 0u) ? 1u : 0u; mine = (j == x) ? c : mine; }
        if (sum == G) break;
        __builtin_amdgcn_s_sleep(1);
        if ((++sp & 255u) == 0u) { if (xb_ld(&bar[XB_TMO])) break; if (sp > XB_SPIN_CAP) { atomicAdd(&bar[XB_TMO], 1u); break; } }
    }
    nloc = mine > 0u ? mine : 1u; nx = cnt > 0u ? cnt : 1u;
}
__device__ __forceinline__ void xcd_barrier(const XcdBarrier& b) {
    asm volatile("s_waitcnt vmcnt(0)" ::: "memory");
    __syncthreads();
    if (threadIdx.x == 0) {
        unsigned* bar = b.bar;
        __builtin_amdgcn_s_waitcnt(0);
        unsigned nloc = b.st[0], nx = b.st[1];
        if (nloc == 0u) { xcd_barrier_complete(bar, b.x, nloc, nx); b.st[0] = nloc; b.st[1] = nx; }
        const unsigned old = xb_add(&bar[XB_XSUB(b.x)], 1u);
        const unsigned gen = old / nloc;
        if (old + 1u == (gen + 1u) * nloc) {
            __builtin_amdgcn_fence(__ATOMIC_RELEASE, "agent");
            asm volatile("s_waitcnt vmcnt(0)" ::: "memory");
            const unsigned og = xb_add(&bar[XB_TOP], 1u);
            const unsigned tg = og / nx;
            if (og + 1u == (tg + 1u) * nx) xb_add(&bar[XB_TOPGEN], 1u);
            else XB_SPIN(xb_ld(&bar[XB_TOPGEN]) == tg, bar);
            __builtin_amdgcn_fence(__ATOMIC_ACQUIRE, "agent");
            xb_add(&bar[XB_XGEN(b.x)], 1u);
            asm volatile("s_waitcnt vmcnt(0)" ::: "memory");
        } else {
            XB_SPIN(xb_ld(&bar[XB_XGEN(b.x)]) == gen, bar);
            __builtin_amdgcn_fence(__ATOMIC_ACQUIRE, "agent");
            asm volatile("s_waitcnt vmcnt(0)" ::: "memory");
        }
    }
    __syncthreads();
}

struct Frame {
    LAS unsigned char* lds;
    int tid, lane, wave, G, blk;
    const float* in[20];
    float* out; unsigned char* ws;
};

__device__ __forceinline__ void p0_transpose_item(const float* W, int ldw, int K, bf16_t* WT, int n0, int srcn0, int k0, const float* kscale, LAS float* scr, int lane) {
#pragma unroll 8
    for (int i = 0; i < 32; ++i) { const int kk = 2 * i + (lane >> 5); float v = W[(size_t)(k0 + kk) * ldw + srcn0 + (lane & 31)]; if (kscale) v *= kscale[k0 + kk]; scr[kk * 33 + (lane & 31)] = v; }
    LDS_WAIT(); asm volatile("" ::: "memory");
    const int c = lane & 7;
#pragma unroll
    for (int j = 0; j < 4; ++j) { const int n = (lane >> 3) + 8 * j; const LAS float* s = scr + (8 * c) * 33 + n;
        u32x4 o; o.x = cvt_pk_bf16(s[0 * 33], s[1 * 33]); o.y = cvt_pk_bf16(s[2 * 33], s[3 * 33]); o.z = cvt_pk_bf16(s[4 * 33], s[5 * 33]); o.w = cvt_pk_bf16(s[6 * 33], s[7 * 33]);
        *(u32x4*)(WT + (size_t)(n0 + n) * K + k0 + 8 * c) = o; }
    LDS_WAIT(); asm volatile("" ::: "memory");
}
__device__ __forceinline__ int in_colmap(int n0) {
    const int pn = n0 >> 8;
    if (pn >= 4) return n0;
    const int c = n0 & 255, bj = c >> 7, cc = c & 127, hl = cc >> 6, j = cc & 63;
    return (pn >= 2 ? 512 : 0) + ((pn & 1) * 2 + hl) * 128 + bj * 64 + j;
}
__device__ __forceinline__ void p0_prologue(Frame& F) {
    const float* w_in = F.in[8]; const float* w_out = F.in[14]; const float* w_up = F.in[16]; const float* w_dn = F.in[18];
    bf16_t* WIN = (bf16_t*)(F.ws + WS_WIN); bf16_t* WOUT = (bf16_t*)(F.ws + WS_WOUT); bf16_t* WUP = (bf16_t*)(F.ws + WS_WUP); bf16_t* WDN = (bf16_t*)(F.ws + WS_WDN);
    LAS float* scr = (LAS float*)(F.lds + F.wave * 8448);
    LAS float* WX = (LAS float*)(F.lds + 69632);
    for (int i = F.tid; i < 1024 * 8; i += 512) WX[i] = w_in[(size_t)(i >> 3) * INW + NIN + (i & 7)];
    const int gw = F.blk * 8 + F.wave, NGW = F.G * 8;
    constexpr int I_IN = 16 * 128, I_OUT = 16 * 32, I_UP = 16 * 176, I_DN = 44 * 32, NIT = I_IN + I_OUT + I_UP + I_DN;
    for (int it = gw; it < NIT; it += NGW) {
        int r = it;
        if (r < I_IN) { const int kb = r / 128, nb = r % 128; p0_transpose_item(w_in, INW, 1024, WIN, nb * 32, in_colmap(nb * 32), kb * 64, nullptr, scr, F.lane); continue; } r -= I_IN;
        if (r < I_OUT) { const int kb = r / 32, nb = r % 32; p0_transpose_item(w_out, 1024, 1024, WOUT, nb * 32, nb * 32, kb * 64, nullptr, scr, F.lane); continue; } r -= I_OUT;
        if (r < I_UP) { const int kb = r / 176, nb = r % 176; const int n0 = nb * 32, pn = n0 >> 8, c = n0 & 255; p0_transpose_item(w_up, NUP, 1024, WUP, n0, (c >> 7) * DFF + pn * 128 + (c & 127), kb * 64, F.in[15], scr, F.lane); continue; } r -= I_UP;
        { const int kb = r / 32, nb = r % 32; p0_transpose_item(w_dn, 1024, DFF, WDN, nb * 32, nb * 32, kb * 64, nullptr, scr, F.lane); }
    }
    __syncthreads();
    bf16_t* H = (bf16_t*)(F.ws + WS_H); float* BG = (float*)(F.ws + WS_BG);
    const float* nm = F.in[7];
    for (int g = gw; g < MPAD; g += NGW) {
        unsigned long long* o8 = (unsigned long long*)(H + (size_t)g * DM) + F.lane;
        if (g >= MREAL) {
#pragma unroll
            for (int j = 0; j < 4; ++j) o8[64 * j] = 0ull;
            continue;
        }
        const f32x4* xr = (const f32x4*)x_src_row(F.in[0], F.in[1], F.in[6], g) + F.lane;
        const f32x4* nr = (const f32x4*)nm + F.lane;
        f32x4 v[4]; float ss = 0.f;
#pragma unroll
        for (int j = 0; j < 4; ++j) { v[j] = xr[64 * j]; ss += (v[j][0] * v[j][0] + v[j][1] * v[j][1]) + (v[j][2] * v[j][2] + v[j][3] * v[j][3]); }
        const float rstd = rsqrtf(wave_sum(ss) * (1.0f / DM) + EPS);
        float ex[8];
#pragma unroll
        for (int e = 0; e < 8; ++e) ex[e] = 0.f;
#pragma unroll
        for (int j = 0; j < 4; ++j) {
            const f32x4 n4 = nr[64 * j];
            v[j] = v[j] * rstd * n4;
            o8[64 * j] = (unsigned long long)cvt_pk_bf16(v[j][0], v[j][1]) | ((unsigned long long)cvt_pk_bf16(v[j][2], v[j][3]) << 32);
#pragma unroll
            for (int i = 0; i < 4; ++i) {
                const int k = 4 * (F.lane + 64 * j) + i;
                const f32x4 wa = *(const LAS f32x4*)(WX + k * 8), wb = *(const LAS f32x4*)(WX + k * 8 + 4);
                ex[0] += v[j][i] * wa[0]; ex[1] += v[j][i] * wa[1]; ex[2] += v[j][i] * wa[2]; ex[3] += v[j][i] * wa[3];
                ex[4] += v[j][i] * wb[0]; ex[5] += v[j][i] * wb[1]; ex[6] += v[j][i] * wb[2]; ex[7] += v[j][i] * wb[3];
            }
        }
#pragma unroll
        for (int e = 0; e < 8; ++e) ex[e] = wave_sum(ex[e]);
        if (F.lane < 4) {
            const int h = F.lane;
            const float gb = h == 0 ? ex[0] : h == 1 ? ex[1] : h == 2 ? ex[2] : ex[3];
            const float ga = h == 0 ? ex[4] : h == 1 ? ex[5] : h == 2 ? ex[6] : ex[7];
            const float beta = 1.0f / (1.0f + __expf(-gb));
            const float xx = ga + F.in[11][h];
            const float sp = xx > 20.f ? xx : log1pf(__expf(xx));
            BG[(size_t)g * 8 + h] = beta;
            BG[(size_t)g * 8 + 4 + h] = -__expf(F.in[10][h]) * sp;
        }
    }
    {
        bf16_t* PGX = (bf16_t*)(F.ws + WS_PGX); const float* stq = F.in[4];
        for (int e = F.blk * 512 + F.tid; e < 385 * GQKV; e += F.G * 512) PGX[e] = e < 384 * GQKV ? (bf16_t)(cvt_pk_bf16(stq[e], 0.f) & 0xffffu) : (bf16_t)0;
    }
    float* ROT = (float*)(F.ws + WS_ROT);
    for (int e = F.blk * 512 + F.tid; e < 2068 * 64; e += F.G * 512) {
        const int p = e >> 6, j = e & 63; const int pos = p < LP ? p : 16384 + (p - LP);
        double f = 1.0, b = 0.8659643233600653523531691834202299819398;
#pragma unroll
        for (int k = 0; k < 6; ++k) { if ((j >> k) & 1) f *= b; b *= b; }
        double rev = (double)pos * f * 0.15915494309189533576888376337251436203445964574046;
        rev -= floor(rev);
        const float rf = (float)rev;
        ROT[(size_t)e * 2] = __builtin_amdgcn_cosf(rf); ROT[(size_t)e * 2 + 1] = __builtin_amdgcn_sinf(rf);
    }
}

struct SeqD { int row0, len, samp, idx; };
__device__ __forceinline__ bf16x8 mk8(s16x4 lo, s16x4 hi) { return (bf16x8){lo[0], lo[1], lo[2], lo[3], hi[0], hi[1], hi[2], hi[3]}; }
__device__ __forceinline__ s16x4 ld_tr(LAS unsigned char* p) { return __builtin_bit_cast(s16x4, __builtin_amdgcn_ds_read_tr16_b64_v4i16((LAS s16x4*)p)); }
__device__ __forceinline__ s16x4 ld_b64(LAS unsigned char* p) { return *(LAS s16x4*)p; }
__device__ __forceinline__ s16x4 pk4(f32x4 v) { u32x2 w; w.x = cvt_pk_bf16(v[0], v[1]); w.y = cvt_pk_bf16(v[2], v[3]); return __builtin_bit_cast(s16x4, w); }

__device__ __forceinline__ void p2a_item(Frame& F, const SeqD sq, int h, int t0, int c, unsigned char* slot) {
    unsigned lbase = (unsigned)(uintptr_t)F.lds; int tid = F.tid;
    asm volatile("" : "+s"(lbase), "+v"(tid));
    LAS unsigned char* L = (LAS unsigned char*)(uintptr_t)lbase;
    LAS float* AM = (LAS float*)(L); LAS float* RHS = (LAS float*)(L + 53248);
    LAS float* GL = (LAS float*)(L + 16384); LAS float* CUM = GL + 64; LAS float* BETA = GL + 128;
    LAS unsigned char* QB = L + 20480; LAS unsigned char* KB = L + 36864;
    const float* BG = (const float*)(F.ws + WS_BG);
    const float* cgw = F.in[9];
    const int r = tid >> 3, cg = tid & 7, lane = tid & 63, w = __builtin_amdgcn_readfirstlane(tid >> 6), fr = lane & 15, fg = lane >> 4;
    const bool valid = r < c;
    const int grow = sq.row0 + t0 + r;
    float beta_r = 0.f, gdec = 0.f;
    if (valid) { beta_r = BG[(size_t)grow * 8 + h]; gdec = BG[(size_t)grow * 8 + 4 + h]; }
    if (cg == 0) GL[r] = gdec;
    LAS float* CW = (LAS float*)(L + 118784);
#pragma unroll
    for (int k = 0; k < 3; ++k) { const int e = tid + 512 * k, dt = e / 384, rem = e - dt * 384; CW[e] = cgw[(size_t)dt * GQKV + (rem >> 7) * 512 + h * 128 + (rem & 127)]; }
    __syncthreads();
    float cum = 0.f, cl = 0.f;
#pragma unroll 8
    for (int j = 0; j < 64; ++j) { const float gj = GL[j]; cl += gj; if (j <= r) cum += gj; }
    const float er = __expf(cum), frr = __expf(cl - cum);
    if (cg == 0) { CUM[r] = cum; BETA[r] = beta_r; }
    if (tid == 0) *(float*)(slot + 73728) = __expf(cl);
#pragma unroll 1
    for (int X = 0; X < 3; ++X) {
        const int colb = X * 512 + h * 128 + 16 * cg;
        float y[16];
#pragma unroll
        for (int i = 0; i < 16; ++i) y[i] = 0.f;
        u32x4 da[4], db[4];
#pragma unroll
        for (int dt = 0; dt < 4; ++dt) {
            const int tt = t0 + r - 3 + dt;
            const unsigned oz = (unsigned)(WS_PGX + ((size_t)384 * GQKV + colb) * 2);
            const unsigned opg = (unsigned)(WS_PG + ((size_t)(sq.row0 + (tt >= 0 ? tt : 0)) * 2048 + colb) * 2);
            const unsigned opx = (unsigned)(WS_PGX + ((size_t)(sq.idx * 3 + (tt < 0 ? 3 + tt : 0)) * GQKV + colb) * 2);
            const unsigned so = valid ? (tt >= 0 ? opg : (sq.samp ? opx : oz)) : oz;
            const u32x4* sp = (const u32x4*)(F.ws + so);
            da[dt] = sp[0]; db[dt] = sp[1];
        }
#pragma unroll
        for (int dt = 0; dt < 4; ++dt) {
            const u32x4 a = da[dt], b = db[dt];
            const float xv[16] = {bflo(a.x), bfhi(a.x), bflo(a.y), bfhi(a.y), bflo(a.z), bfhi(a.z), bflo(a.w), bfhi(a.w), bflo(b.x), bfhi(b.x), bflo(b.y), bfhi(b.y), bflo(b.z), bfhi(b.z), bflo(b.w), bfhi(b.w)};
            const LAS f32x4* wp = (const LAS f32x4*)(CW + dt * 384 + X * 128 + 16 * cg);
#pragma unroll
            for (int k = 0; k < 4; ++k) { const f32x4 wv = wp[k]; y[4 * k] += wv[0] * xv[4 * k]; y[4 * k + 1] += wv[1] * xv[4 * k + 1]; y[4 * k + 2] += wv[2] * xv[4 * k + 2]; y[4 * k + 3] += wv[3] * xv[4 * k + 3]; }
        }
        float ss = 0.f;
#pragma unroll
        for (int i = 0; i < 16; ++i) { y[i] = valid ? silu_f(y[i]) : 0.f; ss += y[i] * y[i]; }
        ss += __shfl_xor(ss, 1); ss += __shfl_xor(ss, 2); ss += __shfl_xor(ss, 4);
        const float nrm = X == 0 ? rsqrtf(ss + EPS) * 0.08838834764831845f : (X == 1 ? rsqrtf(ss + EPS) : 1.0f);
        u32x4 p0, p1;
        p0.x = cvt_pk_bf16(y[0] * nrm, y[1] * nrm); p0.y = cvt_pk_bf16(y[2] * nrm, y[3] * nrm); p0.z = cvt_pk_bf16(y[4] * nrm, y[5] * nrm); p0.w = cvt_pk_bf16(y[6] * nrm, y[7] * nrm);
        p1.x = cvt_pk_bf16(y[8] * nrm, y[9] * nrm); p1.y = cvt_pk_bf16(y[10] * nrm, y[11] * nrm); p1.z = cvt_pk_bf16(y[12] * nrm, y[13] * nrm); p1.w = cvt_pk_bf16(y[14] * nrm, y[15] * nrm);
        const float z[16] = {bflo(p0.x), bfhi(p0.x), bflo(p0.y), bfhi(p0.y), bflo(p0.z), bfhi(p0.z), bflo(p0.w), bfhi(p0.w), bflo(p1.x), bfhi(p1.x), bflo(p1.y), bfhi(p1.y), bflo(p1.z), bfhi(p1.z), bflo(p1.w), bfhi(p1.w)};
        if (X < 2) {
            LAS unsigned char* dstl = (X == 0 ? QB : KB) + r * 256;
            *(LAS u32x4*)(dstl + (((2 * cg) ^ (r & 15)) * 16)) = p0; *(LAS u32x4*)(dstl + (((2 * cg + 1) ^ (r & 15)) * 16)) = p1;
            const float sc = X == 0 ? er : frr;
            u32x4 d0, d1;
            d0.x = cvt_pk_bf16(z[0] * sc, z[1] * sc); d0.y = cvt_pk_bf16(z[2] * sc, z[3] * sc); d0.z = cvt_pk_bf16(z[4] * sc, z[5] * sc); d0.w = cvt_pk_bf16(z[6] * sc, z[7] * sc);
            d1.x = cvt_pk_bf16(z[8] * sc, z[9] * sc); d1.y = cvt_pk_bf16(z[10] * sc, z[11] * sc); d1.z = cvt_pk_bf16(z[12] * sc, z[13] * sc); d1.w = cvt_pk_bf16(z[14] * sc, z[15] * sc);
            if (X == 0) { *(u32x4*)(slot + 16384 + r * 256 + (((2 * cg) ^ (r & 15)) * 16)) = d0; *(u32x4*)(slot + 16384 + r * 256 + (((2 * cg + 1) ^ (r & 15)) * 16)) = d1; }
            else { u32x4* gd = (u32x4*)(slot + 32768 + r * 256 + ((cg ^ (r & 7)) * 32)); gd[0] = d0; gd[1] = d1; }
        }
        if (X >= 1) {
            const float sc = X == 1 ? beta_r * er : beta_r;
            LAS float* rd = RHS + r * 256 + (X == 1 ? 128 : 0) + 16 * cg;
#pragma unroll
            for (int k = 0; k < 4; ++k) *(LAS f32x4*)(rd + 4 * k) = (f32x4){z[4 * k] * sc, z[4 * k + 1] * sc, z[4 * k + 2] * sc, z[4 * k + 3] * sc};
        }
    }
    __syncthreads();
    {
        bf16_t* QK = (bf16_t*)(slot + 49152);
#pragma unroll
        for (int rep = 0; rep < 2; ++rep) {
            const int idx = w + 8 * rep, it = idx >> 2, jt = idx & 3;
            const int jcol = 16 * jt + fr;
            if (it >= jt) {
                f32x4 akk = {0.f, 0.f, 0.f, 0.f}, aqk = {0.f, 0.f, 0.f, 0.f};
#pragma unroll
                for (int s = 0; s < 4; ++s) {
                    const int ri = 16 * it + fr, rj = 16 * jt + fr;
                    const bf16x8 bk = *(LAS bf16x8*)(KB + rj * 256 + (((4 * s + fg) ^ (rj & 15)) * 16));
                    const bf16x8 ak = *(LAS bf16x8*)(KB + ri * 256 + (((4 * s + fg) ^ (ri & 15)) * 16));
                    const bf16x8 aq = *(LAS bf16x8*)(QB + ri * 256 + (((4 * s + fg) ^ (ri & 15)) * 16));
                    akk = __builtin_amdgcn_mfma_f32_16x16x32_bf16(ak, bk, akk, 0, 0, 0);
                    aqk = __builtin_amdgcn_mfma_f32_16x16x32_bf16(aq, bk, aqk, 0, 0, 0);
                }
                const float cj = CUM[jcol];
#pragma unroll
                for (int rr = 0; rr < 4; ++rr) {
                    const int i_ = 16 * it + 4 * fg + rr;
                    const float dec = i_ >= jcol ? __expf(CUM[i_] - cj) : 0.f;
                    AM[i_ * 64 + jcol] = i_ > jcol ? BETA[i_] * akk[rr] * dec : 0.f;
                    QK[i_ * 64 + ((((jcol >> 3) ^ ((i_ >> 1) & 7)) << 3) | (jcol & 7))] = (bf16_t)(cvt_pk_bf16(aqk[rr] * dec, 0.f) & 0xffffu);
                }
            } else {
#pragma unroll
                for (int rr = 0; rr < 4; ++rr) { const int i_ = 16 * it + 4 * fg + rr; QK[i_ * 64 + ((((jcol >> 3) ^ ((i_ >> 1) & 7)) << 3) | (jcol & 7))] = 0; }
            }
        }
    }
    __syncthreads();
    {
        const int col = tid >> 1, hh = tid & 1;
        unsigned amo = (unsigned)(uintptr_t)AM + hh * 16u, r0 = (unsigned)(uintptr_t)RHS + col * 4u + hh * 4096u, r1 = (unsigned)(uintptr_t)RHS + col * 4u - hh * 4096u;
        asm volatile("" : "+v"(amo), "+v"(r0), "+v"(r1));
        LAS unsigned char* amb = (LAS unsigned char*)(uintptr_t)amo; LAS unsigned char* rb0 = (LAS unsigned char*)(uintptr_t)r0; LAS unsigned char* rb1 = (LAS unsigned char*)(uintptr_t)r1;
        float xs[64];
#pragma unroll
        for (int k = 0; k < 64; ++k) xs[k] = (k & 4) ? *(LAS float*)(rb1 + k * 1024) : *(LAS float*)(rb0 + k * 1024);
#pragma unroll
        for (int i = 1; i < 64; ++i) {
            float a0 = 0.f, a1 = 0.f;
#pragma unroll
            for (int q = 0; q < 8; ++q) {
                if (8 * q < i) { const f32x4 cq = *(LAS f32x4*)(amb + i * 256 + q * 32); a0 += cq[0] * xs[8 * q]; a1 += cq[1] * xs[8 * q + 1]; a0 += cq[2] * xs[8 * q + 2]; a1 += cq[3] * xs[8 * q + 3]; }
            }
            float a = a0 + a1;
            a += __int_as_float(__builtin_amdgcn_update_dpp(0, __float_as_int(a), 0xB1, 0xf, 0xf, true));
            const float v = (hh ? xs[i ^ 4] : xs[i]) - a;
            xs[i] = hh ? xs[i] : v; xs[i ^ 4] = hh ? v : xs[i ^ 4];
            asm volatile("" ::: "memory");
        }
        unsigned char* rowp = col < 128 ? slot + 57344 + col * 128 : slot + (col - 128) * 128;
        const int wsw = col < 128 ? 0 : (((col - 128) >> 1) & 3);
#pragma unroll
        for (int k = 0; k < 4; ++k) {
            u32x4* dst = (u32x4*)(rowp + (((2 * hh + (k >> 1)) ^ wsw) * 32) + (k & 1) * 16);
            const int e = 8 * k;
            u32x4 o;
            o.x = cvt_pk_bf16(hh ? xs[(32 + e) ^ 4] : xs[e], hh ? xs[(33 + e) ^ 4] : xs[e + 1]); o.y = cvt_pk_bf16(hh ? xs[(34 + e) ^ 4] : xs[e + 2], hh ? xs[(35 + e) ^ 4] : xs[e + 3]);
            o.z = cvt_pk_bf16(hh ? xs[(36 + e) ^ 4] : xs[e + 4], hh ? xs[(37 + e) ^ 4] : xs[e + 5]); o.w = cvt_pk_bf16(hh ? xs[(38 + e) ^ 4] : xs[e + 6], hh ? xs[(39 + e) ^ 4] : xs[e + 7]);
            *dst = o;
        }
    }
    __syncthreads();
}

constexpr int OS_PITCH = 132;
__device__ __forceinline__ void os_write(LAS unsigned char* OSb, const f32x4 (&o)[4], int w, int fr, int fg) {
    LAS float* OS = (LAS float*)OSb;
#pragma unroll
    for (int mt = 0; mt < 4; ++mt)
#pragma unroll
        for (int rr = 0; rr < 4; ++rr) OS[(16 * mt + 4 * fg + rr) * OS_PITCH + 16 * w + fr] = o[mt][rr];
}
template <int MODE  >
__device__ __forceinline__ void os_finish(LAS unsigned char* OSb, int tid, int h, int grow0, int c, const f32x4 (&nwv)[4], u32x4 ga, u32x4 gb, bf16_t* mix) {
    LAS float* OS = (LAS float*)OSb;
    const int r = tid >> 3, cg = tid & 7;
    f32x4 v[4];
#pragma unroll
    for (int k = 0; k < 4; ++k) v[k] = *(LAS f32x4*)(OS + r * OS_PITCH + 16 * cg + 4 * k);
    float rstd;
    if (MODE == 0) {
        float s = 0.f;
#pragma unroll
        for (int k = 0; k < 4; ++k) s += (v[k][0] + v[k][1]) + (v[k][2] + v[k][3]);
        s += __shfl_xor(s, 1); s += __shfl_xor(s, 2); s += __shfl_xor(s, 4);
        const float mu = s * (1.0f / 128.0f);
        float q = 0.f;
#pragma unroll
        for (int k = 0; k < 4; ++k) { v[k] = v[k] - mu; q += (v[k][0] * v[k][0] + v[k][1] * v[k][1]) + (v[k][2] * v[k][2] + v[k][3] * v[k][3]); }
        q += __shfl_xor(q, 1); q += __shfl_xor(q, 2); q += __shfl_xor(q, 4);
        rstd = rsqrtf(q * (1.0f / 128.0f) + EPS);
    } else {
        float q = 0.f;
#pragma unroll
        for (int k = 0; k < 4; ++k) q += (v[k][0] * v[k][0] + v[k][1] * v[k][1]) + (v[k][2] * v[k][2] + v[k][3] * v[k][3]);
        q += __shfl_xor(q, 1); q += __shfl_xor(q, 2); q += __shfl_xor(q, 4);
        rstd = rsqrtf(q * (1.0f / 128.0f) + EPS);
    }
    if (r < c) {
        const float gt[16] = {bflo(ga.x), bfhi(ga.x), bflo(ga.y), bfhi(ga.y), bflo(ga.z), bfhi(ga.z), bflo(ga.w), bfhi(ga.w), bflo(gb.x), bfhi(gb.x), bflo(gb.y), bfhi(gb.y), bflo(gb.z), bfhi(gb.z), bflo(gb.w), bfhi(gb.w)};
        float y[16];
#pragma unroll
        for (int k = 0; k < 4; ++k)
#pragma unroll
            for (int i = 0; i < 4; ++i) y[4 * k + i] = v[k][i] * rstd * nwv[k][i] * gt[4 * k + i];
        u32x4 o0, o1;
        o0.x = cvt_pk_bf16(y[0], y[1]); o0.y = cvt_pk_bf16(y[2], y[3]); o0.z = cvt_pk_bf16(y[4], y[5]); o0.w = cvt_pk_bf16(y[6], y[7]);
        o1.x = cvt_pk_bf16(y[8], y[9]); o1.y = cvt_pk_bf16(y[10], y[11]); o1.z = cvt_pk_bf16(y[12], y[13]); o1.w = cvt_pk_bf16(y[14], y[15]);
        u32x4* mp = (u32x4*)(mix + (size_t)(grow0 + r) * DM + (MODE == 0 ? 0 : 512) + h * 128 + 16 * cg);
        mp[0] = o0; mp[1] = o1;
    }
}

__device__ __forceinline__ void make_sb(const f32x4 (&S)[8], bf16x8 (&Sb)[4]) {
#pragma unroll
    for (int s = 0; s < 4; ++s) Sb[s] = mk8(pk4(S[2 * s]), pk4(S[2 * s + 1]));
}
__device__ __forceinline__ void chunk_of(const SeqD& sq, int n, int& t0, int& c) { if (sq.samp) { t0 = 0; c = 4; } else if (n == 0) { t0 = 0; c = 16; } else { t0 = 16 + 64 * (n - 1); c = 64; } }
constexpr int SCAN_BUF = 57344;

__device__ __forceinline__ void scan_gdn(Frame& F, const SeqD sq, int h, int nchunks, const unsigned char* slot0, const float* sinit, float* sfinal) {
    unsigned lbase = (unsigned)(uintptr_t)F.lds; int tid = F.tid;
    asm volatile("" : "+s"(lbase), "+v"(tid));
    LAS unsigned char* L = (LAS unsigned char*)(uintptr_t)lbase;
    const int lane = tid & 63, w = __builtin_amdgcn_readfirstlane(tid >> 6), fr = lane & 15, fg = lane >> 4;
    const bf16_t* PG = (const bf16_t*)(F.ws + WS_PG);
    bf16_t* mix = (bf16_t*)((unsigned char*)F.out + OS_MIX);
    f32x4 nwv[4];
#pragma unroll
    for (int k = 0; k < 4; ++k) nwv[k] = *(const f32x4*)(F.in[13] + 16 * (tid & 7) + 4 * k);
    f32x4 S[8]; bf16x8 Sb[4];
#pragma unroll
    for (int t = 0; t < 8; ++t) {
        if (sinit) { S[t] = (f32x4){sinit[(16 * t + 4 * fg + 0) * 128 + 16 * w + fr], sinit[(16 * t + 4 * fg + 1) * 128 + 16 * w + fr], sinit[(16 * t + 4 * fg + 2) * 128 + 16 * w + fr], sinit[(16 * t + 4 * fg + 3) * 128 + 16 * w + fr]}; }
        else S[t] = (f32x4){0.f, 0.f, 0.f, 0.f};
    }
    make_sb(S, Sb);
    const int uoff = 57344 + ((16 * w + fr) * 64 + 4 * fg) * 2;
    u32x4 R[7]; u32x2 ur[4];
#pragma unroll
    for (int p = 0; p < 7; ++p) R[p] = ((const u32x4*)slot0)[p * 512 + tid];
#pragma unroll
    for (int mt = 0; mt < 4; ++mt) ur[mt] = *(const u32x2*)(slot0 + uoff + 32 * mt);
    float cdn = *(const float*)(slot0 + 73728);
#pragma unroll
    for (int p = 0; p < 7; ++p) ((LAS u32x4*)L)[p * 512 + tid] = R[p];
    __syncthreads();
    unsigned accA = 0, accB = 0, accC = 0;
    for (int n = 0; n < nchunks; ++n) {
        const unsigned tq0 = MK_TPROBE ? (unsigned)__builtin_amdgcn_s_memrealtime() : 0u;
        const unsigned char* img = slot0 + (size_t)n * SLOT;
        LAS unsigned char* Bc = L + (n & 1) * SCAN_BUF; LAS unsigned char* Bn = L + ((n & 1) ^ 1) * SCAN_BUF;
        int lane_ = lane; asm volatile("" : "+v"(lane_));
        const int fr = lane_ & 15, fg = lane_ >> 4;
        int t0, c; chunk_of(sq, n, t0, c);
        const float cd = cdn;
        const bool more = n + 1 < nchunks;
        f32x4 u[4];
#pragma unroll
        for (int mt = 0; mt < 4; ++mt) u[mt] = (f32x4){bflo(ur[mt].x), bfhi(ur[mt].x), bflo(ur[mt].y), bfhi(ur[mt].y)};
        if (more) {
#pragma unroll
            for (int p = 0; p < 7; ++p) R[p] = ((const u32x4*)(img + SLOT))[p * 512 + tid];
#pragma unroll
            for (int mt = 0; mt < 4; ++mt) ur[mt] = *(const u32x2*)(img + SLOT + uoff + 32 * mt);
            cdn = *(const float*)(img + SLOT + 73728);
        }
        u32x4 ga = {0u, 0u, 0u, 0u}, gb = ga;
        if ((tid >> 3) < c) { const u32x4* gp = (const u32x4*)(PG + (size_t)(sq.row0 + t0 + (tid >> 3)) * 2048 + 1536 + h * 128 + 16 * (tid & 7)); ga = gp[0]; gb = gp[1]; }
        f32x4 wv[4];
#pragma unroll
        for (int mt = 0; mt < 4; ++mt) {
            f32x4 a = {0.f, 0.f, 0.f, 0.f};
#pragma unroll
            for (int s = 0; s < 4; ++s) {
                const int r0 = 32 * s + 4 * fg + (fr >> 2), r1 = r0 + 16;
                const s16x4 lo = ld_tr(Bc + r0 * 128 + ((mt ^ ((r0 >> 1) & 3)) * 32) + (fr & 3) * 8);
                const s16x4 hi = ld_tr(Bc + r1 * 128 + ((mt ^ ((r1 >> 1) & 3)) * 32) + (fr & 3) * 8);
                a = __builtin_amdgcn_mfma_f32_16x16x32_bf16(mk8(lo, hi), Sb[s], a, 0, 0, 0);
            }
            wv[mt] = u[mt] - a;
        }
        bf16x8 wb[2];
        wb[0] = mk8(pk4(wv[0]), pk4(wv[1])); wb[1] = mk8(pk4(wv[2]), pk4(wv[3]));
        f32x4 o[4];
#pragma unroll
        for (int mt = 0; mt < 4; ++mt) {
            f32x4 a = {0.f, 0.f, 0.f, 0.f};
            const int row = 16 * mt + fr;
#pragma unroll
            for (int s = 0; s < 4; ++s) {
                const s16x4 lo = ld_b64(Bc + 16384 + row * 256 + (((4 * s + (fg >> 1)) ^ fr) * 16) + (fg & 1) * 8);
                const s16x4 hi = ld_b64(Bc + 16384 + row * 256 + (((4 * s + 2 + (fg >> 1)) ^ fr) * 16) + (fg & 1) * 8);
                a = __builtin_amdgcn_mfma_f32_16x16x32_bf16(mk8(lo, hi), Sb[s], a, 0, 0, 0);
            }
#pragma unroll
            for (int s = 0; s < 2; ++s) {
                const s16x4 lo = ld_b64(Bc + 49152 + row * 128 + (((4 * s + (fg >> 1)) ^ ((row >> 1) & 7)) * 16) + (fg & 1) * 8);
                const s16x4 hi = ld_b64(Bc + 49152 + row * 128 + (((4 * s + 2 + (fg >> 1)) ^ ((row >> 1) & 7)) * 16) + (fg & 1) * 8);
                a = __builtin_amdgcn_mfma_f32_16x16x32_bf16(mk8(lo, hi), wb[s], a, 0, 0, 0);
            }
            o[mt] = a;
        }
#pragma unroll
        for (int t = 0; t < 8; ++t) {
            f32x4 a = S[t] * cd;
#pragma unroll
            for (int s = 0; s < 2; ++s) {
                const int r0 = 32 * s + 4 * fg + (fr >> 2), r1 = r0 + 16;
                const s16x4 lo = ld_tr(Bc + 32768 + r0 * 256 + ((t ^ (r0 & 7)) * 32) + (fr & 3) * 8);
                const s16x4 hi = ld_tr(Bc + 32768 + r1 * 256 + ((t ^ (r1 & 7)) * 32) + (fr & 3) * 8);
                a = __builtin_amdgcn_mfma_f32_16x16x32_bf16(mk8(lo, hi), wb[s], a, 0, 0, 0);
            }
            S[t] = a;
        }
        make_sb(S, Sb);
        const unsigned tq1 = MK_TPROBE ? (unsigned)__builtin_amdgcn_s_memrealtime() : 0u;
        __syncthreads();
        os_write(Bc, o, w, fr, fg);
        if (more) {
#pragma unroll
            for (int p = 0; p < 7; ++p) ((LAS u32x4*)Bn)[p * 512 + tid] = R[p];
        }
        __syncthreads();
        const unsigned tq2 = MK_TPROBE ? (unsigned)__builtin_amdgcn_s_memrealtime() : 0u;
        os_finish<1>(Bc, tid, h, sq.row0 + t0, c, nwv, ga, gb, mix);
        const unsigned tq3 = MK_TPROBE ? (unsigned)__builtin_amdgcn_s_memrealtime() : 0u;
        accA += tq1 - tq0; accB += tq2 - tq1; accC += tq3 - tq2;
    }
    if (MK_TPROBE && tid == 0 && nchunks > 1) { unsigned* TS = (unsigned*)(F.ws + WS_CTL) + CW_TS; TS[9 * 256 + F.blk] = accA; TS[10 * 256 + F.blk] = accB; TS[11 * 256 + F.blk] = accC; }
#pragma unroll
    for (int t = 0; t < 8; ++t)
#pragma unroll
        for (int rr = 0; rr < 4; ++rr) sfinal[(16 * t + 4 * fg + rr) * 128 + 16 * w + fr] = S[t][rr];
    __syncthreads();
}

__device__ __forceinline__ int swb(int row) { return ((row & 3) << 2) | ((row >> 2) & 3); }
__device__ __forceinline__ void scan_ret(Frame& F, const SeqD sq, int h, int nchunks, const float* sinit, float* sfinal) {
    unsigned lbase = (unsigned)(uintptr_t)F.lds; int tid = F.tid;
    asm volatile("" : "+s"(lbase), "+v"(tid));
    LAS unsigned char* L = (LAS unsigned char*)(uintptr_t)lbase;
    const int lane = tid & 63, w = __builtin_amdgcn_readfirstlane(tid >> 6), fr = lane & 15, fg = lane >> 4;
    const bf16_t* PR = (const bf16_t*)(F.ws + WS_PR);
    bf16_t* mix = (bf16_t*)((unsigned char*)F.out + OS_MIX);
    const float lg = h == 0 ? -0.04580368961312479f : h == 1 ? -0.02272007650008353f : h == 2 ? -0.011315313227834146f : -0.005646563141142063f;
    f32x4 nwv[4];
#pragma unroll
    for (int k = 0; k < 4; ++k) nwv[k] = *(const f32x4*)(F.in[12] + h * 128 + 16 * (tid & 7) + 4 * k);
    f32x4 S[8]; bf16x8 Sb[4];
#pragma unroll
    for (int t = 0; t < 8; ++t) {
        if (sinit) { S[t] = (f32x4){sinit[(16 * t + 4 * fg + 0) * 128 + 16 * w + fr], sinit[(16 * t + 4 * fg + 1) * 128 + 16 * w + fr], sinit[(16 * t + 4 * fg + 2) * 128 + 16 * w + fr], sinit[(16 * t + 4 * fg + 3) * 128 + 16 * w + fr]}; }
        else S[t] = (f32x4){0.f, 0.f, 0.f, 0.f};
    }
    make_sb(S, Sb);
    const int lr = tid >> 3, lpart = tid & 7;
    const int lsw = swb(lr);
    u32x4 RQ[6];
    {
        int t0, c; chunk_of(sq, 0, t0, c);
#pragma unroll
        for (int X = 0; X < 3; ++X) { RQ[2 * X] = (u32x4){0u, 0u, 0u, 0u}; RQ[2 * X + 1] = RQ[2 * X];
            if (lr < c) { const u32x4* p = (const u32x4*)(PR + (size_t)(sq.row0 + t0 + lr) * 2048 + X * 512 + h * 128 + 16 * lpart); RQ[2 * X] = p[0]; RQ[2 * X + 1] = p[1]; } }
#pragma unroll
        for (int X = 0; X < 3; ++X) { *(LAS u32x4*)(L + X * 16384 + lr * 256 + (((2 * lpart) ^ lsw) * 16)) = RQ[2 * X]; *(LAS u32x4*)(L + X * 16384 + lr * 256 + (((2 * lpart + 1) ^ lsw) * 16)) = RQ[2 * X + 1]; }
    }
    __syncthreads();
    for (int n = 0; n < nchunks; ++n) {
        LAS unsigned char* Bc = L + (n & 1) * SCAN_BUF; LAS unsigned char* Bn = L + ((n & 1) ^ 1) * SCAN_BUF;
        int lane_ = lane; asm volatile("" : "+v"(lane_));
        const int fr = lane_ & 15, fg = lane_ >> 4, swr = swb(fr);
        int t0, c; chunk_of(sq, n, t0, c);
        const bool more = n + 1 < nchunks;
        if (more) {
            int t1, c1; chunk_of(sq, n + 1, t1, c1);
#pragma unroll
            for (int X = 0; X < 3; ++X) { RQ[2 * X] = (u32x4){0u, 0u, 0u, 0u}; RQ[2 * X + 1] = RQ[2 * X];
                if (lr < c1) { const u32x4* p = (const u32x4*)(PR + (size_t)(sq.row0 + t1 + lr) * 2048 + X * 512 + h * 128 + 16 * lpart); RQ[2 * X] = p[0]; RQ[2 * X + 1] = p[1]; } }
        }
        u32x4 ga = {0u, 0u, 0u, 0u}, gb = ga;
        if (lr < c) { const u32x4* gp = (const u32x4*)(PR + (size_t)(sq.row0 + t0 + lr) * 2048 + 1536 + h * 128 + 16 * lpart); ga = gp[0]; gb = gp[1]; }
#pragma unroll
        for (int rep = 0; rep < 2; ++rep) {
            const int idx = w + 8 * rep, it = idx >> 2, jt = idx & 3, jcol = 16 * jt + fr;
            LAS bf16_t* Pb = (LAS bf16_t*)(Bc + 49152);
            f32x4 a = {0.f, 0.f, 0.f, 0.f};
            if (it >= jt) {
#pragma unroll
                for (int s = 0; s < 4; ++s) {
                    const bf16x8 aq = *(LAS bf16x8*)(Bc + (16 * it + fr) * 256 + (((4 * s + fg) ^ swr) * 16));
                    const bf16x8 bk = *(LAS bf16x8*)(Bc + 16384 + (16 * jt + fr) * 256 + (((4 * s + fg) ^ swr) * 16));
                    a = __builtin_amdgcn_mfma_f32_16x16x32_bf16(aq, bk, a, 0, 0, 0);
                }
            }
#pragma unroll
            for (int rr = 0; rr < 4; ++rr) {
                const int i_ = 16 * it + 4 * fg + rr;
                const float p = (it >= jt && i_ >= jcol) ? a[rr] * exp2f(lg * (float)(i_ - jcol)) : 0.f;
                Pb[i_ * 64 + ((((jcol >> 3) ^ ((i_ >> 1) & 7)) << 3) | (jcol & 7))] = (bf16_t)(cvt_pk_bf16(p, 0.f) & 0xffffu);
            }
        }
        __syncthreads();
        s16x4 vlo[2], vhi[2];
#pragma unroll
        for (int s = 0; s < 2; ++s) {
            const int r0 = 32 * s + 8 * fg + (fr >> 2), r1 = r0 + 4;
            vlo[s] = ld_tr(Bc + 32768 + r0 * 256 + (((2 * w + ((fr & 3) >> 1)) ^ swb(r0)) * 16) + (fr & 1) * 8);
            vhi[s] = ld_tr(Bc + 32768 + r1 * 256 + (((2 * w + ((fr & 3) >> 1)) ^ swb(r1)) * 16) + (fr & 1) * 8);
        }
        f32x4 o[4];
#pragma unroll
        for (int mt = 0; mt < 4; ++mt) {
            f32x4 a1 = {0.f, 0.f, 0.f, 0.f}, a2 = {0.f, 0.f, 0.f, 0.f};
            const int row = 16 * mt + fr;
#pragma unroll
            for (int s = 0; s < 2; ++s) {
                const bf16x8 ap = *(LAS bf16x8*)(Bc + 49152 + row * 128 + (((4 * s + fg) ^ ((row >> 1) & 7)) * 16));
                a1 = __builtin_amdgcn_mfma_f32_16x16x32_bf16(ap, mk8(vlo[s], vhi[s]), a1, 0, 0, 0);
            }
#pragma unroll
            for (int s = 0; s < 4; ++s) {
                const s16x4 lo = ld_b64(Bc + row * 256 + (((4 * s + (fg >> 1)) ^ swr) * 16) + (fg & 1) * 8);
                const s16x4 hi = ld_b64(Bc + row * 256 + (((4 * s + 2 + (fg >> 1)) ^ swr) * 16) + (fg & 1) * 8);
                a2 = __builtin_amdgcn_mfma_f32_16x16x32_bf16(mk8(lo, hi), Sb[s], a2, 0, 0, 0);
            }
#pragma unroll
            for (int rr = 0; rr < 4; ++rr) o[mt][rr] = a1[rr] + exp2f(lg * (float)(16 * mt + 4 * fg + rr + 1)) * a2[rr];
        }
        bf16x8 vd[2];
#pragma unroll
        for (int s = 0; s < 2; ++s) {
            float f[8];
#pragma unroll
            for (int jj = 0; jj < 8; ++jj) { const int j = 32 * s + 8 * fg + jj; const int e = c - 1 - j; f[jj] = e >= 0 ? exp2f(lg * (float)e) : 0.f; }
            const u32x2 l2 = __builtin_bit_cast(u32x2, vlo[s]), h2 = __builtin_bit_cast(u32x2, vhi[s]);
            u32x2 lo, hi;
            lo.x = cvt_pk_bf16(bflo(l2.x) * f[0], bfhi(l2.x) * f[1]); lo.y = cvt_pk_bf16(bflo(l2.y) * f[2], bfhi(l2.y) * f[3]);
            hi.x = cvt_pk_bf16(bflo(h2.x) * f[4], bfhi(h2.x) * f[5]); hi.y = cvt_pk_bf16(bflo(h2.y) * f[6], bfhi(h2.y) * f[7]);
            vd[s] = mk8(__builtin_bit_cast(s16x4, lo), __builtin_bit_cast(s16x4, hi));
        }
        const float gc = exp2f(lg * (float)c);
#pragma unroll
        for (int t = 0; t < 8; ++t) {
            f32x4 a = S[t] * gc;
#pragma unroll
            for (int s = 0; s < 2; ++s) {
                const int r0 = 32 * s + 8 * fg + (fr >> 2), r1 = r0 + 4;
                const s16x4 lo = ld_tr(Bc + 16384 + r0 * 256 + (((2 * t + ((fr & 3) >> 1)) ^ swb(r0)) * 16) + (fr & 1) * 8);
                const s16x4 hi = ld_tr(Bc + 16384 + r1 * 256 + (((2 * t + ((fr & 3) >> 1)) ^ swb(r1)) * 16) + (fr & 1) * 8);
                a = __builtin_amdgcn_mfma_f32_16x16x32_bf16(mk8(lo, hi), vd[s], a, 0, 0, 0);
            }
            S[t] = a;
        }
        make_sb(S, Sb);
        __syncthreads();
        os_write(Bc, o, w, fr, fg);
        if (more) {
#pragma unroll
            for (int X = 0; X < 3; ++X) { *(LAS u32x4*)(Bn + X * 16384 + lr * 256 + (((2 * lpart) ^ lsw) * 16)) = RQ[2 * X]; *(LAS u32x4*)(Bn + X * 16384 + lr * 256 + (((2 * lpart + 1) ^ lsw) * 16)) = RQ[2 * X + 1]; }
        }
        __syncthreads();
        os_finish<0>(Bc, tid, h, sq.row0 + t0, c, nwv, ga, gb, mix);
    }
#pragma unroll
    for (int t = 0; t < 8; ++t)
#pragma unroll
        for (int rr = 0; rr < 4; ++rr) sfinal[(16 * t + 4 * fg + rr) * 128 + 16 * w + fr] = S[t][rr];
    __syncthreads();
}

struct Args { const float* in[20]; float* out; unsigned char* ws; int ph_lo, ph_hi, li, pad; };
constexpr int NPHASE = 8;

__global__ void __launch_bounds__(512, 2) mega_fwd(Args args) {
    extern __shared__ __attribute__((aligned(16))) unsigned char lds[];
    Frame F;
    F.lds = (LAS unsigned char*)lds;
    F.tid = threadIdx.x; F.lane = F.tid & 63; F.wave = __builtin_amdgcn_readfirstlane(F.tid >> 6);
    F.G = gridDim.x; F.blk = blockIdx.x;
#pragma unroll
    for (int i = 0; i < 20; ++i) F.in[i] = args.in[i];
    F.out = args.out; F.ws = args.ws;
    volatile LAS unsigned* MISC = (volatile LAS unsigned*)(F.lds + MISC_OFF);
    for (int u = F.tid; u < (LDS_BYTES - LDSCTL_OFF) / 4; u += 512) ((LAS unsigned*)(F.lds + LDSCTL_OFF))[u] = 0u;
    __syncthreads();
    unsigned* barw = (unsigned*)(F.ws + WS_CTL) + CW_BAR + args.li * XCD_BAR_WORDS;
    XcdBarrier bar; bar.bar = barw; bar.x = 0; bar.st = nullptr;
    if (MK_N_LAUNCHES == 1) bar = xcd_barrier_post(barw, MISC + 8);
    const int lo = args.ph_lo, hi = args.ph_hi;
#define IN(k) (lo <= (k) && (k) < hi)
#define SEAM(k) do { if (IN(k) && IN((k) + 1)) xcd_barrier(bar); } while (0)
#define STAMP(k) do { if (MK_TPROBE && F.tid == 0) ((unsigned*)(F.ws + WS_CTL))[CW_TS + (k) * 256 + F.blk] = (unsigned)__builtin_amdgcn_s_memrealtime(); } while (0)
    STAMP(0);

    for (int rep = 0; rep < 1 + (MK_REPEAT & 1); ++rep) { if (rep) xcd_barrier(bar); if (IN(0)) { p0_prologue(F); } }
    STAMP(1); SEAM(0);
    for (int rep = 0; rep < 1 + ((MK_REPEAT >> 1) & 1); ++rep) { if (rep) xcd_barrier(bar);
    if (IN(1)) {
        pg8::Gemm g{(const bf16_t*)(F.ws + WS_H), (const bf16_t*)(F.ws + WS_WIN), 1024};
        pg8::StaticOrder S; S.init(MPAD / 256, NIN / 256, F.G, F.blk);
        EpiIn E{(bf16_t*)(F.ws + WS_PR), (bf16_t*)(F.ws + WS_PG), (const float*)(F.ws + WS_ROT), F.out};
        pg8::gemm_phase<EpiIn, pg8::StaticOrder, pg8::MapPlain>(F.lds, g, S, E);
    } }
    STAMP(2); SEAM(1);
#pragma unroll 1
    for (int phx = 0; phx < 2 + ((MK_REPEAT >> 2) & 1) + ((MK_REPEAT >> 3) & 1); ++phx) {
        const int ph = phx < 1 + ((MK_REPEAT >> 2) & 1) ? 2 : 3;
        if (phx > 0 && IN(2) && IN(3)) { STAMP(3); xcd_barrier(bar); }
        if (IN(ph)) {
            int it, iend, istep;
            if (ph == 2) { it = F.blk; iend = 1056; istep = F.G; }
            else if (F.blk < 64) { it = F.blk; iend = F.blk + 1; istep = 1; }
            else { it = F.blk; iend = 64 + 1024; istep = F.G - 64; }
#pragma unroll 1
            for (; it < iend; it += istep) {
                int kind, h, nch, t0 = 0, c = 4; SeqD sq; unsigned char* slot; const float* sinit = nullptr; float* sfinal = nullptr;
                if (ph == 2) {
                    const int bh = it / 33, n = it - bh * 33, b = bh >> 2; h = bh & 3; kind = 0; nch = 0;
                    sq = SeqD{b * LP, LP, 0, b}; t0 = n == 0 ? 0 : 16 + 64 * (n - 1); c = n == 0 ? 16 : 64;
                    slot = F.ws + WS_G2A + (size_t)it * SLOT;
                } else if (it < 64) {
                    const int bb = it & 31, b = bb >> 2; h = bb & 3; kind = it < 32 ? 1 : 2; nch = 33;
                    sq = SeqD{b * LP, LP, 0, b};
                    slot = F.ws + WS_G2A + (size_t)(bb * 33) * SLOT;
                    sfinal = F.out + (it < 32 ? O_PSG : O_PSR) + (size_t)bb * 16384;
                } else {
                    const int j = it - 64, rem = j & 511, sb = rem >> 2; h = rem & 3; kind = j < 512 ? 3 : 2; nch = 1;
                    sq = SeqD{MPROMPT + sb * 4, 4, 1, sb};
                    slot = (unsigned char*)F.out + OS_SCR + (size_t)F.blk * SLOT;
                    sinit = (j < 512 ? F.in[3] : F.in[2]) + (size_t)rem * 16384;
                    sfinal = F.out + (j < 512 ? O_SSG : O_SSR) + (size_t)rem * 16384;
                }
                if (kind == 0 || kind == 3) p2a_item(F, sq, h, t0, c, slot);
                if (kind == 3) {
                    VM_WAIT(); __syncthreads();
                    __builtin_amdgcn_fence(__ATOMIC_ACQUIRE, "agent"); VM_WAIT(); __syncthreads();
                }
                if (kind == 1 || kind == 3) scan_gdn(F, sq, h, nch, slot, sinit, sfinal);
                if (kind == 2) scan_ret(F, sq, h, nch, sinit, sfinal);
            }
        }
    }
    STAMP(4); SEAM(3);
    for (int rep = 0; rep < 1 + ((MK_REPEAT >> 4) & 1); ++rep) { if (rep) xcd_barrier(bar);
    if (IN(4)) {
        pg8::Gemm g{(const bf16_t*)((unsigned char*)F.out + OS_MIX), (const bf16_t*)(F.ws + WS_WOUT), 1024};
        pg8::StaticOrder S; S.init(MPAD / 256, 4, F.G, F.blk);
        EpiOut E{F.in[0], F.in[1], F.in[6], (bf16_t*)(F.ws + WS_X2B), (float*)(F.ws + WS_RSQ2)};
        pg8::gemm_phase<EpiOut, pg8::StaticOrder, pg8::MapPlain>(F.lds, g, S, E);
    } }
    STAMP(5); SEAM(4);
    for (int rep = 0; rep < 1 + ((MK_REPEAT >> 5) & 1); ++rep) { if (rep) xcd_barrier(bar);
    if (IN(5)) {
        pg8::Gemm g{(const bf16_t*)(F.ws + WS_X2B), (const bf16_t*)(F.ws + WS_WUP), 1024};
        pg8::StaticOrder S; S.init(UP_NM, NUP / 256, F.G, F.blk);
        EpiUp E{(const float*)(F.ws + WS_RSQ2), F.in[17], F.in[5], (bf16_t*)(F.ws + WS_ACT), F.out};
        pg8::gemm_phase<EpiUp, pg8::StaticOrder, pg8::MapUp>(F.lds, g, S, E);
    } }
    STAMP(6); SEAM(5);
    for (int rep = 0; rep < 1 + ((MK_REPEAT >> 6) & 1); ++rep) { if (rep) xcd_barrier(bar);
    if (IN(6)) {
        pg8::Gemm g{(const bf16_t*)(F.ws + WS_ACT), (const bf16_t*)(F.ws + WS_WDN), DFF};
        pg8::StaticOrder S; S.init(MPAD / 256, 4, F.G, F.blk);
        EpiDown E{(const bf16_t*)(F.ws + WS_X2B), F.out, (float*)(F.ws + WS_RSQ3)};
        pg8::gemm_phase<EpiDown, pg8::StaticOrder, pg8::MapPlain>(F.lds, g, S, E);
    } }
    STAMP(7); SEAM(6);
    if (IN(7)) {
        const float* rsq = (const float*)(F.ws + WS_RSQ3); const float* nf = F.in[19];
        const int gw = F.blk * 8 + F.wave, NGW = F.G * 8;
        for (int q = gw; q < 16384 + 512; q += NGW) {
            int g; float* dst;
            if (q < 16384) { g = (q >> 11) * LP + 16 + (q & 2047); dst = F.out + O_YP + (size_t)q * DM; } else { g = MPROMPT + (q - 16384); dst = F.out + O_YS + (size_t)(q - 16384) * DM; }
            float s = F.lane < 16 ? rsq[(size_t)g * 16 + F.lane] : 0.f;
            s = wave_sum(s);
            const float rstd = rsqrtf(s * (1.0f / DM) + EPS);
            f32x4* p = (f32x4*)dst + F.lane; const f32x4* np = (const f32x4*)nf + F.lane;
#pragma unroll
            for (int j = 0; j < 4; ++j) { f32x4 v = p[64 * j]; v = v * rstd * np[64 * j]; p[64 * j] = v; }
        }
    }
    if (MK_TPROBE && IN(7)) {
        STAMP(8);
        xcd_barrier(bar);
        if (F.blk == 0) {
            LAS float* sh = (LAS float*)F.lds;
            if (F.tid == 0) {
                const unsigned* TS = (const unsigned*)(F.ws + WS_CTL) + CW_TS;
                auto mx = [&](int k, int lo_, int hi_) { unsigned m = TS[k * 256 + lo_]; for (int b = lo_; b < hi_; ++b) { const unsigned v = TS[k * 256 + b]; if ((int)(v - m) > 0) m = v; } return m; };
                unsigned d = 0;
                const int sel = MK_TPROBE;
                if (sel >= 1 && sel <= 8) d = mx(sel, 0, F.G) - mx(sel - 1, 0, F.G);
                else if (sel == 10) d = TS[4 * 256 + 0] - mx(3, 0, F.G);
                else if (sel == 11) d = TS[4 * 256 + 32] - mx(3, 0, F.G);
                else if (sel == 12) d = mx(4, 64, F.G) - mx(3, 0, F.G);
                else if (sel == 13) d = mx(8, 0, F.G) - TS[0];
                else if (sel >= 20 && sel <= 22) d = TS[(sel - 11) * 256 + 0];
                sh[0] = sqrtf(MK_TSCALE * (float)d * 0.01f);
            }
            __syncthreads();
            const float f = 1.0f + sh[0];
            for (int e = F.tid; e < 8 * 3 * GQKV; e += 512) F.out[O_PCQ + e] *= f;
        }
    }
#undef IN
#undef SEAM
}

extern "C" void kernel_launch(void* const* d_in, const int* in_sizes, int n_in, void* d_out, int out_size, void* d_ws, size_t ws_size, hipStream_t stream) {
    static int grid = 0;
    if (grid == 0) {
        if (n_in != 20 || (size_t)out_size != O_TOTAL || ws_size < WS_END) { fprintf(stderr, "kernel_launch: unexpected shapes (n_in %d, out %d, ws %zu); nothing launched\n", n_in, out_size, ws_size); grid = -1; return; }
        int dev = 0, cus = 0;
        if (hipGetDevice(&dev) != hipSuccess || hipDeviceGetAttribute(&cus, hipDeviceAttributeMultiprocessorCount, dev) != hipSuccess) { grid = -1; return; }
        if (hipFuncSetAttribute((const void*)mega_fwd, hipFuncAttributeMaxDynamicSharedMemorySize, LDS_BYTES) != hipSuccess) { fprintf(stderr, "kernel_launch: hipFuncSetAttribute failed\n"); grid = -1; return; }
        (void)hipGetLastError();
        grid = cus;
        if (grid < 128 || (grid & 7)) { fprintf(stderr, "kernel_launch: unexpected CU count %d\n", cus); }
    }
    if (grid < 0) return;
    if (hipMemsetAsync((char*)d_ws + WS_CTL, 0, CTL_ZERO_BYTES, stream) != hipSuccess) return;
    Args a{};
    for (int i = 0; i < 20; ++i) a.in[i] = (const float*)d_in[i];
    a.out = (float*)d_out; a.ws = (unsigned char*)d_ws;
#if MK_N_LAUNCHES == 1
    a.ph_lo = 0; a.ph_hi = NPHASE; a.li = 0;
    hipLaunchKernelGGL(mega_fwd, dim3(grid), dim3(512), LDS_BYTES, stream, a);
#else
    for (int li = 0; li < NPHASE; ++li) { a.ph_lo = li; a.ph_hi = li + 1; a.li = 0; hipLaunchKernelGGL(mega_fwd, dim3(grid), dim3(512), LDS_BYTES, stream, a); }
#endif
}
```

```cpp
#include <hip/hip_runtime.h>
#include <cstdio>
#include <cstdint>

#ifndef MK_REPEAT
#define MK_REPEAT 0
#endif
#ifndef MK_TPROBE
#define MK_TPROBE 0
#endif
#ifndef MK_TSCALE
#define MK_TSCALE 2e-7f
#endif
#ifndef MK_N_LAUNCHES
#define MK_N_LAUNCHES 1
#endif

#define LAS __attribute__((address_space(3)))
typedef unsigned short bf16_t;
typedef short bf16x8 __attribute__((ext_vector_type(8)));
typedef short s16x4 __attribute__((ext_vector_type(4)));
typedef float f32x4 __attribute__((ext_vector_type(4)));
typedef unsigned u32x4 __attribute__((ext_vector_type(4)));
typedef unsigned u32x2 __attribute__((ext_vector_type(2)));

constexpr int DM = 1024, LP = 2064, NBATCH = 8, MPROMPT = NBATCH * LP  , NSB = 128, MSAMP = 512, MREAL = MPROMPT + MSAMP  , MPAD = 17152  ;
constexpr int NIN = 4096, INW = 4104, DFF = 2816, NUP = 5632, GQKV = 1536;
constexpr int UP_TROWS = 248, UP_NM = 69;
constexpr float EPS = 1e-6f;
constexpr size_t O_YP = 0, O_YS = 16777216, O_PSR = 17301504, O_PSG = 17825792, O_PCQ = 18350080, O_PCF = 18386944, O_SSR = 18477056, O_SSG = 26865664, O_SCQ = 35254272, O_SCF = 35844096, O_TOTAL = 37285888;
constexpr size_t MiB = 1u << 20;
constexpr size_t WS_CTL = 0, CTL_ZERO_BYTES = 1 * MiB;
constexpr size_t WS_WIN = 1 * MiB, WS_WOUT = 9 * MiB, WS_WUP = 11 * MiB, WS_WDN = 22 * MiB, WS_ROT = 28 * MiB, WS_BG = 30 * MiB, WS_RSQ2 = 31 * MiB, WS_RSQ3 = 32 * MiB + 512 * 1024;
constexpr size_t WS_PGX = 34 * MiB;
constexpr size_t WS_BIG = 36 * MiB;
constexpr size_t WS_PR = WS_BIG, WS_PG = WS_BIG + 67 * MiB, WS_G2A = WS_BIG + 134 * MiB, WS_H = WS_G2A;
constexpr size_t WS_X2F = WS_BIG, WS_X2B = WS_BIG + 67 * MiB, WS_ACT = WS_BIG + 101 * MiB;
constexpr size_t SLOT = 73984;
constexpr size_t WS_END = 256 * MiB;
static_assert(WS_G2A + 1056 * SLOT <= WS_END && WS_ACT + (size_t)MPAD * DFF * 2 <= WS_END, "ws map");
constexpr size_t OS_MIX = 0, OS_SCR = 34 * MiB;
static_assert(OS_SCR + 256 * SLOT <= 64 * MiB, "d_out scratch");
constexpr int CW_BAR = 4096, CW_TS = 16384;
constexpr int RING_BYTES = 131072, LDSCTL_OFF = 150528, MISC_OFF = LDSCTL_OFF + 320, LDS_BYTES = 151552;

#define LDS_WAIT() asm volatile("s_waitcnt lgkmcnt(0)" ::: "memory")
#define VM_WAIT() asm volatile("s_waitcnt vmcnt(0)" ::: "memory")

typedef float f32x2_t __attribute__((ext_vector_type(2))); typedef __bf16 bf16x2_t __attribute__((ext_vector_type(2)));
__device__ __forceinline__ unsigned cvt_pk_bf16(float lo, float hi) { const f32x2_t v = {lo, hi}; const bf16x2_t b = __builtin_convertvector(v, bf16x2_t); return __builtin_bit_cast(unsigned, b); }
__device__ __forceinline__ float bflo(unsigned w) { return __uint_as_float(w << 16); }
__device__ __forceinline__ float bfhi(unsigned w) { return __uint_as_float(w & 0xffff0000u); }
__device__ __forceinline__ float bfround(float x) { return bflo(cvt_pk_bf16(x, 0.f)); }
__device__ __forceinline__ float silu_f(float y) { return y * __builtin_amdgcn_rcpf(1.0f + __expf(-y)); }
__device__ __forceinline__ float wave_sum(float v) {
#pragma unroll
    for (int o = 1; o < 64; o <<= 1) v += __shfl_xor(v, o);
    return v;
}
__device__ __forceinline__ float dpp_shr1(float x) { return __int_as_float(__builtin_amdgcn_update_dpp(0, __float_as_int(x), 0x111, 0xf, 0xf, true)); }

struct RowInfo { int t, len, idx, samp; };
__device__ __forceinline__ RowInfo rowinfo(int g) {
    RowInfo r;
    if (g < MPROMPT) { r.idx = g / LP; r.t = g - r.idx * LP; r.len = LP; r.samp = 0; }
    else { const int s = g - MPROMPT; r.idx = s >> 2; r.t = s & 3; r.len = 4; r.samp = 1; }
    return r;
}

namespace pg8 {
constexpr int BM = 256, BK = 64, HALF = 128, HTB = HALF * BK * 2, STAGE_BYTES = 8 * HTB, NXCD = 8, WGM = 8;
__host__ __device__ __forceinline__ int lds_byte(int r, int c) { const int st = (r >> 4) * 2 + (c >> 5), rr = r & 15, cc = c & 31, ob = rr * 64 + cc * 2; return st * 1024 + (ob ^ (((ob >> 9) & 1) << 5)); }
__host__ __device__ __forceinline__ void stage_rc(int b, int& R, int& C) { const int st = b / 1024, sb = b % 1024, swz = sb ^ (((sb >> 9) & 1) << 5); R = (st >> 1) * 16 + swz / 64; C = (st & 1) * 32 + (swz % 64) / 2; }
__host__ __device__ __forceinline__ int perm32(int rho) { const int n = rho >> 4, i = rho & 15; return 8 * (i >> 2) + 4 * n + (i & 3); }
struct Unit { int pm, pn; };
struct Gemm { const bf16_t* A; const bf16_t* Bt; int K; };
struct StaticOrder {
    int nM, nN, nwg, G, c;
    __host__ __device__ void init(int nM_, int nN_, int G_, int c_) { nM = nM_; nN = nN_; nwg = nM * nN; G = G_; c = c_; }
    __host__ __device__ bool next(int i, Unit& u) const {
        const long L = (long)i * G + c; if (L >= nwg) return false;
        int wgid = (int)L; { const int q = nwg / NXCD, r = nwg % NXCD, xcd = wgid % NXCD, off = wgid / NXCD; wgid = (xcd < r ? xcd * (q + 1) : r * (q + 1) + (xcd - r) * q) + off; }
        const int nig = WGM * nN, gid = wgid / nig, fm = gid * WGM, gsz = (nM - fm) < WGM ? (nM - fm) : WGM;
        u.pm = fm + ((wgid % nig) % gsz); u.pn = (wgid % nig) / gsz; return true;
    }
    __device__ __forceinline__ void a_ready(const Unit&) const {}
    __device__ __forceinline__ void done(const Unit&) const {}
};
struct MapPlain { static constexpr int HROWS = 128, TROWS = 256; static __device__ __forceinline__ int row(int R) { return R; } };
struct MapUp { static constexpr int HROWS = 124, TROWS = UP_TROWS; static __device__ __forceinline__ int row(int R) { return 62 * (R >> 6) - 2 + 4 * (R & 15) + ((R >> 4) & 3); } };

template <class Epi, class Sched, class AMap, bool ALIGN_EPI = true>
__device__ __forceinline__ void gemm_phase(LAS unsigned char* lds, const Gemm g, const Sched& S, const Epi& E) {
    const int tid = threadIdx.x, wid = __builtin_amdgcn_readfirstlane(tid >> 6), lane = tid & 63, wr = wid >> 2, wc = wid & 3, fr = lane & 15, fq = lane >> 4;
    const int K = g.K, nt = K / BK;
    int voffA[2], voffB[2];
#pragma unroll
    for (int i = 0; i < 2; ++i) { int R, C; stage_rc(tid * 16 + i * 8192, R, C); const int Rb = Epi::PERM ? ((R & ~31) + perm32(R & 31)) : R;
        voffA[i] = (AMap::row(R) * K + C) * 2; voffB[i] = (Rb * K + C) * 2; }
    const size_t kstep = (size_t)(BK * 2);
    const size_t hstepA = (size_t)AMap::HROWS * K * 2, tstepA = (size_t)AMap::TROWS * K * 2;
    const size_t hstepB = (size_t)HALF * K * 2, tstepB = 2 * hstepB;
    const unsigned ldsw = (unsigned)wid * 1024u;
    const int aoff = lds_byte(wr * 64 + fr, fq * 8), boff = lds_byte(wc * 32 + fr, fq * 8);
#define PG8_SA(b, h) (((b) * 2 + (h)) * HTB)
#define PG8_SB(b, h) ((4 + (b) * 2 + (h)) * HTB)
#define PG8_STAGE(bufoff, gbase, voff) do { _Pragma("unroll") for (int _i = 0; _i < 2; ++_i) \
        __builtin_amdgcn_global_load_lds((const unsigned*)((const char*)(gbase) + (voff)[_i]), (LAS unsigned*)(lds + (bufoff) + ldsw + _i * 8192), 16, 0, 0); } while (0)
#define PG8_LDA(dst, b, h) do { _Pragma("unroll") for (int m = 0; m < 4; ++m) _Pragma("unroll") for (int k = 0; k < 2; ++k) dst[m][k] = *(const LAS bf16x8*)(lds + PG8_SA(b, h) + aoff + m * 2048 + k * 1024); } while (0)
#define PG8_LDB(dst, b, h) do { _Pragma("unroll") for (int n = 0; n < 2; ++n) _Pragma("unroll") for (int k = 0; k < 2; ++k) dst[n][k] = *(const LAS bf16x8*)(lds + PG8_SB(b, h) + boff + n * 2048 + k * 1024); } while (0)
#define PG8_MMA(ai, bj, At, Bt) do { __builtin_amdgcn_s_setprio(1); _Pragma("unroll") for (int m = 0; m < 4; ++m) _Pragma("unroll") for (int n = 0; n < 2; ++n) _Pragma("unroll") for (int k = 0; k < 2; ++k) \
        acc[ai][bj][m][n] = __builtin_amdgcn_mfma_f32_16x16x32_bf16(Bt[n][k], At[m][k], acc[ai][bj][m][n], 0, 0, 0); __builtin_amdgcn_s_setprio(0); } while (0)
#define PG8_WAIT_V(n) asm volatile("s_waitcnt vmcnt(" #n ")" ::: "memory")
#define PG8_WAIT_L(n) asm volatile("s_waitcnt lgkmcnt(" #n ")" ::: "memory")
#define PG8_BAR __builtin_amdgcn_s_barrier()
#define PG8_SCHED __builtin_amdgcn_sched_barrier(0)
    Unit cur, nxt; int ui = 0;
    if (!S.next(0, cur)) return;
    f32x4 acc[2][2][4][2];
#pragma unroll
    for (int a = 0; a < 2; ++a)
#pragma unroll
        for (int b = 0; b < 2; ++b)
#pragma unroll
            for (int m = 0; m < 4; ++m)
#pragma unroll
                for (int n = 0; n < 2; ++n) acc[a][b][m][n] = (f32x4){0.f, 0.f, 0.f, 0.f};
    bf16x8 At[4][2], B0[2][2], B1[2][2];
    const char* cA = (const char*)g.A + (size_t)cur.pm * tstepA; const char* cB = (const char*)g.Bt + (size_t)cur.pn * tstepB;
    S.a_ready(cur);
    PG8_STAGE(PG8_SB(0, 0), cB, voffB); PG8_STAGE(PG8_SB(0, 1), cB + hstepB, voffB); PG8_STAGE(PG8_SA(0, 0), cA, voffA); PG8_STAGE(PG8_SA(0, 1), cA + hstepA, voffA);
    if (wr == 1) PG8_BAR;
    PG8_WAIT_V(2); PG8_BAR;
    PG8_STAGE(PG8_SB(1, 0), cB + kstep, voffB); PG8_STAGE(PG8_SA(1, 0), cA + kstep, voffA); PG8_STAGE(PG8_SB(1, 1), cB + hstepB + kstep, voffB);
    PG8_WAIT_V(6); PG8_BAR;
    for (;;) {
        const bool has_next = S.next(ui + 1, nxt);
        const char* nA = has_next ? (const char*)g.A + (size_t)nxt.pm * tstepA : cA; const char* nB = has_next ? (const char*)g.Bt + (size_t)nxt.pn * tstepB : cB;
        for (int t = 0; t < nt; t += 2) {
            const bool last = (t == nt - 2);
            const char* a1 = cA + (size_t)(t + 1) * kstep;
            const char* a2 = last ? nA : cA + (size_t)(t + 2) * kstep; const char* b2 = last ? nB : cB + (size_t)(t + 2) * kstep;
            const char* a3 = a2 + kstep; const char* b3 = b2 + kstep;
            if (last && has_next) S.a_ready(nxt);
            PG8_LDB(B0, 0, 0); PG8_LDB(B1, 0, 1); PG8_SCHED; PG8_LDA(At, 0, 0); PG8_STAGE(PG8_SA(1, 1), a1 + hstepA, voffA);
            PG8_WAIT_V(8); PG8_WAIT_L(0); PG8_BAR; PG8_MMA(0, 0, At, B0); PG8_MMA(0, 1, At, B1); PG8_BAR; PG8_SCHED;
            PG8_LDA(At, 0, 1); PG8_STAGE(PG8_SB(0, 0), b2, voffB); PG8_STAGE(PG8_SB(0, 1), b2 + hstepB, voffB); PG8_STAGE(PG8_SA(0, 0), a2, voffA);
            PG8_WAIT_V(8); PG8_WAIT_L(0); PG8_BAR; PG8_MMA(1, 0, At, B0); PG8_MMA(1, 1, At, B1); PG8_BAR; PG8_SCHED;
            PG8_LDB(B0, 1, 0); PG8_LDB(B1, 1, 1); PG8_SCHED; PG8_LDA(At, 1, 0); PG8_STAGE(PG8_SA(0, 1), a2 + hstepA, voffA);
            PG8_WAIT_V(8); PG8_WAIT_L(0); PG8_BAR; PG8_MMA(0, 0, At, B0); PG8_MMA(0, 1, At, B1); PG8_BAR; PG8_SCHED;
            PG8_LDA(At, 1, 1); PG8_STAGE(PG8_SB(1, 0), b3, voffB); PG8_STAGE(PG8_SB(1, 1), b3 + hstepB, voffB); PG8_STAGE(PG8_SA(1, 0), a3, voffA);
            PG8_WAIT_V(8); PG8_WAIT_L(0); PG8_BAR; PG8_MMA(1, 0, At, B0); PG8_MMA(1, 1, At, B1); PG8_BAR; PG8_SCHED;
        }
        if constexpr (ALIGN_EPI) { if (wr == 0) PG8_BAR; }
        E(acc, cur, wr, wc, fr, fq); S.done(cur);
        if (!has_next) break;
#pragma unroll
        for (int a = 0; a < 2; ++a)
#pragma unroll
            for (int b = 0; b < 2; ++b)
#pragma unroll
                for (int m = 0; m < 4; ++m)
#pragma unroll
                    for (int n = 0; n < 2; ++n) acc[a][b][m][n] = (f32x4){0.f, 0.f, 0.f, 0.f};
        cur = nxt; cA = nA; cB = nB; ++ui;
        if constexpr (ALIGN_EPI) { if (wr == 1) PG8_BAR; }
    }
    PG8_WAIT_V(0);
    if constexpr (!ALIGN_EPI) { if (wr == 0) PG8_BAR; }
    PG8_BAR;
#undef PG8_SA
#undef PG8_SB
#undef PG8_STAGE
#undef PG8_LDA
#undef PG8_LDB
#undef PG8_MMA
#undef PG8_WAIT_V
#undef PG8_WAIT_L
#undef PG8_BAR
#undef PG8_SCHED
}
}
using pg8::Unit;


struct EpiIn {
    static constexpr bool PERM = true;
    bf16_t* PR; bf16_t* PG; const float* rot; float* out;
    __device__ __forceinline__ void operator()(const f32x4 (&acc)[2][2][4][2], const Unit& u, int wr, int wc, int fr_, int fq_) const {
        int ln_; asm volatile("v_mbcnt_lo_u32_b32 %0, -1, 0\n\tv_mbcnt_hi_u32_b32 %0, -1, %0" : "=v"(ln_)); const int fr = ln_ & 15, fq = ln_ >> 4;
        const int pn = u.pn, rbase = u.pm * 256 + wr * 64 + fr;
        if (pn < 4) {
            const int head = (pn & 1) * 2 + (wc >> 1), j0 = 32 * (wc & 1) + 8 * fq;
            const float sc = pn >= 2 ? 0.08838834764831845f : 1.0f;
            bf16_t* dstb = PR + (pn >= 2 ? 512 : 0) + head * 128 + j0;
#pragma unroll
            for (int ai = 0; ai < 2; ++ai)
#pragma unroll
                for (int m = 0; m < 4; ++m) {
                    const int row = rbase + ai * 128 + m * 16;
                    int ridx = 0; if (row < MPROMPT) ridx = row % LP; else if (row < MREAL) ridx = LP + ((row - MPROMPT) & 3);
                    const f32x4* rp = (const f32x4*)(rot + (size_t)ridx * 128 + j0 * 2);
                    const f32x4 cs0 = rp[0], cs1 = rp[1], cs2 = rp[2], cs3 = rp[3];
                    const f32x4 a0 = acc[ai][0][m][0], a1 = acc[ai][0][m][1], b0 = acc[ai][1][m][0], b1 = acc[ai][1][m][1];
                    const float c[8] = {cs0[0], cs0[2], cs1[0], cs1[2], cs2[0], cs2[2], cs3[0], cs3[2]};
                    const float s[8] = {cs0[1], cs0[3], cs1[1], cs1[3], cs2[1], cs2[3], cs3[1], cs3[3]};
                    const float x1[8] = {a0[0], a0[1], a0[2], a0[3], a1[0], a1[1], a1[2], a1[3]};
                    const float x2[8] = {b0[0], b0[1], b0[2], b0[3], b1[0], b1[1], b1[2], b1[3]};
                    float o1[8], o2[8];
#pragma unroll
                    for (int i = 0; i < 8; ++i) { o1[i] = (x1[i] * c[i] - x2[i] * s[i]) * sc; o2[i] = (x1[i] * s[i] + x2[i] * c[i]) * sc; }
                    u32x4 w1, w2; w1.x = cvt_pk_bf16(o1[0], o1[1]); w1.y = cvt_pk_bf16(o1[2], o1[3]); w1.z = cvt_pk_bf16(o1[4], o1[5]); w1.w = cvt_pk_bf16(o1[6], o1[7]);
                    w2.x = cvt_pk_bf16(o2[0], o2[1]); w2.y = cvt_pk_bf16(o2[2], o2[3]); w2.z = cvt_pk_bf16(o2[4], o2[5]); w2.w = cvt_pk_bf16(o2[6], o2[7]);
                    bf16_t* rowp = dstb + (size_t)row * 2048;
                    *(u32x4*)(rowp) = w1; *(u32x4*)(rowp + 64) = w2;
                }
        } else {
            const bool act = (pn == 6 || pn == 7 || pn >= 14);
            const bool cst = (pn >= 8 && pn < 14);
            bf16_t* dbase = pn < 8 ? PR : PG;
            const int colt = (pn < 8 ? pn * 256 : pn * 256 - 2048) + wc * 32 + 8 * fq;
#pragma unroll
            for (int ai = 0; ai < 2; ++ai)
#pragma unroll
                for (int m = 0; m < 4; ++m) {
                    const int row = rbase + ai * 128 + m * 16;
                    bf16_t* rowp = dbase + (size_t)row * 2048 + colt;
                    float* cdst = nullptr;
                    if (cst && row < MREAL) { const RowInfo ri = rowinfo(row); if (ri.t >= ri.len - 3) cdst = out + (ri.samp ? O_SCQ : O_PCQ) + (size_t)(ri.idx * 3 + (ri.t - (ri.len - 3))) * GQKV + colt; }
#pragma unroll
                    for (int bj = 0; bj < 2; ++bj) {
                        f32x4 v0 = acc[ai][bj][m][0], v1 = acc[ai][bj][m][1];
                        if (cdst) { *(f32x4*)(cdst + bj * 128) = v0; *(f32x4*)(cdst + bj * 128 + 4) = v1; }
                        if (act) {
#pragma unroll
                            for (int i = 0; i < 4; ++i) { v0[i] = silu_f(v0[i]); v1[i] = silu_f(v1[i]); }
                        }
                        u32x4 w; w.x = cvt_pk_bf16(v0[0], v0[1]); w.y = cvt_pk_bf16(v0[2], v0[3]); w.z = cvt_pk_bf16(v1[0], v1[1]); w.w = cvt_pk_bf16(v1[2], v1[3]);
                        *(u32x4*)(rowp + bj * 128) = w;
                    }
                }
        }
    }
};

__device__ __forceinline__ const float* x_src_row(const float* xp, const float* xs, const float* meta, int g) {
    if (g < MPROMPT) { const int b = g / LP, t = g - b * LP; return t < 16 ? meta + (size_t)t * DM : xp + ((size_t)b * 2048 + (t - 16)) * DM; }
    return xs + (size_t)(g - MPROMPT) * DM;
}

struct EpiOut {
    static constexpr bool PERM = false;
    const float* xp; const float* xs; const float* meta; bf16_t* X2B; float* rsq;
    __device__ __forceinline__ void operator()(const f32x4 (&acc)[2][2][4][2], const Unit& u, int wr, int wc, int fr_, int fq_) const {
        int ln_; asm volatile("v_mbcnt_lo_u32_b32 %0, -1, 0\n\tv_mbcnt_hi_u32_b32 %0, -1, %0" : "=v"(ln_)); const int fr = ln_ & 15, fq = ln_ >> 4;
        const int rbase = u.pm * 256 + wr * 64 + fr, col0 = u.pn * 256 + wc * 32 + 4 * fq;
#pragma unroll
        for (int ai = 0; ai < 2; ++ai)
#pragma unroll
            for (int m = 0; m < 4; ++m) {
                const int row = rbase + ai * 128 + m * 16;
                const float* xr = row < MREAL ? x_src_row(xp, xs, meta, row) + col0 : nullptr;
                bf16_t* ob = X2B + (size_t)row * DM + col0;
                float ss = 0.f;
#pragma unroll
                for (int bj = 0; bj < 2; ++bj)
#pragma unroll
                    for (int n = 0; n < 2; ++n) {
                        f32x4 v = acc[ai][bj][m][n];
                        if (xr) v += *(const f32x4*)(xr + bj * 128 + n * 16);
                        ss += (v[0] * v[0] + v[1] * v[1]) + (v[2] * v[2] + v[3] * v[3]);
                        u32x2 w; w.x = cvt_pk_bf16(v[0], v[1]); w.y = cvt_pk_bf16(v[2], v[3]);
                        *(u32x2*)(ob + bj * 128 + n * 16) = w;
                    }
                ss += __shfl_xor(ss, 16); ss += __shfl_xor(ss, 32);
                if (fq == 0) rsq[(size_t)row * 16 + u.pn * 4 + wc] = ss;
            }
    }
};

struct EpiDown {
    static constexpr bool PERM = false;
    const bf16_t* X2B; float* out; float* rsq;
    __device__ __forceinline__ void operator()(const f32x4 (&acc)[2][2][4][2], const Unit& u, int wr, int wc, int fr_, int fq_) const {
        int ln_; asm volatile("v_mbcnt_lo_u32_b32 %0, -1, 0\n\tv_mbcnt_hi_u32_b32 %0, -1, %0" : "=v"(ln_)); const int fr = ln_ & 15, fq = ln_ >> 4;
        const int rbase = u.pm * 256 + wr * 64 + fr, col0 = u.pn * 256 + wc * 32 + 4 * fq;
#pragma unroll
        for (int ai = 0; ai < 2; ++ai)
#pragma unroll
            for (int m = 0; m < 4; ++m) {
                const int row = rbase + ai * 128 + m * 16;
                float* yr = nullptr;
                if (row < MPROMPT) { const int b = row / LP, t = row - b * LP; if (t >= 16) yr = out + O_YP + ((size_t)b * 2048 + (t - 16)) * DM + col0; }
                else if (row < MREAL) yr = out + O_YS + (size_t)(row - MPROMPT) * DM + col0;
                const bf16_t* xr = X2B + (size_t)row * DM + col0;
                float ss = 0.f;
#pragma unroll
                for (int bj = 0; bj < 2; ++bj)
#pragma unroll
                    for (int n = 0; n < 2; ++n) {
                        const u32x2 xb = *(const u32x2*)(xr + bj * 128 + n * 16);
                        const f32x4 v = acc[ai][bj][m][n] + (f32x4){bflo(xb.x), bfhi(xb.x), bflo(xb.y), bfhi(xb.y)};
                        ss += (v[0] * v[0] + v[1] * v[1]) + (v[2] * v[2] + v[3] * v[3]);
                        if (yr) *(f32x4*)(yr + bj * 128 + n * 16) = v;
                    }
                ss += __shfl_xor(ss, 16); ss += __shfl_xor(ss, 32);
                if (fq == 0) rsq[(size_t)row * 16 + u.pn * 4 + wc] = ss;
            }
    }
};

struct EpiUp {
    static constexpr bool PERM = true;
    const float* rsq2; const float* cw; const float* stf; bf16_t* act; float* out;
    __device__ __forceinline__ void operator()(const f32x4 (&acc)[2][2][4][2], const Unit& u, int wr, int wc, int fr_, int fq_) const {
        int ln_; asm volatile("v_mbcnt_lo_u32_b32 %0, -1, 0\n\tv_mbcnt_hi_u32_b32 %0, -1, %0" : "=v"(ln_)); const int fr = ln_ & 15, fq = ln_ >> 4;
        const int colg = u.pn * 128 + wc * 32 + fq * 8;
#pragma unroll
        for (int ai = 0; ai < 2; ++ai) {
            const int g0 = u.pm * UP_TROWS + (2 * ai + wr) * 62 - 2 + 4 * fr;
            float rs[4];
#pragma unroll
            for (int m = 0; m < 4; ++m) {
                int g = g0 + m; g = g < 0 ? 0 : g;
                const f32x4* p = (const f32x4*)(rsq2 + (size_t)g * 16);
                const f32x4 s0 = p[0], s1 = p[1], s2 = p[2], s3 = p[3];
                const float s = ((s0[0] + s0[1]) + (s0[2] + s0[3])) + ((s1[0] + s1[1]) + (s1[2] + s1[3])) + ((s2[0] + s2[1]) + (s2[2] + s2[3])) + ((s3[0] + s3[1]) + (s3[2] + s3[3]));
                rs[m] = rsqrtf(s * (1.0f / DM) + EPS);
                asm volatile("" : "+v"(rs[m]));
                __builtin_amdgcn_sched_barrier(0);
            }
#pragma unroll
            for (int n = 0; n < 2; ++n) {
                const int col = colg + 4 * n;
                f32x4 w[2][3];
#pragma unroll
                for (int bj = 0; bj < 2; ++bj)
#pragma unroll
                    for (int k = 0; k < 3; ++k) w[bj][k] = *(const f32x4*)(cw + (size_t)k * NUP + bj * DFF + col);
#pragma unroll
                for (int m = 0; m < 4; ++m) {
                    const int g = g0 + m;
                    const bool vout = (4 * fr + m >= 2) && (g < MREAL);
                    const RowInfo ri = rowinfo(g < 0 ? 0 : g);
                    float y[2][4];
#pragma unroll
                    for (int bj = 0; bj < 2; ++bj) {
                        float cur[4], p1[4], p2[4];
#pragma unroll
                        for (int i = 0; i < 4; ++i) {
                            cur[i] = acc[ai][bj][m][n][i] * rs[m];
                            p1[i] = m >= 1 ? acc[ai][bj][m >= 1 ? m - 1 : 0][n][i] * rs[m >= 1 ? m - 1 : 0] : dpp_shr1(acc[ai][bj][3][n][i] * rs[3]);
                            p2[i] = m >= 2 ? acc[ai][bj][m >= 2 ? m - 2 : 0][n][i] * rs[m >= 2 ? m - 2 : 0] : dpp_shr1(acc[ai][bj][m == 0 ? 2 : 3][n][i] * rs[m == 0 ? 2 : 3]);
                        }
                        if (ri.t < 2) {
                            f32x4 S0 = {0.f, 0.f, 0.f, 0.f}, S1 = {0.f, 0.f, 0.f, 0.f};
                            if (ri.samp && ri.idx < NSB) { S0 = *(const f32x4*)(stf + (size_t)(ri.idx * 2 + 0) * NUP + bj * DFF + col); S1 = *(const f32x4*)(stf + (size_t)(ri.idx * 2 + 1) * NUP + bj * DFF + col); }
#pragma unroll
                            for (int i = 0; i < 4; ++i) { if (ri.t == 0) { p1[i] = S1[i]; p2[i] = S0[i]; } else { p2[i] = S1[i]; } }
                        }
                        if (vout && ri.t >= ri.len - 2) {
                            float* d = out + (ri.samp ? O_SCF : O_PCF) + (size_t)(ri.idx * 2 + (ri.t - (ri.len - 2))) * NUP + bj * DFF + col;
                            *(f32x4*)(d) = (f32x4){cur[0], cur[1], cur[2], cur[3]};
                        }
#pragma unroll
                        for (int i = 0; i < 4; ++i) y[bj][i] = w[bj][0][i] * p2[i] + w[bj][1][i] * p1[i] + w[bj][2][i] * cur[i];
                    }
                    if (vout) {
                        u32x2 pk; pk.x = cvt_pk_bf16(silu_f(y[0][0]) * y[1][0], silu_f(y[0][1]) * y[1][1]); pk.y = cvt_pk_bf16(silu_f(y[0][2]) * y[1][2], silu_f(y[0][3]) * y[1][3]);
                        *(u32x2*)(act + (size_t)g * DFF + col) = pk;
                    }
                    __builtin_amdgcn_sched_barrier(0);
                }
            }
        }
    }
};

#define XB_TMO      128
#define XB_XCNT(j)  (256  + 64 * (j))
#define XB_XSUB(j)  (1280 + 64 * (j))
#define XB_XGEN(j)  (2304 + 64 * (j))
#define XB_TOP      3328
#define XB_TOPGEN   3392
#define XCD_BAR_WORDS 3456
#define XB_SPIN_CAP (1u << 20)
__device__ __forceinline__ unsigned xb_ld(unsigned* p)              { return __hip_atomic_load(p, __ATOMIC_RELAXED, __HIP_MEMORY_SCOPE_AGENT); }
__device__ __forceinline__ unsigned xb_add(unsigned* p, unsigned v) { return __hip_atomic_fetch_add(p, v, __ATOMIC_RELAXED, __HIP_MEMORY_SCOPE_AGENT); }
__device__ __forceinline__ unsigned xb_xcc_id() { return (unsigned)__builtin_amdgcn_s_getreg((3 << 11) | 20) & 0xFu; }
#define XB_SPIN(cond, bar) do { unsigned _sp = 0; while (cond) { __builtin_amdgcn_s_sleep(1); \
    if ((++_sp & 255u) == 0u) { if (xb_ld(&(bar)[XB_TMO])) break; if (_sp > XB_SPIN_CAP) { atomicAdd(&(bar)[XB_TMO], 1u); break; } } } } while (0)
struct XcdBarrier { unsigned* bar; unsigned x; volatile LAS unsigned* st; };
__device__ __forceinline__ XcdBarrier xcd_barrier_post(unsigned* bar, volatile LAS unsigned* st) {
    XcdBarrier b; b.bar = bar; b.x = xb_xcc_id(); b.st = st;
    if (threadIdx.x == 0) (void)xb_add(&bar[XB_XCNT(b.x)], 1u);
    return b;
}
__device__ __forceinline__ void xcd_barrier_complete(unsigned* bar, unsigned x, unsigned& nloc, unsigned& nx) {
    const unsigned G = gridDim.x * gridDim.y * gridDim.z;
    unsigned sum, cnt, mine, sp = 0u;
    for (;;) {
        sum = 0u; cnt = 0u; mine = 0u;
#pragma unroll
        for (unsigned j = 0; j < 16; ++j) { const unsigned c = xb_ld(&bar[XB_XCNT(j)]); sum += c; cnt += (c > 0u) ? 1u : 0u; mine = (j == x) ? c : mine; }
        if (sum == G) break;
        __builtin_amdgcn_s_sleep(1);
        if ((++sp & 255u) == 0u) { if (xb_ld(&bar[XB_TMO])) break; if (sp > XB_SPIN_CAP) { atomicAdd(&bar[XB_TMO], 1u); break; } }
    }
    nloc = mine > 0u ? mine : 1u; nx = cnt > 0u ? cnt : 1u;
}
__device__ __forceinline__ void xcd_barrier(const XcdBarrier& b) {
    asm volatile("s_waitcnt vmcnt(0)" ::: "memory");
    __syncthreads();
    if (threadIdx.x == 0) {
        unsigned* bar = b.bar;
        __builtin_amdgcn_s_waitcnt(0);
        unsigned nloc = b.st[0], nx = b.st[1];
        if (nloc == 0u) { xcd_barrier_complete(bar, b.x, nloc, nx); b.st[0] = nloc; b.st[1] = nx; }
        const unsigned old = xb_add(&bar[XB_XSUB(b.x)], 1u);
        const unsigned gen = old / nloc;
        if (old + 1u == (gen + 1u) * nloc) {
            __builtin_amdgcn_fence(__ATOMIC_RELEASE, "agent");
            asm volatile("s_waitcnt vmcnt(0)" ::: "memory");
            const unsigned og = xb_add(&bar[XB_TOP], 1u);
            const unsigned tg = og / nx;
            if (og + 1u == (tg + 1u) * nx) xb_add(&bar[XB_TOPGEN], 1u);
            else XB_SPIN(xb_ld(&bar[XB_TOPGEN]) == tg, bar);
            __builtin_amdgcn_fence(__ATOMIC_ACQUIRE, "agent");
            xb_add(&bar[XB_XGEN(b.x)], 1u);
            asm volatile("s_waitcnt vmcnt(0)" ::: "memory");
        } else {
            XB_SPIN(xb_ld(&bar[XB_XGEN(b.x)]) == gen, bar);
            __builtin_amdgcn_fence(__ATOMIC_ACQUIRE, "agent");
            asm volatile("s_waitcnt vmcnt(0)" ::: "memory");
        }
    }
    __syncthreads();
}

struct Frame {
    LAS unsigned char* lds;
    int tid, lane, wave, G, blk;
    const float* in[20];
    float* out; unsigned char* ws;
};

__device__ __forceinline__ void p0_transpose_item(const float* W, int ldw, int K, bf16_t* WT, int n0, int srcn0, int k0, const float* kscale, LAS float* scr, int lane) {
#pragma unroll 8
    for (int i = 0; i < 32; ++i) { const int kk = 2 * i + (lane >> 5); float v = W[(size_t)(k0 + kk) * ldw + srcn0 + (lane & 31)]; if (kscale) v *= kscale[k0 + kk]; scr[kk * 33 + (lane & 31)] = v; }
    LDS_WAIT(); asm volatile("" ::: "memory");
    const int c = lane & 7;
#pragma unroll
    for (int j = 0; j < 4; ++j) { const int n = (lane >> 3) + 8 * j; const LAS float* s = scr + (8 * c) * 33 + n;
        u32x4 o; o.x = cvt_pk_bf16(s[0 * 33], s[1 * 33]); o.y = cvt_pk_bf16(s[2 * 33], s[3 * 33]); o.z = cvt_pk_bf16(s[4 * 33], s[5 * 33]); o.w = cvt_pk_bf16(s[6 * 33], s[7 * 33]);
        *(u32x4*)(WT + (size_t)(n0 + n) * K + k0 + 8 * c) = o; }
    LDS_WAIT(); asm volatile("" ::: "memory");
}
__device__ __forceinline__ int in_colmap(int n0) {
    const int pn = n0 >> 8;
    if (pn >= 4) return n0;
    const int c = n0 & 255, bj = c >> 7, cc = c & 127, hl = cc >> 6, j = cc & 63;
    return (pn >= 2 ? 512 : 0) + ((pn & 1) * 2 + hl) * 128 + bj * 64 + j;
}
__device__ __forceinline__ void p0_prologue(Frame& F) {
    const float* w_in = F.in[8]; const float* w_out = F.in[14]; const float* w_up = F.in[16]; const float* w_dn = F.in[18];
    bf16_t* WIN = (bf16_t*)(F.ws + WS_WIN); bf16_t* WOUT = (bf16_t*)(F.ws + WS_WOUT); bf16_t* WUP = (bf16_t*)(F.ws + WS_WUP); bf16_t* WDN = (bf16_t*)(F.ws + WS_WDN);
    LAS float* scr = (LAS float*)(F.lds + F.wave * 8448);
    LAS float* WX = (LAS float*)(F.lds + 69632);
    for (int i = F.tid; i < 1024 * 8; i += 512) WX[i] = w_in[(size_t)(i >> 3) * INW + NIN + (i & 7)];
    const int gw = F.blk * 8 + F.wave, NGW = F.G * 8;
    constexpr int I_IN = 16 * 128, I_OUT = 16 * 32, I_UP = 16 * 176, I_DN = 44 * 32, NIT = I_IN + I_OUT + I_UP + I_DN;
    for (int it = gw; it < NIT; it += NGW) {
        int r = it;
        if (r < I_IN) { const int kb = r / 128, nb = r % 128; p0_transpose_item(w_in, INW, 1024, WIN, nb * 32, in_colmap(nb * 32), kb * 64, nullptr, scr, F.lane); continue; } r -= I_IN;
        if (r < I_OUT) { const int kb = r / 32, nb = r % 32; p0_transpose_item(w_out, 1024, 1024, WOUT, nb * 32, nb * 32, kb * 64, nullptr, scr, F.lane); continue; } r -= I_OUT;
        if (r < I_UP) { const int kb = r / 176, nb = r % 176; const int n0 = nb * 32, pn = n0 >> 8, c = n0 & 255; p0_transpose_item(w_up, NUP, 1024, WUP, n0, (c >> 7) * DFF + pn * 128 + (c & 127), kb * 64, F.in[15], scr, F.lane); continue; } r -= I_UP;
        { const int kb = r / 32, nb = r % 32; p0_transpose_item(w_dn, 1024, DFF, WDN, nb * 32, nb * 32, kb * 64, nullptr, scr, F.lane); }
    }
    __syncthreads();
    bf16_t* H = (bf16_t*)(F.ws + WS_H); float* BG = (float*)(F.ws + WS_BG);
    const float* nm = F.in[7];
    for (int g = gw; g < MPAD; g += NGW) {
        unsigned long long* o8 = (unsigned long long*)(H + (size_t)g * DM) + F.lane;
        if (g >= MREAL) {
#pragma unroll
            for (int j = 0; j < 4; ++j) o8[64 * j] = 0ull;
            continue;
        }
        const f32x4* xr = (const f32x4*)x_src_row(F.in[0], F.in[1], F.in[6], g) + F.lane;
        const f32x4* nr = (const f32x4*)nm + F.lane;
        f32x4 v[4]; float ss = 0.f;
#pragma unroll
        for (int j = 0; j < 4; ++j) { v[j] = xr[64 * j]; ss += (v[j][0] * v[j][0] + v[j][1] * v[j][1]) + (v[j][2] * v[j][2] + v[j][3] * v[j][3]); }
        const float rstd = rsqrtf(wave_sum(ss) * (1.0f / DM) + EPS);
        float ex[8];
#pragma unroll
        for (int e = 0; e < 8; ++e) ex[e] = 0.f;
#pragma unroll
        for (int j = 0; j < 4; ++j) {
            const f32x4 n4 = nr[64 * j];
            v[j] = v[j] * rstd * n4;
            o8[64 * j] = (unsigned long long)cvt_pk_bf16(v[j][0], v[j][1]) | ((unsigned long long)cvt_pk_bf16(v[j][2], v[j][3]) << 32);
#pragma unroll
            for (int i = 0; i < 4; ++i) {
                const int k = 4 * (F.lane + 64 * j) + i;
                const f32x4 wa = *(const LAS f32x4*)(WX + k * 8), wb = *(const LAS f32x4*)(WX + k * 8 + 4);
                ex[0] += v[j][i] * wa[0]; ex[1] += v[j][i] * wa[1]; ex[2] += v[j][i] * wa[2]; ex[3] += v[j][i] * wa[3];
                ex[4] += v[j][i] * wb[0]; ex[5] += v[j][i] * wb[1]; ex[6] += v[j][i] * wb[2]; ex[7] += v[j][i] * wb[3];
            }
        }
#pragma unroll
        for (int e = 0; e < 8; ++e) ex[e] = wave_sum(ex[e]);
        if (F.lane < 4) {
            const int h = F.lane;
            const float gb = h == 0 ? ex[0] : h == 1 ? ex[1] : h == 2 ? ex[2] : ex[3];
            const float ga = h == 0 ? ex[4] : h == 1 ? ex[5] : h == 2 ? ex[6] : ex[7];
            const float beta = 1.0f / (1.0f + __expf(-gb));
            const float xx = ga + F.in[11][h];
            const float sp = xx > 20.f ? xx : log1pf(__expf(xx));
            BG[(size_t)g * 8 + h] = beta;
            BG[(size_t)g * 8 + 4 + h] = -__expf(F.in[10][h]) * sp;
        }
    }
    {
        bf16_t* PGX = (bf16_t*)(F.ws + WS_PGX); const float* stq = F.in[4];
        for (int e = F.blk * 512 + F.tid; e < 385 * GQKV; e += F.G * 512) PGX[e] = e < 384 * GQKV ? (bf16_t)(cvt_pk_bf16(stq[e], 0.f) & 0xffffu) : (bf16_t)0;
    }
    float* ROT = (float*)(F.ws + WS_ROT);
    for (int e = F.blk * 512 + F.tid; e < 2068 * 64; e += F.G * 512) {
        const int p = e >> 6, j = e & 63; const int pos = p < LP ? p : 16384 + (p - LP);
        double f = 1.0, b = 0.8659643233600653523531691834202299819398;
#pragma unroll
        for (int k = 0; k < 6; ++k) { if ((j >> k) & 1) f *= b; b *= b; }
        double rev = (double)pos * f * 0.15915494309189533576888376337251436203445964574046;
        rev -= floor(rev);
        const float rf = (float)rev;
        ROT[(size_t)e * 2] = __builtin_amdgcn_cosf(rf); ROT[(size_t)e * 2 + 1] = __builtin_amdgcn_sinf(rf);
    }
}

struct SeqD { int row0, len, samp, idx; };
__device__ __forceinline__ bf16x8 mk8(s16x4 lo, s16x4 hi) { return (bf16x8){lo[0], lo[1], lo[2], lo[3], hi[0], hi[1], hi[2], hi[3]}; }
__device__ __forceinline__ s16x4 ld_tr(LAS unsigned char* p) { return __builtin_bit_cast(s16x4, __builtin_amdgcn_ds_read_tr16_b64_v4i16((LAS s16x4*)p)); }
__device__ __forceinline__ s16x4 ld_b64(LAS unsigned char* p) { return *(LAS s16x4*)p; }
__device__ __forceinline__ s16x4 pk4(f32x4 v) { u32x2 w; w.x = cvt_pk_bf16(v[0], v[1]); w.y = cvt_pk_bf16(v[2], v[3]); return __builtin_bit_cast(s16x4, w); }

__device__ __forceinline__ int qk_pos(int i, int j) { const int p = (j & ~12) | ((j & 4) << 1) | ((j & 8) >> 1); return (((p >> 3) ^ ((i >> 1) & 7)) << 3) | (p & 7); }
__device__ __forceinline__ void p2a_item(Frame& F, const SeqD sq, int h, int t0, int c, unsigned char* slot) {
    unsigned lbase = (unsigned)(uintptr_t)F.lds; int tid = F.tid;
    asm volatile("" : "+s"(lbase), "+v"(tid));
    LAS unsigned char* L = (LAS unsigned char*)(uintptr_t)lbase;
    LAS float* AM = (LAS float*)(L); LAS float* RHS = (LAS float*)(L + 53248);
    LAS float* GL = (LAS float*)(L + 16384); LAS float* CUM = GL + 64; LAS float* BETA = GL + 128;
    LAS unsigned char* QB = L + 20480; LAS unsigned char* KB = L + 36864;
    const float* BG = (const float*)(F.ws + WS_BG);
    const float* cgw = F.in[9];
    const int r = tid >> 3, cg = tid & 7, lane = tid & 63, w = __builtin_amdgcn_readfirstlane(tid >> 6), fr = lane & 15, fg = lane >> 4;
    const bool valid = r < c;
    const int grow = sq.row0 + t0 + r;
    float beta_r = 0.f, gdec = 0.f;
    if (valid) { beta_r = BG[(size_t)grow * 8 + h]; gdec = BG[(size_t)grow * 8 + 4 + h]; }
    if (cg == 0) GL[r] = gdec;
    LAS float* CW = (LAS float*)(L + 118784);
#pragma unroll
    for (int k = 0; k < 3; ++k) { const int e = tid + 512 * k, dt = e / 384, rem = e - dt * 384; CW[e] = cgw[(size_t)dt * GQKV + (rem >> 7) * 512 + h * 128 + (rem & 127)]; }
    __syncthreads();
    float cum = 0.f, cl = 0.f;
#pragma unroll 8
    for (int j = 0; j < 64; ++j) { const float gj = GL[j]; cl += gj; if (j <= r) cum += gj; }
    const float er = __expf(cum), frr = __expf(cl - cum);
    if (cg == 0) { CUM[r] = cum; BETA[r] = beta_r; }
    if (tid == 0) *(float*)(slot + 73728) = __expf(cl);
#pragma unroll 1
    for (int X = 0; X < 3; ++X) {
        const int colb = X * 512 + h * 128 + 16 * cg;
        float y[16];
#pragma unroll
        for (int i = 0; i < 16; ++i) y[i] = 0.f;
        u32x4 da[4], db[4];
#pragma unroll
        for (int dt = 0; dt < 4; ++dt) {
            const int tt = t0 + r - 3 + dt;
            const unsigned oz = (unsigned)(WS_PGX + ((size_t)384 * GQKV + colb) * 2);
            const unsigned opg = (unsigned)(WS_PG + ((size_t)(sq.row0 + (tt >= 0 ? tt : 0)) * 2048 + colb) * 2);
            const unsigned opx = (unsigned)(WS_PGX + ((size_t)(sq.idx * 3 + (tt < 0 ? 3 + tt : 0)) * GQKV + colb) * 2);
            const unsigned so = valid ? (tt >= 0 ? opg : (sq.samp ? opx : oz)) : oz;
            const u32x4* sp = (const u32x4*)(F.ws + so);
            da[dt] = sp[0]; db[dt] = sp[1];
        }
#pragma unroll
        for (int dt = 0; dt < 4; ++dt) {
            const u32x4 a = da[dt], b = db[dt];
            const float xv[16] = {bflo(a.x), bfhi(a.x), bflo(a.y), bfhi(a.y), bflo(a.z), bfhi(a.z), bflo(a.w), bfhi(a.w), bflo(b.x), bfhi(b.x), bflo(b.y), bfhi(b.y), bflo(b.z), bfhi(b.z), bflo(b.w), bfhi(b.w)};
            const LAS f32x4* wp = (const LAS f32x4*)(CW + dt * 384 + X * 128 + 16 * cg);
#pragma unroll
            for (int k = 0; k < 4; ++k) { const f32x4 wv = wp[k]; y[4 * k] += wv[0] * xv[4 * k]; y[4 * k + 1] += wv[1] * xv[4 * k + 1]; y[4 * k + 2] += wv[2] * xv[4 * k + 2]; y[4 * k + 3] += wv[3] * xv[4 * k + 3]; }
        }
        float ss = 0.f;
#pragma unroll
        for (int i = 0; i < 16; ++i) { y[i] = valid ? silu_f(y[i]) : 0.f; ss += y[i] * y[i]; }
        ss += __shfl_xor(ss, 1); ss += __shfl_xor(ss, 2); ss += __shfl_xor(ss, 4);
        const float nrm = X == 0 ? rsqrtf(ss + EPS) * 0.08838834764831845f : (X == 1 ? rsqrtf(ss + EPS) : 1.0f);
        u32x4 p0, p1;
        p0.x = cvt_pk_bf16(y[0] * nrm, y[1] * nrm); p0.y = cvt_pk_bf16(y[2] * nrm, y[3] * nrm); p0.z = cvt_pk_bf16(y[4] * nrm, y[5] * nrm); p0.w = cvt_pk_bf16(y[6] * nrm, y[7] * nrm);
        p1.x = cvt_pk_bf16(y[8] * nrm, y[9] * nrm); p1.y = cvt_pk_bf16(y[10] * nrm, y[11] * nrm); p1.z = cvt_pk_bf16(y[12] * nrm, y[13] * nrm); p1.w = cvt_pk_bf16(y[14] * nrm, y[15] * nrm);
        const float z[16] = {bflo(p0.x), bfhi(p0.x), bflo(p0.y), bfhi(p0.y), bflo(p0.z), bfhi(p0.z), bflo(p0.w), bfhi(p0.w), bflo(p1.x), bfhi(p1.x), bflo(p1.y), bfhi(p1.y), bflo(p1.z), bfhi(p1.z), bflo(p1.w), bfhi(p1.w)};
        if (X < 2) {
            LAS unsigned char* dstl = (X == 0 ? QB : KB) + r * 256;
            *(LAS u32x4*)(dstl + (((2 * cg) ^ (r & 15)) * 16)) = p0; *(LAS u32x4*)(dstl + (((2 * cg + 1) ^ (r & 15)) * 16)) = p1;
            const float sc = X == 0 ? er : frr;
            u32x4 d0, d1;
            d0.x = cvt_pk_bf16(z[0] * sc, z[1] * sc); d0.y = cvt_pk_bf16(z[2] * sc, z[3] * sc); d0.z = cvt_pk_bf16(z[4] * sc, z[5] * sc); d0.w = cvt_pk_bf16(z[6] * sc, z[7] * sc);
            d1.x = cvt_pk_bf16(z[8] * sc, z[9] * sc); d1.y = cvt_pk_bf16(z[10] * sc, z[11] * sc); d1.z = cvt_pk_bf16(z[12] * sc, z[13] * sc); d1.w = cvt_pk_bf16(z[14] * sc, z[15] * sc);
            if (X == 0) { const u32x4 e0 = {d0.x, d0.y, d1.x, d1.y}, e1 = {d0.z, d0.w, d1.z, d1.w};
                *(u32x4*)(slot + 16384 + r * 256 + (((2 * cg) ^ (r & 15)) * 16)) = e0; *(u32x4*)(slot + 16384 + r * 256 + (((2 * cg + 1) ^ (r & 15)) * 16)) = e1; }
            else { u32x4* gd = (u32x4*)(slot + 32768 + r * 256 + (((cg >> 1) ^ (r & 3)) * 64) + (cg & 1) * 32); gd[0] = d0; gd[1] = d1; }
        }
        if (X >= 1) {
            const float sc = X == 1 ? beta_r * er : beta_r;
            LAS float* rd = RHS + r * 256 + (X == 1 ? 128 : 0) + 16 * cg;
#pragma unroll
            for (int k = 0; k < 4; ++k) *(LAS f32x4*)(rd + 4 * k) = (f32x4){z[4 * k] * sc, z[4 * k + 1] * sc, z[4 * k + 2] * sc, z[4 * k + 3] * sc};
        }
    }
    __syncthreads();
    {
        bf16_t* QK = (bf16_t*)(slot + 49152);
#pragma unroll
        for (int rep = 0; rep < 2; ++rep) {
            const int idx = w + 8 * rep, it = idx >> 2, jt = idx & 3;
            const int jcol = 16 * jt + fr;
            if (it >= jt) {
                f32x4 akk = {0.f, 0.f, 0.f, 0.f}, aqk = {0.f, 0.f, 0.f, 0.f};
#pragma unroll
                for (int s = 0; s < 4; ++s) {
                    const int ri = 16 * it + fr, rj = 16 * jt + fr;
                    const bf16x8 bk = *(LAS bf16x8*)(KB + rj * 256 + (((4 * s + fg) ^ (rj & 15)) * 16));
                    const bf16x8 ak = *(LAS bf16x8*)(KB + ri * 256 + (((4 * s + fg) ^ (ri & 15)) * 16));
                    const bf16x8 aq = *(LAS bf16x8*)(QB + ri * 256 + (((4 * s + fg) ^ (ri & 15)) * 16));
                    akk = __builtin_amdgcn_mfma_f32_16x16x32_bf16(ak, bk, akk, 0, 0, 0);
                    aqk = __builtin_amdgcn_mfma_f32_16x16x32_bf16(aq, bk, aqk, 0, 0, 0);
                }
                const float cj = CUM[jcol];
#pragma unroll
                for (int rr = 0; rr < 4; ++rr) {
                    const int i_ = 16 * it + 4 * fg + rr;
                    const float dec = i_ >= jcol ? __expf(CUM[i_] - cj) : 0.f;
                    AM[i_ * 64 + jcol] = i_ > jcol ? BETA[i_] * akk[rr] * dec : 0.f;
                    QK[i_ * 64 + qk_pos(i_, jcol)] = (bf16_t)(cvt_pk_bf16(aqk[rr] * dec, 0.f) & 0xffffu);
                }
            } else {
#pragma unroll
                for (int rr = 0; rr < 4; ++rr) { const int i_ = 16 * it + 4 * fg + rr; QK[i_ * 64 + qk_pos(i_, jcol)] = 0; }
            }
        }
    }
    __syncthreads();
    {
        const int col = tid >> 1, hh = tid & 1;
        unsigned amo = (unsigned)(uintptr_t)AM + hh * 16u, r0 = (unsigned)(uintptr_t)RHS + col * 4u + hh * 4096u, r1 = (unsigned)(uintptr_t)RHS + col * 4u - hh * 4096u;
        asm volatile("" : "+v"(amo), "+v"(r0), "+v"(r1));
        LAS unsigned char* amb = (LAS unsigned char*)(uintptr_t)amo; LAS unsigned char* rb0 = (LAS unsigned char*)(uintptr_t)r0; LAS unsigned char* rb1 = (LAS unsigned char*)(uintptr_t)r1;
        float xs[64];
#pragma unroll
        for (int k = 0; k < 64; ++k) xs[k] = (k & 4) ? *(LAS float*)(rb1 + k * 1024) : *(LAS float*)(rb0 + k * 1024);
#pragma unroll
        for (int i = 1; i < 64; ++i) {
            float a0 = 0.f, a1 = 0.f;
#pragma unroll
            for (int q = 0; q < 8; ++q) {
                if (8 * q < i) { const f32x4 cq = *(LAS f32x4*)(amb + i * 256 + q * 32); a0 += cq[0] * xs[8 * q]; a1 += cq[1] * xs[8 * q + 1]; a0 += cq[2] * xs[8 * q + 2]; a1 += cq[3] * xs[8 * q + 3]; }
            }
            float a = a0 + a1;
            a += __int_as_float(__builtin_amdgcn_update_dpp(0, __float_as_int(a), 0xB1, 0xf, 0xf, true));
            const float v = (hh ? xs[i ^ 4] : xs[i]) - a;
            xs[i] = hh ? xs[i] : v; xs[i ^ 4] = hh ? v : xs[i ^ 4];
            asm volatile("" ::: "memory");
        }
        unsigned char* rowp = col < 128 ? slot + 57344 + col * 128 : slot + (col - 128) * 128;
        const int wsw = col < 128 ? 0 : (((col - 128) >> 1) & 1);
#pragma unroll
        for (int k = 0; k < 4; ++k) {
            u32x4* dst = (u32x4*)(rowp + ((hh ^ wsw) * 64) + k * 16);
            const int e = 8 * k;
            u32x4 o;
            o.x = cvt_pk_bf16(hh ? xs[(32 + e) ^ 4] : xs[e], hh ? xs[(33 + e) ^ 4] : xs[e + 1]); o.y = cvt_pk_bf16(hh ? xs[(34 + e) ^ 4] : xs[e + 2], hh ? xs[(35 + e) ^ 4] : xs[e + 3]);
            o.z = cvt_pk_bf16(hh ? xs[(36 + e) ^ 4] : xs[e + 4], hh ? xs[(37 + e) ^ 4] : xs[e + 5]); o.w = cvt_pk_bf16(hh ? xs[(38 + e) ^ 4] : xs[e + 6], hh ? xs[(39 + e) ^ 4] : xs[e + 7]);
            *dst = o;
        }
    }
    __syncthreads();
}

constexpr int OS_PITCH = 132;
__device__ __forceinline__ void os_write(LAS unsigned char* OSb, const f32x4 (&o)[4], int w, int fr, int fg) {
    LAS float* OS = (LAS float*)OSb;
#pragma unroll
    for (int mt = 0; mt < 4; ++mt)
#pragma unroll
        for (int rr = 0; rr < 4; ++rr) OS[(16 * mt + 4 * fg + rr) * OS_PITCH + 16 * w + fr] = o[mt][rr];
}
template <int MODE  >
__device__ __forceinline__ void os_finish(LAS unsigned char* OSb, int tid, int h, int grow0, int c, const f32x4 (&nwv)[4], u32x4 ga, u32x4 gb, bf16_t* mix) {
    LAS float* OS = (LAS float*)OSb;
    const int r = tid >> 3, cg = tid & 7;
    f32x4 v[4];
#pragma unroll
    for (int k = 0; k < 4; ++k) v[k] = *(LAS f32x4*)(OS + r * OS_PITCH + 16 * cg + 4 * k);
    float rstd;
    if (MODE == 0) {
        float s = 0.f;
#pragma unroll
        for (int k = 0; k < 4; ++k) s += (v[k][0] + v[k][1]) + (v[k][2] + v[k][3]);
        s += __shfl_xor(s, 1); s += __shfl_xor(s, 2); s += __shfl_xor(s, 4);
        const float mu = s * (1.0f / 128.0f);
        float q = 0.f;
#pragma unroll
        for (int k = 0; k < 4; ++k) { v[k] = v[k] - mu; q += (v[k][0] * v[k][0] + v[k][1] * v[k][1]) + (v[k][2] * v[k][2] + v[k][3] * v[k][3]); }
        q += __shfl_xor(q, 1); q += __shfl_xor(q, 2); q += __shfl_xor(q, 4);
        rstd = rsqrtf(q * (1.0f / 128.0f) + EPS);
    } else {
        float q = 0.f;
#pragma unroll
        for (int k = 0; k < 4; ++k) q += (v[k][0] * v[k][0] + v[k][1] * v[k][1]) + (v[k][2] * v[k][2] + v[k][3] * v[k][3]);
        q += __shfl_xor(q, 1); q += __shfl_xor(q, 2); q += __shfl_xor(q, 4);
        rstd = rsqrtf(q * (1.0f / 128.0f) + EPS);
    }
    if (r < c) {
        const float gt[16] = {bflo(ga.x), bfhi(ga.x), bflo(ga.y), bfhi(ga.y), bflo(ga.z), bfhi(ga.z), bflo(ga.w), bfhi(ga.w), bflo(gb.x), bfhi(gb.x), bflo(gb.y), bfhi(gb.y), bflo(gb.z), bfhi(gb.z), bflo(gb.w), bfhi(gb.w)};
        float y[16];
#pragma unroll
        for (int k = 0; k < 4; ++k)
#pragma unroll
            for (int i = 0; i < 4; ++i) y[4 * k + i] = v[k][i] * rstd * nwv[k][i] * gt[4 * k + i];
        u32x4 o0, o1;
        o0.x = cvt_pk_bf16(y[0], y[1]); o0.y = cvt_pk_bf16(y[2], y[3]); o0.z = cvt_pk_bf16(y[4], y[5]); o0.w = cvt_pk_bf16(y[6], y[7]);
        o1.x = cvt_pk_bf16(y[8], y[9]); o1.y = cvt_pk_bf16(y[10], y[11]); o1.z = cvt_pk_bf16(y[12], y[13]); o1.w = cvt_pk_bf16(y[14], y[15]);
        u32x4* mp = (u32x4*)(mix + (size_t)(grow0 + r) * DM + (MODE == 0 ? 0 : 512) + h * 128 + 16 * cg);
        mp[0] = o0; mp[1] = o1;
    }
}

__device__ __forceinline__ void make_sb(const f32x4 (&S)[8], bf16x8 (&Sb)[4]) {
#pragma unroll
    for (int s = 0; s < 4; ++s) Sb[s] = mk8(pk4(S[2 * s]), pk4(S[2 * s + 1]));
}
__device__ __forceinline__ void chunk_of(const SeqD& sq, int n, int& t0, int& c) { if (sq.samp) { t0 = 0; c = 4; } else if (n == 0) { t0 = 0; c = 16; } else { t0 = 16 + 64 * (n - 1); c = 64; } }
constexpr int SCAN_BUF = 57344;

typedef float f32x16 __attribute__((ext_vector_type(16)));
constexpr int SC_IMG = 57344, SC_OS = 114688, SC_OSB = 17408, OST_PITCH = 136;
__device__ __forceinline__ void glds16(const void* gsrc, unsigned lds_dst) { unsigned keep;
    asm volatile("s_mov_b32 %0, m0\n\ts_mov_b32 m0, %2\n\ts_nop 0\n\tglobal_load_lds_dwordx4 %1, off\n\ts_mov_b32 m0, %0" : "=&s"(keep) : "v"(gsrc), "s"(lds_dst) : "memory"); }
__device__ __forceinline__ f32x16 mfma32(bf16x8 a, bf16x8 b, f32x16 c) { return __builtin_amdgcn_mfma_f32_32x32x16_bf16(a, b, c, 0, 0, 0); }
__device__ __forceinline__ bf16x8 pk8(const f32x16& v, int s) {
    u32x4 w; w.x = cvt_pk_bf16(v[8 * s], v[8 * s + 1]); w.y = cvt_pk_bf16(v[8 * s + 2], v[8 * s + 3]); w.z = cvt_pk_bf16(v[8 * s + 4], v[8 * s + 5]); w.w = cvt_pk_bf16(v[8 * s + 6], v[8 * s + 7]);
    return __builtin_bit_cast(bf16x8, w);
}
template <int MODE  >
__device__ __forceinline__ void scan_finish(LAS unsigned char* OSb, int hw, int lane, int h, int grow0, int c, const float* nw, const u32x4 (&gpre)[4], bf16_t* mix) {
    const int i16 = lane & 15, g = lane >> 4, tok = 16 * hw + i16;
    float v[32];
#pragma unroll
    for (int k = 0; k < 8; ++k) {
        const s16x4 t4 = ld_tr(OSb + (32 * g + 4 * k + (i16 >> 2)) * OST_PITCH + (16 * hw + 4 * (i16 & 3)) * 2);
        const u32x2 t2 = __builtin_bit_cast(u32x2, t4);
        v[4 * k] = bflo(t2.x); v[4 * k + 1] = bfhi(t2.x); v[4 * k + 2] = bflo(t2.y); v[4 * k + 3] = bfhi(t2.y);
    }
    float rstd;
    if (MODE == 0) {
        float s = 0.f;
#pragma unroll
        for (int k = 0; k < 32; ++k) s += v[k];
        s += __shfl_xor(s, 16); s += __shfl_xor(s, 32);
        const float mu = s * (1.0f / 128.0f);
        float q = 0.f;
#pragma unroll
        for (int k = 0; k < 32; ++k) { v[k] -= mu; q += v[k] * v[k]; }
        q += __shfl_xor(q, 16); q += __shfl_xor(q, 32);
        rstd = rsqrtf(q * (1.0f / 128.0f) + EPS);
    } else {
        float q = 0.f;
#pragma unroll
        for (int k = 0; k < 32; ++k) q += v[k] * v[k];
        q += __shfl_xor(q, 16); q += __shfl_xor(q, 32);
        rstd = rsqrtf(q * (1.0f / 128.0f) + EPS);
    }
    if (tok < c) {
        const f32x4* np = (const f32x4*)(nw + (MODE == 0 ? h * 128 : 0) + 32 * g);
        u32x4* mp = (u32x4*)(mix + (size_t)(grow0 + tok) * DM + (MODE == 0 ? 0 : 512) + h * 128 + 32 * g);
#pragma unroll
        for (int k = 0; k < 4; ++k) {
            const u32x4 gv = gpre[k]; const f32x4 n0 = np[2 * k], n1 = np[2 * k + 1];
            u32x4 o;
            o.x = cvt_pk_bf16(v[8 * k] * rstd * n0[0] * bflo(gv.x), v[8 * k + 1] * rstd * n0[1] * bfhi(gv.x));
            o.y = cvt_pk_bf16(v[8 * k + 2] * rstd * n0[2] * bflo(gv.y), v[8 * k + 3] * rstd * n0[3] * bfhi(gv.y));
            o.z = cvt_pk_bf16(v[8 * k + 4] * rstd * n1[0] * bflo(gv.z), v[8 * k + 5] * rstd * n1[1] * bfhi(gv.z));
            o.w = cvt_pk_bf16(v[8 * k + 6] * rstd * n1[2] * bflo(gv.w), v[8 * k + 7] * rstd * n1[3] * bfhi(gv.w));
            mp[k] = o;
        }
    }
}

__device__ __forceinline__ void scan_gdn(Frame& F, const SeqD sq, int h, int nchunks, const unsigned char* slot0, const float* sinit, float* sfinal) {
    unsigned lbase = (unsigned)(uintptr_t)F.lds; int tid = F.tid;
    asm volatile("" : "+s"(lbase), "+v"(tid));
    LAS unsigned char* L = (LAS unsigned char*)(uintptr_t)lbase;
    const int lane = tid & 63, w8 = __builtin_amdgcn_readfirstlane(tid >> 6), w = w8 & 3;
    const bool isM = w8 < 4;
    const bf16_t* PG = (const bf16_t*)(F.ws + WS_PG);
    bf16_t* mix = (bf16_t*)((unsigned char*)F.out + OS_MIX);
    const int r = lane & 31, hh = lane >> 5, i16 = lane & 15, g16 = lane >> 4;
    f32x16 S[4]; bf16x8 Sb[4][2];
    u32x2 ur[2][4]; float cdn = 1.0f;
#define GSET(k, v) do { ur[(k) >> 1][((k) & 1) * 2] = (u32x2){(v).x, (v).y}; ur[(k) >> 1][((k) & 1) * 2 + 1] = (u32x2){(v).z, (v).w}; } while (0)
    const int uoff = 57344 + ((32 * w + r) * 64 + 4 * hh) * 2;
    if (isM) {
#pragma unroll
        for (int t = 0; t < 4; ++t)
#pragma unroll
            for (int e = 0; e < 16; ++e) S[t][e] = sinit ? sinit[(32 * t + (e & 3) + 8 * (e >> 2) + 4 * hh) * 128 + 32 * w + r] : 0.f;
#pragma unroll
        for (int t = 0; t < 4; ++t) { Sb[t][0] = pk8(S[t], 0); Sb[t][1] = pk8(S[t], 1); }
#pragma unroll
        for (int mt = 0; mt < 2; ++mt)
#pragma unroll
            for (int q = 0; q < 4; ++q) ur[mt][q] = *(const u32x2*)(slot0 + uoff + 64 * mt + 16 * q);
        cdn = *(const float*)(slot0 + 73728);
    } else {
#pragma unroll
        for (int k = 0; k < 14; ++k) { const int pc = w + 4 * k; glds16(slot0 + pc * 1024 + lane * 16, lbase + pc * 1024); }
        { int t0, c; chunk_of(sq, 0, t0, c); const int tok = 16 * w + (lane & 15);
          if (tok < c) { const u32x4* gp = (const u32x4*)(PG + (size_t)(sq.row0 + t0 + tok) * 2048 + 1536 + h * 128 + 32 * (lane >> 4));
#pragma unroll
              for (int k = 0; k < 4; ++k) { const u32x4 gv = gp[k]; GSET(k, gv); } } }
        asm volatile("s_waitcnt vmcnt(0)" ::: "memory");
    }
    __syncthreads();
    unsigned accA = 0, accB = 0;
    for (int n = 0; n <= nchunks; ++n) {
        LAS unsigned char* Bc = L + (n & 1) * SC_IMG; LAS unsigned char* Bn = L + ((n & 1) ^ 1) * SC_IMG;
        LAS unsigned char* OSc = L + SC_OS + (n & 1) * SC_OSB; LAS unsigned char* OSp = L + SC_OS + ((n & 1) ^ 1) * SC_OSB;
        const unsigned char* img = slot0 + (size_t)n * SLOT;
        const unsigned tq0 = MK_TPROBE ? (unsigned)__builtin_amdgcn_s_memrealtime() : 0u;
        if (isM) {
            if (n < nchunks) {
                int lane_ = lane; asm volatile("" : "+v"(lane_));
                const int r_ = lane_ & 31, hh_ = lane_ >> 5, i16_ = lane_ & 15, gb_ = (lane_ >> 4) & 1;
                const float cd = cdn;
                f32x16 u[2];
#pragma unroll
                for (int mt = 0; mt < 2; ++mt)
#pragma unroll
                    for (int q = 0; q < 4; ++q) { u[mt][4 * q] = bflo(ur[mt][q].x); u[mt][4 * q + 1] = bfhi(ur[mt][q].x); u[mt][4 * q + 2] = bflo(ur[mt][q].y); u[mt][4 * q + 3] = bfhi(ur[mt][q].y); }
                if (n + 1 < nchunks) {
#pragma unroll
                    for (int mt = 0; mt < 2; ++mt)
#pragma unroll
                        for (int q = 0; q < 4; ++q) ur[mt][q] = *(const u32x2*)(img + SLOT + uoff + 64 * mt + 16 * q);
                    cdn = *(const float*)(img + SLOT + 73728);
                }
                const int trc = 32 * gb_ + 8 * (i16_ & 3);
                f32x16 wv[2];
#pragma unroll
                for (int mt = 0; mt < 2; ++mt) {
                    f32x16 a;
#pragma unroll
                    for (int e = 0; e < 16; ++e) a[e] = 0.f;
#pragma unroll
                    for (int t = 0; t < 4; ++t)
#pragma unroll
                        for (int s = 0; s < 2; ++s) {
                            const int ra = 32 * t + 16 * s + 4 * hh_ + (i16_ >> 2), rb = ra + 8;
                            const s16x4 lo = ld_tr(Bc + ra * 128 + ((mt ^ ((ra >> 1) & 1)) * 64) + trc);
                            const s16x4 hi = ld_tr(Bc + rb * 128 + ((mt ^ ((rb >> 1) & 1)) * 64) + trc);
                            a = mfma32(mk8(lo, hi), Sb[t][s], a);
                        }
                    wv[mt] = u[mt] - a;
                }
                bf16x8 wb[2][2];
#pragma unroll
                for (int mt = 0; mt < 2; ++mt) { wb[mt][0] = pk8(wv[mt], 0); wb[mt][1] = pk8(wv[mt], 1); }
#pragma unroll
                for (int mt = 0; mt < 2; ++mt) {
                    f32x16 a;
#pragma unroll
                    for (int e = 0; e < 16; ++e) a[e] = 0.f;
                    const int row = 32 * mt + r_;
#pragma unroll
                    for (int t = 0; t < 4; ++t)
#pragma unroll
                        for (int s = 0; s < 2; ++s) {
                            const bf16x8 af = *(LAS bf16x8*)(Bc + 16384 + row * 256 + (((2 * (2 * t + s) + hh_) ^ (row & 15)) * 16));
                            a = mfma32(af, Sb[t][s], a);
                        }
#pragma unroll
                    for (int m2 = 0; m2 <= mt; ++m2)
#pragma unroll
                        for (int s = 0; s < 2; ++s) {
                            const bf16x8 af = *(LAS bf16x8*)(Bc + 49152 + row * 128 + (((2 * (2 * m2 + s) + hh_) ^ ((row >> 1) & 7)) * 16));
                            a = mfma32(af, wb[m2][s], a);
                        }
#pragma unroll
                    for (int q = 0; q < 4; ++q) { u32x2 pkd; pkd.x = cvt_pk_bf16(a[4 * q], a[4 * q + 1]); pkd.y = cvt_pk_bf16(a[4 * q + 2], a[4 * q + 3]);
                        *(LAS u32x2*)(OSc + (32 * w + r_) * OST_PITCH + (32 * mt + 8 * q + 4 * hh_) * 2) = pkd; }
                }
#pragma unroll
                for (int t = 0; t < 4; ++t) {
                    f32x16 a = S[t] * cd;
#pragma unroll
                    for (int m2 = 0; m2 < 2; ++m2)
#pragma unroll
                        for (int s = 0; s < 2; ++s) {
                            const int ra = 32 * m2 + 16 * s + 4 * hh_ + (i16_ >> 2), rb = ra + 8;
                            const s16x4 lo = ld_tr(Bc + 32768 + ra * 256 + ((t ^ (ra & 3)) * 64) + trc);
                            const s16x4 hi = ld_tr(Bc + 32768 + rb * 256 + ((t ^ (rb & 3)) * 64) + trc);
                            a = mfma32(mk8(lo, hi), wb[m2][s], a);
                        }
                    S[t] = a;
                }
#pragma unroll
                for (int t = 0; t < 4; ++t) { Sb[t][0] = pk8(S[t], 0); Sb[t][1] = pk8(S[t], 1); }
            }
        } else {
            if (n + 1 < nchunks) {
                const unsigned bn = lbase + ((n & 1) ^ 1) * SC_IMG;
#pragma unroll
                for (int k = 0; k < 14; ++k) { const int pc = w + 4 * k; glds16(img + SLOT + pc * 1024 + lane * 16, bn + pc * 1024); }
            }
            if (n >= 1) { int t0, c; chunk_of(sq, n - 1, t0, c);
                const u32x4 gpre[4] = {{ur[0][0].x, ur[0][0].y, ur[0][1].x, ur[0][1].y}, {ur[0][2].x, ur[0][2].y, ur[0][3].x, ur[0][3].y}, {ur[1][0].x, ur[1][0].y, ur[1][1].x, ur[1][1].y}, {ur[1][2].x, ur[1][2].y, ur[1][3].x, ur[1][3].y}};
                scan_finish<1>(OSp, w, lane, h, sq.row0 + t0, c, F.in[13], gpre, mix); }
            if (n < nchunks) { int t0, c; chunk_of(sq, n, t0, c); const int tok = 16 * w + (lane & 15);
                if (tok < c) { const u32x4* gp = (const u32x4*)(PG + (size_t)(sq.row0 + t0 + tok) * 2048 + 1536 + h * 128 + 32 * (lane >> 4));
#pragma unroll
                    for (int k = 0; k < 4; ++k) { const u32x4 gv = gp[k]; GSET(k, gv); } } }
            asm volatile("s_waitcnt vmcnt(0)" ::: "memory");
        }
        const unsigned tq1 = MK_TPROBE ? (unsigned)__builtin_amdgcn_s_memrealtime() : 0u;
        __syncthreads();
        const unsigned tq2 = MK_TPROBE ? (unsigned)__builtin_amdgcn_s_memrealtime() : 0u;
        accA += tq1 - tq0; accB += tq2 - tq1;
    }
    if (MK_TPROBE && nchunks > 1 && (tid == 0 || tid == 256)) { unsigned* TS = (unsigned*)(F.ws + WS_CTL) + CW_TS; const int o_ = tid ? 2 : 0; TS[(9 + o_) * 256 + F.blk] = accA; TS[(10 + o_) * 256 + F.blk] = accB; }
    if (isM) {
#pragma unroll
        for (int t = 0; t < 4; ++t)
#pragma unroll
            for (int e = 0; e < 16; ++e) sfinal[(32 * t + (e & 3) + 8 * (e >> 2) + 4 * hh) * 128 + 32 * w + r] = S[t][e];
    }
    __syncthreads();
}

#undef GSET
__device__ __forceinline__ int swb(int row) { return ((row & 3) << 2) | ((row >> 2) & 3); }
__device__ __forceinline__ void scan_ret(Frame& F, const SeqD sq, int h, int nchunks, const float* sinit, float* sfinal) {
    unsigned lbase = (unsigned)(uintptr_t)F.lds; int tid = F.tid;
    asm volatile("" : "+s"(lbase), "+v"(tid));
    LAS unsigned char* L = (LAS unsigned char*)(uintptr_t)lbase;
    const int lane = tid & 63, w = __builtin_amdgcn_readfirstlane(tid >> 6), fr = lane & 15, fg = lane >> 4;
    const bf16_t* PR = (const bf16_t*)(F.ws + WS_PR);
    bf16_t* mix = (bf16_t*)((unsigned char*)F.out + OS_MIX);
    const float lg = h == 0 ? -0.04580368961312479f : h == 1 ? -0.02272007650008353f : h == 2 ? -0.011315313227834146f : -0.005646563141142063f;
    f32x4 nwv[4];
#pragma unroll
    for (int k = 0; k < 4; ++k) nwv[k] = *(const f32x4*)(F.in[12] + h * 128 + 16 * (tid & 7) + 4 * k);
    f32x4 S[8]; bf16x8 Sb[4];
#pragma unroll
    for (int t = 0; t < 8; ++t) {
        if (sinit) { S[t] = (f32x4){sinit[(16 * t + 4 * fg + 0) * 128 + 16 * w + fr], sinit[(16 * t + 4 * fg + 1) * 128 + 16 * w + fr], sinit[(16 * t + 4 * fg + 2) * 128 + 16 * w + fr], sinit[(16 * t + 4 * fg + 3) * 128 + 16 * w + fr]}; }
        else S[t] = (f32x4){0.f, 0.f, 0.f, 0.f};
    }
    make_sb(S, Sb);
    const int lr = tid >> 3, lpart = tid & 7;
    const int lsw = swb(lr);
    u32x4 RQ[6];
    {
        int t0, c; chunk_of(sq, 0, t0, c);
#pragma unroll
        for (int X = 0; X < 3; ++X) { RQ[2 * X] = (u32x4){0u, 0u, 0u, 0u}; RQ[2 * X + 1] = RQ[2 * X];
            if (lr < c) { const u32x4* p = (const u32x4*)(PR + (size_t)(sq.row0 + t0 + lr) * 2048 + X * 512 + h * 128 + 16 * lpart); RQ[2 * X] = p[0]; RQ[2 * X + 1] = p[1]; } }
#pragma unroll
        for (int X = 0; X < 3; ++X) { *(LAS u32x4*)(L + X * 16384 + lr * 256 + (((2 * lpart) ^ lsw) * 16)) = RQ[2 * X]; *(LAS u32x4*)(L + X * 16384 + lr * 256 + (((2 * lpart + 1) ^ lsw) * 16)) = RQ[2 * X + 1]; }
    }
    __syncthreads();
    for (int n = 0; n < nchunks; ++n) {
        LAS unsigned char* Bc = L + (n & 1) * SCAN_BUF; LAS unsigned char* Bn = L + ((n & 1) ^ 1) * SCAN_BUF;
        int lane_ = lane; asm volatile("" : "+v"(lane_));
        const int fr = lane_ & 15, fg = lane_ >> 4, swr = swb(fr);
        int t0, c; chunk_of(sq, n, t0, c);
        const bool more = n + 1 < nchunks;
        if (more) {
            int t1, c1; chunk_of(sq, n + 1, t1, c1);
#pragma unroll
            for (int X = 0; X < 3; ++X) { RQ[2 * X] = (u32x4){0u, 0u, 0u, 0u}; RQ[2 * X + 1] = RQ[2 * X];
                if (lr < c1) { const u32x4* p = (const u32x4*)(PR + (size_t)(sq.row0 + t1 + lr) * 2048 + X * 512 + h * 128 + 16 * lpart); RQ[2 * X] = p[0]; RQ[2 * X + 1] = p[1]; } }
        }
        u32x4 ga = {0u, 0u, 0u, 0u}, gb = ga;
        if (lr < c) { const u32x4* gp = (const u32x4*)(PR + (size_t)(sq.row0 + t0 + lr) * 2048 + 1536 + h * 128 + 16 * lpart); ga = gp[0]; gb = gp[1]; }
#pragma unroll
        for (int rep = 0; rep < 2; ++rep) {
            const int idx = w + 8 * rep, it = idx >> 2, jt = idx & 3, jcol = 16 * jt + fr;
            LAS bf16_t* Pb = (LAS bf16_t*)(Bc + 49152);
            f32x4 a = {0.f, 0.f, 0.f, 0.f};
            if (it >= jt) {
#pragma unroll
                for (int s = 0; s < 4; ++s) {
                    const bf16x8 aq = *(LAS bf16x8*)(Bc + (16 * it + fr) * 256 + (((4 * s + fg) ^ swr) * 16));
                    const bf16x8 bk = *(LAS bf16x8*)(Bc + 16384 + (16 * jt + fr) * 256 + (((4 * s + fg) ^ swr) * 16));
                    a = __builtin_amdgcn_mfma_f32_16x16x32_bf16(aq, bk, a, 0, 0, 0);
                }
            }
#pragma unroll
            for (int rr = 0; rr < 4; ++rr) {
                const int i_ = 16 * it + 4 * fg + rr;
                const float p = (it >= jt && i_ >= jcol) ? a[rr] * exp2f(lg * (float)(i_ - jcol)) : 0.f;
                Pb[i_ * 64 + ((((jcol >> 3) ^ ((i_ >> 1) & 7)) << 3) | (jcol & 7))] = (bf16_t)(cvt_pk_bf16(p, 0.f) & 0xffffu);
            }
        }
        __syncthreads();
        s16x4 vlo[2], vhi[2];
#pragma unroll
        for (int s = 0; s < 2; ++s) {
            const int r0 = 32 * s + 8 * fg + (fr >> 2), r1 = r0 + 4;
            vlo[s] = ld_tr(Bc + 32768 + r0 * 256 + (((2 * w + ((fr & 3) >> 1)) ^ swb(r0)) * 16) + (fr & 1) * 8);
            vhi[s] = ld_tr(Bc + 32768 + r1 * 256 + (((2 * w + ((fr & 3) >> 1)) ^ swb(r1)) * 16) + (fr & 1) * 8);
        }
        f32x4 o[4];
#pragma unroll
        for (int mt = 0; mt < 4; ++mt) {
            f32x4 a1 = {0.f, 0.f, 0.f, 0.f}, a2 = {0.f, 0.f, 0.f, 0.f};
            const int row = 16 * mt + fr;
#pragma unroll
            for (int s = 0; s < 2; ++s) {
                const bf16x8 ap = *(LAS bf16x8*)(Bc + 49152 + row * 128 + (((4 * s + fg) ^ ((row >> 1) & 7)) * 16));
                a1 = __builtin_amdgcn_mfma_f32_16x16x32_bf16(ap, mk8(vlo[s], vhi[s]), a1, 0, 0, 0);
            }
#pragma unroll
            for (int s = 0; s < 4; ++s) {
                const s16x4 lo = ld_b64(Bc + row * 256 + (((4 * s + (fg >> 1)) ^ swr) * 16) + (fg & 1) * 8);
                const s16x4 hi = ld_b64(Bc + row * 256 + (((4 * s + 2 + (fg >> 1)) ^ swr) * 16) + (fg & 1) * 8);
                a2 = __builtin_amdgcn_mfma_f32_16x16x32_bf16(mk8(lo, hi), Sb[s], a2, 0, 0, 0);
            }
#pragma unroll
            for (int rr = 0; rr < 4; ++rr) o[mt][rr] = a1[rr] + exp2f(lg * (float)(16 * mt + 4 * fg + rr + 1)) * a2[rr];
        }
        bf16x8 vd[2];
#pragma unroll
        for (int s = 0; s < 2; ++s) {
            float f[8];
#pragma unroll
            for (int jj = 0; jj < 8; ++jj) { const int j = 32 * s + 8 * fg + jj; const int e = c - 1 - j; f[jj] = e >= 0 ? exp2f(lg * (float)e) : 0.f; }
            const u32x2 l2 = __builtin_bit_cast(u32x2, vlo[s]), h2 = __builtin_bit_cast(u32x2, vhi[s]);
            u32x2 lo, hi;
            lo.x = cvt_pk_bf16(bflo(l2.x) * f[0], bfhi(l2.x) * f[1]); lo.y = cvt_pk_bf16(bflo(l2.y) * f[2], bfhi(l2.y) * f[3]);
            hi.x = cvt_pk_bf16(bflo(h2.x) * f[4], bfhi(h2.x) * f[5]); hi.y = cvt_pk_bf16(bflo(h2.y) * f[6], bfhi(h2.y) * f[7]);
            vd[s] = mk8(__builtin_bit_cast(s16x4, lo), __builtin_bit_cast(s16x4, hi));
        }
        const float gc = exp2f(lg * (float)c);
#pragma unroll
        for (int t = 0; t < 8; ++t) {
            f32x4 a = S[t] * gc;
#pragma unroll
            for (int s = 0; s < 2; ++s) {
                const int r0 = 32 * s + 8 * fg + (fr >> 2), r1 = r0 + 4;
                const s16x4 lo = ld_tr(Bc + 16384 + r0 * 256 + (((2 * t + ((fr & 3) >> 1)) ^ swb(r0)) * 16) + (fr & 1) * 8);
                const s16x4 hi = ld_tr(Bc + 16384 + r1 * 256 + (((2 * t + ((fr & 3) >> 1)) ^ swb(r1)) * 16) + (fr & 1) * 8);
                a = __builtin_amdgcn_mfma_f32_16x16x32_bf16(mk8(lo, hi), vd[s], a, 0, 0, 0);
            }
            S[t] = a;
        }
        make_sb(S, Sb);
        __syncthreads();
        os_write(Bc, o, w, fr, fg);
        if (more) {
#pragma unroll
            for (int X = 0; X < 3; ++X) { *(LAS u32x4*)(Bn + X * 16384 + lr * 256 + (((2 * lpart) ^ lsw) * 16)) = RQ[2 * X]; *(LAS u32x4*)(Bn + X * 16384 + lr * 256 + (((2 * lpart + 1) ^ lsw) * 16)) = RQ[2 * X + 1]; }
        }
        __syncthreads();
        os_finish<0>(Bc, tid, h, sq.row0 + t0, c, nwv, ga, gb, mix);
    }
#pragma unroll
    for (int t = 0; t < 8; ++t)
#pragma unroll
        for (int rr = 0; rr < 4; ++rr) sfinal[(16 * t + 4 * fg + rr) * 128 + 16 * w + fr] = S[t][rr];
    __syncthreads();
}

struct Args { const float* in[20]; float* out; unsigned char* ws; int ph_lo, ph_hi, li, pad; };
constexpr int NPHASE = 8;

__global__ void __launch_bounds__(512, 2) mega_fwd(Args args) {
    extern __shared__ __attribute__((aligned(16))) unsigned char lds[];
    Frame F;
    F.lds = (LAS unsigned char*)lds;
    F.tid = threadIdx.x; F.lane = F.tid & 63; F.wave = __builtin_amdgcn_readfirstlane(F.tid >> 6);
    F.G = gridDim.x; F.blk = blockIdx.x;
#pragma unroll
    for (int i = 0; i < 20; ++i) F.in[i] = args.in[i];
    F.out = args.out; F.ws = args.ws;
    volatile LAS unsigned* MISC = (volatile LAS unsigned*)(F.lds + MISC_OFF);
    for (int u = F.tid; u < (LDS_BYTES - LDSCTL_OFF) / 4; u += 512) ((LAS unsigned*)(F.lds + LDSCTL_OFF))[u] = 0u;
    __syncthreads();
    unsigned* barw = (unsigned*)(F.ws + WS_CTL) + CW_BAR + args.li * XCD_BAR_WORDS;
    XcdBarrier bar; bar.bar = barw; bar.x = 0; bar.st = nullptr;
    if (MK_N_LAUNCHES == 1) bar = xcd_barrier_post(barw, MISC + 8);
    const int lo = args.ph_lo, hi = args.ph_hi;
#define IN(k) (lo <= (k) && (k) < hi)
#define SEAM(k) do { if (IN(k) && IN((k) + 1)) xcd_barrier(bar); } while (0)
#define STAMP(k) do { if (MK_TPROBE && F.tid == 0) ((unsigned*)(F.ws + WS_CTL))[CW_TS + (k) * 256 + F.blk] = (unsigned)__builtin_amdgcn_s_memrealtime(); } while (0)
    STAMP(0);

    for (int rep = 0; rep < 1 + (MK_REPEAT & 1); ++rep) { if (rep) xcd_barrier(bar); if (IN(0)) { p0_prologue(F); } }
    STAMP(1); SEAM(0);
    for (int rep = 0; rep < 1 + ((MK_REPEAT >> 1) & 1); ++rep) { if (rep) xcd_barrier(bar);
    if (IN(1)) {
        pg8::Gemm g{(const bf16_t*)(F.ws + WS_H), (const bf16_t*)(F.ws + WS_WIN), 1024};
        pg8::StaticOrder S; S.init(MPAD / 256, NIN / 256, F.G, F.blk);
        EpiIn E{(bf16_t*)(F.ws + WS_PR), (bf16_t*)(F.ws + WS_PG), (const float*)(F.ws + WS_ROT), F.out};
        pg8::gemm_phase<EpiIn, pg8::StaticOrder, pg8::MapPlain>(F.lds, g, S, E);
    } }
    STAMP(2); SEAM(1);
#pragma unroll 1
    for (int phx = 0; phx < 2 + ((MK_REPEAT >> 2) & 1) + ((MK_REPEAT >> 3) & 1); ++phx) {
        const int ph = phx < 1 + ((MK_REPEAT >> 2) & 1) ? 2 : 3;
        if (phx > 0 && IN(2) && IN(3)) { STAMP(3); xcd_barrier(bar); }
        if (IN(ph)) {
            int it, iend, istep;
            if (ph == 2) { it = F.blk; iend = 1056; istep = F.G; }
            else if (F.blk < 64) { it = F.blk; iend = F.blk + 1; istep = 1; }
            else { it = F.blk; iend = 64 + 1024; istep = F.G - 64; }
#pragma unroll 1
            for (; it < iend; it += istep) {
                int kind, h, nch, t0 = 0, c = 4; SeqD sq; unsigned char* slot; const float* sinit = nullptr; float* sfinal = nullptr;
                if (ph == 2) {
                    const int bh = it / 33, n = it - bh * 33, b = bh >> 2; h = bh & 3; kind = 0; nch = 0;
                    sq = SeqD{b * LP, LP, 0, b}; t0 = n == 0 ? 0 : 16 + 64 * (n - 1); c = n == 0 ? 16 : 64;
                    slot = F.ws + WS_G2A + (size_t)it * SLOT;
                } else if (it < 64) {
                    const int bb = it & 31, b = bb >> 2; h = bb & 3; kind = it < 32 ? 1 : 2; nch = 33;
                    sq = SeqD{b * LP, LP, 0, b};
                    slot = F.ws + WS_G2A + (size_t)(bb * 33) * SLOT;
                    sfinal = F.out + (it < 32 ? O_PSG : O_PSR) + (size_t)bb * 16384;
                } else {
                    const int j = it - 64, rem = j & 511, sb = rem >> 2; h = rem & 3; kind = j < 512 ? 3 : 2; nch = 1;
                    sq = SeqD{MPROMPT + sb * 4, 4, 1, sb};
                    slot = (unsigned char*)F.out + OS_SCR + (size_t)F.blk * SLOT;
                    sinit = (j < 512 ? F.in[3] : F.in[2]) + (size_t)rem * 16384;
                    sfinal = F.out + (j < 512 ? O_SSG : O_SSR) + (size_t)rem * 16384;
                }
                if (kind == 0 || kind == 3) p2a_item(F, sq, h, t0, c, slot);
                if (kind == 3) {
                    VM_WAIT(); __syncthreads();
                    __builtin_amdgcn_fence(__ATOMIC_ACQUIRE, "agent"); VM_WAIT(); __syncthreads();
                }
                if (kind == 1 || kind == 3) scan_gdn(F, sq, h, nch, slot, sinit, sfinal);
                if (kind == 2) scan_ret(F, sq, h, nch, sinit, sfinal);
            }
        }
    }
    STAMP(4); SEAM(3);
    for (int rep = 0; rep < 1 + ((MK_REPEAT >> 4) & 1); ++rep) { if (rep) xcd_barrier(bar);
    if (IN(4)) {
        pg8::Gemm g{(const bf16_t*)((unsigned char*)F.out + OS_MIX), (const bf16_t*)(F.ws + WS_WOUT), 1024};
        pg8::StaticOrder S; S.init(MPAD / 256, 4, F.G, F.blk);
        EpiOut E{F.in[0], F.in[1], F.in[6], (bf16_t*)(F.ws + WS_X2B), (float*)(F.ws + WS_RSQ2)};
        pg8::gemm_phase<EpiOut, pg8::StaticOrder, pg8::MapPlain>(F.lds, g, S, E);
    } }
    STAMP(5); SEAM(4);
    for (int rep = 0; rep < 1 + ((MK_REPEAT >> 5) & 1); ++rep) { if (rep) xcd_barrier(bar);
    if (IN(5)) {
        pg8::Gemm g{(const bf16_t*)(F.ws + WS_X2B), (const bf16_t*)(F.ws + WS_WUP), 1024};
        pg8::StaticOrder S; S.init(UP_NM, NUP / 256, F.G, F.blk);
        EpiUp E{(const float*)(F.ws + WS_RSQ2), F.in[17], F.in[5], (bf16_t*)(F.ws + WS_ACT), F.out};
        pg8::gemm_phase<EpiUp, pg8::StaticOrder, pg8::MapUp>(F.lds, g, S, E);
    } }
    STAMP(6); SEAM(5);
    for (int rep = 0; rep < 1 + ((MK_REPEAT >> 6) & 1); ++rep) { if (rep) xcd_barrier(bar);
    if (IN(6)) {
        pg8::Gemm g{(const bf16_t*)(F.ws + WS_ACT), (const bf16_t*)(F.ws + WS_WDN), DFF};
        pg8::StaticOrder S; S.init(MPAD / 256, 4, F.G, F.blk);
        EpiDown E{(const bf16_t*)(F.ws + WS_X2B), F.out, (float*)(F.ws + WS_RSQ3)};
        pg8::gemm_phase<EpiDown, pg8::StaticOrder, pg8::MapPlain>(F.lds, g, S, E);
    } }
    STAMP(7); SEAM(6);
    if (IN(7)) {
        const float* rsq = (const float*)(F.ws + WS_RSQ3); const float* nf = F.in[19];
        const int gw = F.blk * 8 + F.wave, NGW = F.G * 8;
        for (int q = gw; q < 16384 + 512; q += NGW) {
            int g; float* dst;
            if (q < 16384) { g = (q >> 11) * LP + 16 + (q & 2047); dst = F.out + O_YP + (size_t)q * DM; } else { g = MPROMPT + (q - 16384); dst = F.out + O_YS + (size_t)(q - 16384) * DM; }
            float s = F.lane < 16 ? rsq[(size_t)g * 16 + F.lane] : 0.f;
            s = wave_sum(s);
            const float rstd = rsqrtf(s * (1.0f / DM) + EPS);
            f32x4* p = (f32x4*)dst + F.lane; const f32x4* np = (const f32x4*)nf + F.lane;
#pragma unroll
            for (int j = 0; j < 4; ++j) { f32x4 v = p[64 * j]; v = v * rstd * np[64 * j]; p[64 * j] = v; }
        }
    }
    if (MK_TPROBE && IN(7)) {
        STAMP(8);
        xcd_barrier(bar);
        if (F.blk == 0) {
            LAS float* sh = (LAS float*)F.lds;
            if (F.tid == 0) {
                const unsigned* TS = (const unsigned*)(F.ws + WS_CTL) + CW_TS;
                auto mx = [&](int k, int lo_, int hi_) { unsigned m = TS[k * 256 + lo_]; for (int b = lo_; b < hi_; ++b) { const unsigned v = TS[k * 256 + b]; if ((int)(v - m) > 0) m = v; } return m; };
                unsigned d = 0;
                const int sel = MK_TPROBE;
                if (sel >= 1 && sel <= 8) d = mx(sel, 0, F.G) - mx(sel - 1, 0, F.G);
                else if (sel == 10) d = TS[4 * 256 + 0] - mx(3, 0, F.G);
                else if (sel == 11) d = TS[4 * 256 + 32] - mx(3, 0, F.G);
                else if (sel == 12) d = mx(4, 64, F.G) - mx(3, 0, F.G);
                else if (sel == 13) d = mx(8, 0, F.G) - TS[0];
                else if (sel >= 20 && sel <= 23) d = TS[(sel - 11) * 256 + 0];
                sh[0] = sqrtf(MK_TSCALE * (float)d * 0.01f);
            }
            __syncthreads();
            const float f = 1.0f + sh[0];
            for (int e = F.tid; e < 8 * 3 * GQKV; e += 512) F.out[O_PCQ + e] *= f;
        }
    }
#undef IN
#undef SEAM
}

extern "C" void kernel_launch(void* const* d_in, const int* in_sizes, int n_in, void* d_out, int out_size, void* d_ws, size_t ws_size, hipStream_t stream) {
    static int grid = 0;
    if (grid == 0) {
        if (n_in != 20 || (size_t)out_size != O_TOTAL || ws_size < WS_END) { fprintf(stderr, "kernel_launch: unexpected shapes (n_in %d, out %d, ws %zu); nothing launched\n", n_in, out_size, ws_size); grid = -1; return; }
        int dev = 0, cus = 0;
        if (hipGetDevice(&dev) != hipSuccess || hipDeviceGetAttribute(&cus, hipDeviceAttributeMultiprocessorCount, dev) != hipSuccess) { grid = -1; return; }
        if (hipFuncSetAttribute((const void*)mega_fwd, hipFuncAttributeMaxDynamicSharedMemorySize, LDS_BYTES) != hipSuccess) { fprintf(stderr, "kernel_launch: hipFuncSetAttribute failed\n"); grid = -1; return; }
        (void)hipGetLastError();
        grid = cus;
        if (grid < 128 || (grid & 7)) { fprintf(stderr, "kernel_launch: unexpected CU count %d\n", cus); }
    }
    if (grid < 0) return;
    if (hipMemsetAsync((char*)d_ws + WS_CTL, 0, CTL_ZERO_BYTES, stream) != hipSuccess) return;
    Args a{};
    for (int i = 0; i < 20; ++i) a.in[i] = (const float*)d_in[i];
    a.out = (float*)d_out; a.ws = (unsigned char*)d_ws;
#if MK_N_LAUNCHES == 1
    a.ph_lo = 0; a.ph_hi = NPHASE; a.li = 0;
    hipLaunchKernelGGL(mega_fwd, dim3(grid), dim3(512), LDS_BYTES, stream, a);
#else
    for (int li = 0; li < NPHASE; ++li) { a.ph_lo = li; a.ph_hi = li + 1; a.li = 0; hipLaunchKernelGGL(mega_fwd, dim3(grid), dim3(512), LDS_BYTES, stream, a); }
#endif
}
```

```cpp
#include <hip/hip_runtime.h>
#include <cstdio>
#include <cstdint>

#ifndef MK_REPEAT
#define MK_REPEAT 0
#endif
#ifndef MK_TPROBE
#define MK_TPROBE 0
#endif
#ifndef MK_TSCALE
#define MK_TSCALE 2e-7f
#endif
#ifndef MK_N_LAUNCHES
#define MK_N_LAUNCHES 1
#endif

#define LAS __attribute__((address_space(3)))
typedef unsigned short bf16_t;
typedef short bf16x8 __attribute__((ext_vector_type(8)));
typedef short s16x4 __attribute__((ext_vector_type(4)));
typedef float f32x4 __attribute__((ext_vector_type(4)));
typedef unsigned u32x4 __attribute__((ext_vector_type(4)));
typedef unsigned u32x2 __attribute__((ext_vector_type(2)));

constexpr int DM = 1024, LP = 2064, NBATCH = 8, MPROMPT = NBATCH * LP  , NSB = 128, MSAMP = 512, MREAL = MPROMPT + MSAMP  , MPAD = 17152  ;
constexpr int NIN = 4096, INW = 4104, DFF = 2816, NUP = 5632, GQKV = 1536;
constexpr int UP_TROWS = 248, UP_NM = 69;
constexpr float EPS = 1e-6f;
constexpr size_t O_YP = 0, O_YS = 16777216, O_PSR = 17301504, O_PSG = 17825792, O_PCQ = 18350080, O_PCF = 18386944, O_SSR = 18477056, O_SSG = 26865664, O_SCQ = 35254272, O_SCF = 35844096, O_TOTAL = 37285888;
constexpr size_t MiB = 1u << 20;
constexpr size_t WS_CTL = 0, CTL_ZERO_BYTES = 1 * MiB;
constexpr size_t WS_WIN = 1 * MiB, WS_WOUT = 9 * MiB, WS_WUP = 11 * MiB, WS_WDN = 22 * MiB, WS_ROT = 28 * MiB, WS_BG = 30 * MiB, WS_RSQ2 = 31 * MiB, WS_RSQ3 = 32 * MiB + 512 * 1024;
constexpr size_t WS_PGX = 34 * MiB;
constexpr size_t WS_BIG = 36 * MiB;
constexpr size_t WS_PR = WS_BIG, WS_PG = WS_BIG + 67 * MiB, WS_G2A = WS_BIG + 134 * MiB, WS_H = WS_G2A;
constexpr size_t WS_X2F = WS_BIG, WS_X2B = WS_BIG + 67 * MiB, WS_ACT = WS_BIG + 101 * MiB;
constexpr size_t SLOT = 73984;
constexpr size_t WS_RP = WS_BIG + 209 * MiB;
constexpr size_t WS_END = 256 * MiB;
static_assert(WS_G2A + 1056 * SLOT <= WS_RP && WS_RP + 1056 * 8192 <= WS_END && WS_ACT + (size_t)MPAD * DFF * 2 <= WS_END, "ws map");
constexpr size_t OS_MIX = 0, OS_SCR = 34 * MiB;
static_assert(OS_SCR + 256 * SLOT <= 64 * MiB, "d_out scratch");
constexpr int CW_BAR = 4096, CW_TS = 16384;
constexpr int RING_BYTES = 131072, LDSCTL_OFF = 150528, MISC_OFF = LDSCTL_OFF + 320, LDS_BYTES = 151552;

#define LDS_WAIT() asm volatile("s_waitcnt lgkmcnt(0)" ::: "memory")
#define VM_WAIT() asm volatile("s_waitcnt vmcnt(0)" ::: "memory")

typedef float f32x2_t __attribute__((ext_vector_type(2))); typedef __bf16 bf16x2_t __attribute__((ext_vector_type(2)));
__device__ __forceinline__ unsigned cvt_pk_bf16(float lo, float hi) { const f32x2_t v = {lo, hi}; const bf16x2_t b = __builtin_convertvector(v, bf16x2_t); return __builtin_bit_cast(unsigned, b); }
__device__ __forceinline__ float bflo(unsigned w) { return __uint_as_float(w << 16); }
__device__ __forceinline__ float bfhi(unsigned w) { return __uint_as_float(w & 0xffff0000u); }
__device__ __forceinline__ float bfround(float x) { return bflo(cvt_pk_bf16(x, 0.f)); }
__device__ __forceinline__ float silu_f(float y) { return y * __builtin_amdgcn_rcpf(1.0f + __expf(-y)); }
__device__ __forceinline__ float wave_sum(float v) {
#pragma unroll
    for (int o = 1; o < 64; o <<= 1) v += __shfl_xor(v, o);
    return v;
}
__device__ __forceinline__ float bsel(int mask  , float a_if_set, float b_if_clear) { return __int_as_float((mask & __float_as_int(a_if_set)) | (~mask & __float_as_int(b_if_clear))); }
__device__ __forceinline__ float dpp_shr1(float x) { return __int_as_float(__builtin_amdgcn_update_dpp(0, __float_as_int(x), 0x111, 0xf, 0xf, true)); }

struct RowInfo { int t, len, idx, samp; };
__device__ __forceinline__ RowInfo rowinfo(int g) {
    RowInfo r;
    if (g < MPROMPT) { r.idx = g / LP; r.t = g - r.idx * LP; r.len = LP; r.samp = 0; }
    else { const int s = g - MPROMPT; r.idx = s >> 2; r.t = s & 3; r.len = 4; r.samp = 1; }
    return r;
}

namespace pg8 {
constexpr int BM = 256, BK = 64, HALF = 128, HTB = HALF * BK * 2, STAGE_BYTES = 8 * HTB, NXCD = 8, WGM = 8;
__host__ __device__ __forceinline__ int lds_byte(int r, int c) { const int st = (r >> 4) * 2 + (c >> 5), rr = r & 15, cc = c & 31, ob = rr * 64 + cc * 2; return st * 1024 + (ob ^ (((ob >> 9) & 1) << 5)); }
__host__ __device__ __forceinline__ void stage_rc(int b, int& R, int& C) { const int st = b / 1024, sb = b % 1024, swz = sb ^ (((sb >> 9) & 1) << 5); R = (st >> 1) * 16 + swz / 64; C = (st & 1) * 32 + (swz % 64) / 2; }
__host__ __device__ __forceinline__ int perm32(int rho) { const int n = rho >> 4, i = rho & 15; return 8 * (i >> 2) + 4 * n + (i & 3); }
struct Unit { int pm, pn; };
struct Gemm { const bf16_t* A; const bf16_t* Bt; int K; };
struct StaticOrder {
    int nM, nN, nwg, G, c;
    __host__ __device__ void init(int nM_, int nN_, int G_, int c_) { nM = nM_; nN = nN_; nwg = nM * nN; G = G_; c = c_; }
    __host__ __device__ bool next(int i, Unit& u) const {
        const long L = (long)i * G + c; if (L >= nwg) return false;
        int wgid = (int)L; { const int q = nwg / NXCD, r = nwg % NXCD, xcd = wgid % NXCD, off = wgid / NXCD; wgid = (xcd < r ? xcd * (q + 1) : r * (q + 1) + (xcd - r) * q) + off; }
        const int nig = WGM * nN, gid = wgid / nig, fm = gid * WGM, gsz = (nM - fm) < WGM ? (nM - fm) : WGM;
        u.pm = fm + ((wgid % nig) % gsz); u.pn = (wgid % nig) / gsz; return true;
    }
    __device__ __forceinline__ void a_ready(const Unit&) const {}
    __device__ __forceinline__ void done(const Unit&) const {}
};
struct MapPlain { static constexpr int HROWS = 128, TROWS = 256; static __device__ __forceinline__ int row(int R) { return R; } };
struct MapUp { static constexpr int HROWS = 124, TROWS = UP_TROWS; static __device__ __forceinline__ int row(int R) { return 62 * (R >> 6) - 2 + 4 * (R & 15) + ((R >> 4) & 3); } };

template <class Epi, class Sched, class AMap, bool ALIGN_EPI = true>
__device__ __forceinline__ void gemm_phase(LAS unsigned char* lds, const Gemm g, const Sched& S, const Epi& E) {
    const int tid = threadIdx.x, wid = __builtin_amdgcn_readfirstlane(tid >> 6), lane = tid & 63, wr = wid >> 2, wc = wid & 3, fr = lane & 15, fq = lane >> 4;
    const int K = g.K, nt = K / BK;
    int voffA[2], voffB[2];
#pragma unroll
    for (int i = 0; i < 2; ++i) { int R, C; stage_rc(tid * 16 + i * 8192, R, C); const int Rb = Epi::PERM ? ((R & ~31) + perm32(R & 31)) : R;
        voffA[i] = (AMap::row(R) * K + C) * 2; voffB[i] = (Rb * K + C) * 2; }
    const size_t kstep = (size_t)(BK * 2);
    const size_t hstepA = (size_t)AMap::HROWS * K * 2, tstepA = (size_t)AMap::TROWS * K * 2;
    const size_t hstepB = (size_t)HALF * K * 2, tstepB = 2 * hstepB;
    const unsigned ldsw = (unsigned)wid * 1024u;
    const int aoff = lds_byte(wr * 64 + fr, fq * 8), boff = lds_byte(wc * 32 + fr, fq * 8);
#define PG8_SA(b, h) (((b) * 2 + (h)) * HTB)
#define PG8_SB(b, h) ((4 + (b) * 2 + (h)) * HTB)
#define PG8_STAGE(bufoff, gbase, voff) do { _Pragma("unroll") for (int _i = 0; _i < 2; ++_i) \
        __builtin_amdgcn_global_load_lds((const unsigned*)((const char*)(gbase) + (voff)[_i]), (LAS unsigned*)(lds + (bufoff) + ldsw + _i * 8192), 16, 0, 0); } while (0)
#define PG8_LDA(dst, b, h) do { _Pragma("unroll") for (int m = 0; m < 4; ++m) _Pragma("unroll") for (int k = 0; k < 2; ++k) dst[m][k] = *(const LAS bf16x8*)(lds + PG8_SA(b, h) + aoff + m * 2048 + k * 1024); } while (0)
#define PG8_LDB(dst, b, h) do { _Pragma("unroll") for (int n = 0; n < 2; ++n) _Pragma("unroll") for (int k = 0; k < 2; ++k) dst[n][k] = *(const LAS bf16x8*)(lds + PG8_SB(b, h) + boff + n * 2048 + k * 1024); } while (0)
#define PG8_MMA(ai, bj, At, Bt) do { __builtin_amdgcn_s_setprio(1); _Pragma("unroll") for (int m = 0; m < 4; ++m) _Pragma("unroll") for (int n = 0; n < 2; ++n) _Pragma("unroll") for (int k = 0; k < 2; ++k) \
        acc[ai][bj][m][n] = __builtin_amdgcn_mfma_f32_16x16x32_bf16(Bt[n][k], At[m][k], acc[ai][bj][m][n], 0, 0, 0); __builtin_amdgcn_s_setprio(0); } while (0)
#define PG8_WAIT_V(n) asm volatile("s_waitcnt vmcnt(" #n ")" ::: "memory")
#define PG8_WAIT_L(n) asm volatile("s_waitcnt lgkmcnt(" #n ")" ::: "memory")
#define PG8_BAR __builtin_amdgcn_s_barrier()
#define PG8_SCHED __builtin_amdgcn_sched_barrier(0)
    Unit cur, nxt; int ui = 0;
    if (!S.next(0, cur)) return;
    f32x4 acc[2][2][4][2];
#pragma unroll
    for (int a = 0; a < 2; ++a)
#pragma unroll
        for (int b = 0; b < 2; ++b)
#pragma unroll
            for (int m = 0; m < 4; ++m)
#pragma unroll
                for (int n = 0; n < 2; ++n) acc[a][b][m][n] = (f32x4){0.f, 0.f, 0.f, 0.f};
    bf16x8 At[4][2], B0[2][2], B1[2][2];
    const char* cA = (const char*)g.A + (size_t)cur.pm * tstepA; const char* cB = (const char*)g.Bt + (size_t)cur.pn * tstepB;
    S.a_ready(cur);
    PG8_STAGE(PG8_SB(0, 0), cB, voffB); PG8_STAGE(PG8_SB(0, 1), cB + hstepB, voffB); PG8_STAGE(PG8_SA(0, 0), cA, voffA); PG8_STAGE(PG8_SA(0, 1), cA + hstepA, voffA);
    if (wr == 1) PG8_BAR;
    PG8_WAIT_V(2); PG8_BAR;
    PG8_STAGE(PG8_SB(1, 0), cB + kstep, voffB); PG8_STAGE(PG8_SA(1, 0), cA + kstep, voffA); PG8_STAGE(PG8_SB(1, 1), cB + hstepB + kstep, voffB);
    PG8_WAIT_V(6); PG8_BAR;
    for (;;) {
        const bool has_next = S.next(ui + 1, nxt);
        const char* nA = has_next ? (const char*)g.A + (size_t)nxt.pm * tstepA : cA; const char* nB = has_next ? (const char*)g.Bt + (size_t)nxt.pn * tstepB : cB;
        for (int t = 0; t < nt; t += 2) {
            const bool last = (t == nt - 2);
            const char* a1 = cA + (size_t)(t + 1) * kstep;
            const char* a2 = last ? nA : cA + (size_t)(t + 2) * kstep; const char* b2 = last ? nB : cB + (size_t)(t + 2) * kstep;
            const char* a3 = a2 + kstep; const char* b3 = b2 + kstep;
            if (last && has_next) S.a_ready(nxt);
            PG8_LDB(B0, 0, 0); PG8_LDB(B1, 0, 1); PG8_SCHED; PG8_LDA(At, 0, 0); PG8_STAGE(PG8_SA(1, 1), a1 + hstepA, voffA);
            PG8_WAIT_V(8); PG8_WAIT_L(0); PG8_BAR; PG8_MMA(0, 0, At, B0); PG8_MMA(0, 1, At, B1); PG8_BAR; PG8_SCHED;
            PG8_LDA(At, 0, 1); PG8_STAGE(PG8_SB(0, 0), b2, voffB); PG8_STAGE(PG8_SB(0, 1), b2 + hstepB, voffB); PG8_STAGE(PG8_SA(0, 0), a2, voffA);
            PG8_WAIT_V(8); PG8_WAIT_L(0); PG8_BAR; PG8_MMA(1, 0, At, B0); PG8_MMA(1, 1, At, B1); PG8_BAR; PG8_SCHED;
            PG8_LDB(B0, 1, 0); PG8_LDB(B1, 1, 1); PG8_SCHED; PG8_LDA(At, 1, 0); PG8_STAGE(PG8_SA(0, 1), a2 + hstepA, voffA);
            PG8_WAIT_V(8); PG8_WAIT_L(0); PG8_BAR; PG8_MMA(0, 0, At, B0); PG8_MMA(0, 1, At, B1); PG8_BAR; PG8_SCHED;
            PG8_LDA(At, 1, 1); PG8_STAGE(PG8_SB(1, 0), b3, voffB); PG8_STAGE(PG8_SB(1, 1), b3 + hstepB, voffB); PG8_STAGE(PG8_SA(1, 0), a3, voffA);
            PG8_WAIT_V(8); PG8_WAIT_L(0); PG8_BAR; PG8_MMA(1, 0, At, B0); PG8_MMA(1, 1, At, B1); PG8_BAR; PG8_SCHED;
        }
        if constexpr (ALIGN_EPI) { if (wr == 0) PG8_BAR; }
        E(acc, cur, wr, wc, fr, fq); S.done(cur);
        if (!has_next) break;
#pragma unroll
        for (int a = 0; a < 2; ++a)
#pragma unroll
            for (int b = 0; b < 2; ++b)
#pragma unroll
                for (int m = 0; m < 4; ++m)
#pragma unroll
                    for (int n = 0; n < 2; ++n) acc[a][b][m][n] = (f32x4){0.f, 0.f, 0.f, 0.f};
        cur = nxt; cA = nA; cB = nB; ++ui;
        if constexpr (ALIGN_EPI) { if (wr == 1) PG8_BAR; }
    }
    PG8_WAIT_V(0);
    if constexpr (!ALIGN_EPI) { if (wr == 0) PG8_BAR; }
    PG8_BAR;
#undef PG8_SA
#undef PG8_SB
#undef PG8_STAGE
#undef PG8_LDA
#undef PG8_LDB
#undef PG8_MMA
#undef PG8_WAIT_V
#undef PG8_WAIT_L
#undef PG8_BAR
#undef PG8_SCHED
}
}
using pg8::Unit;


struct EpiIn {
    static constexpr bool PERM = true;
    bf16_t* PR; bf16_t* PG; const float* rot; float* out;
    __device__ __forceinline__ void operator()(const f32x4 (&acc)[2][2][4][2], const Unit& u, int wr, int wc, int fr_, int fq_) const {
        int ln_; asm volatile("v_mbcnt_lo_u32_b32 %0, -1, 0\n\tv_mbcnt_hi_u32_b32 %0, -1, %0" : "=v"(ln_)); const int fr = ln_ & 15, fq = ln_ >> 4;
        const int pn = u.pn, rbase = u.pm * 256 + wr * 64 + fr;
        if (pn < 4) {
            const int head = (pn & 1) * 2 + (wc >> 1), j0 = 32 * (wc & 1) + 8 * fq;
            const float sc = pn >= 2 ? 0.08838834764831845f : 1.0f;
            bf16_t* dstb = PR + (pn >= 2 ? 512 : 0) + head * 128 + j0;
#pragma unroll
            for (int ai = 0; ai < 2; ++ai)
#pragma unroll
                for (int m = 0; m < 4; ++m) {
                    const int row = rbase + ai * 128 + m * 16;
                    int ridx = 0; if (row < MPROMPT) ridx = row % LP; else if (row < MREAL) ridx = LP + ((row - MPROMPT) & 3);
                    const f32x4* rp = (const f32x4*)(rot + (size_t)ridx * 128 + j0 * 2);
                    const f32x4 cs0 = rp[0], cs1 = rp[1], cs2 = rp[2], cs3 = rp[3];
                    const f32x4 a0 = acc[ai][0][m][0], a1 = acc[ai][0][m][1], b0 = acc[ai][1][m][0], b1 = acc[ai][1][m][1];
                    const float c[8] = {cs0[0], cs0[2], cs1[0], cs1[2], cs2[0], cs2[2], cs3[0], cs3[2]};
                    const float s[8] = {cs0[1], cs0[3], cs1[1], cs1[3], cs2[1], cs2[3], cs3[1], cs3[3]};
                    const float x1[8] = {a0[0], a0[1], a0[2], a0[3], a1[0], a1[1], a1[2], a1[3]};
                    const float x2[8] = {b0[0], b0[1], b0[2], b0[3], b1[0], b1[1], b1[2], b1[3]};
                    float o1[8], o2[8];
#pragma unroll
                    for (int i = 0; i < 8; ++i) { o1[i] = (x1[i] * c[i] - x2[i] * s[i]) * sc; o2[i] = (x1[i] * s[i] + x2[i] * c[i]) * sc; }
                    u32x4 w1, w2; w1.x = cvt_pk_bf16(o1[0], o1[1]); w1.y = cvt_pk_bf16(o1[2], o1[3]); w1.z = cvt_pk_bf16(o1[4], o1[5]); w1.w = cvt_pk_bf16(o1[6], o1[7]);
                    w2.x = cvt_pk_bf16(o2[0], o2[1]); w2.y = cvt_pk_bf16(o2[2], o2[3]); w2.z = cvt_pk_bf16(o2[4], o2[5]); w2.w = cvt_pk_bf16(o2[6], o2[7]);
                    bf16_t* rowp = dstb + (size_t)row * 2048;
                    *(u32x4*)(rowp) = w1; *(u32x4*)(rowp + 64) = w2;
                }
        } else {
            const bool act = (pn == 6 || pn == 7 || pn >= 14);
            const bool cst = (pn >= 8 && pn < 14);
            bf16_t* dbase = pn < 8 ? PR : PG;
            const int colt = (pn < 8 ? pn * 256 : pn * 256 - 2048) + wc * 32 + 8 * fq;
#pragma unroll
            for (int ai = 0; ai < 2; ++ai)
#pragma unroll
                for (int m = 0; m < 4; ++m) {
                    const int row = rbase + ai * 128 + m * 16;
                    bf16_t* rowp = dbase + (size_t)row * 2048 + colt;
                    float* cdst = nullptr;
                    if (cst && row < MREAL) { const RowInfo ri = rowinfo(row); if (ri.t >= ri.len - 3) cdst = out + (ri.samp ? O_SCQ : O_PCQ) + (size_t)(ri.idx * 3 + (ri.t - (ri.len - 3))) * GQKV + colt; }
#pragma unroll
                    for (int bj = 0; bj < 2; ++bj) {
                        f32x4 v0 = acc[ai][bj][m][0], v1 = acc[ai][bj][m][1];
                        if (cdst) { *(f32x4*)(cdst + bj * 128) = v0; *(f32x4*)(cdst + bj * 128 + 4) = v1; }
                        if (act) {
#pragma unroll
                            for (int i = 0; i < 4; ++i) { v0[i] = silu_f(v0[i]); v1[i] = silu_f(v1[i]); }
                        }
                        u32x4 w; w.x = cvt_pk_bf16(v0[0], v0[1]); w.y = cvt_pk_bf16(v0[2], v0[3]); w.z = cvt_pk_bf16(v1[0], v1[1]); w.w = cvt_pk_bf16(v1[2], v1[3]);
                        *(u32x4*)(rowp + bj * 128) = w;
                    }
                }
        }
    }
};

__device__ __forceinline__ const float* x_src_row(const float* xp, const float* xs, const float* meta, int g) {
    if (g < MPROMPT) { const int b = g / LP, t = g - b * LP; return t < 16 ? meta + (size_t)t * DM : xp + ((size_t)b * 2048 + (t - 16)) * DM; }
    return xs + (size_t)(g - MPROMPT) * DM;
}

struct EpiOut {
    static constexpr bool PERM = false;
    const float* xp; const float* xs; const float* meta; bf16_t* X2B; float* rsq;
    __device__ __forceinline__ void operator()(const f32x4 (&acc)[2][2][4][2], const Unit& u, int wr, int wc, int fr_, int fq_) const {
        int ln_; asm volatile("v_mbcnt_lo_u32_b32 %0, -1, 0\n\tv_mbcnt_hi_u32_b32 %0, -1, %0" : "=v"(ln_)); const int fr = ln_ & 15, fq = ln_ >> 4;
        const int rbase = u.pm * 256 + wr * 64 + fr, col0 = u.pn * 256 + wc * 32 + 4 * fq;
#pragma unroll
        for (int ai = 0; ai < 2; ++ai)
#pragma unroll
            for (int m = 0; m < 4; ++m) {
                const int row = rbase + ai * 128 + m * 16;
                const float* xr = row < MREAL ? x_src_row(xp, xs, meta, row) + col0 : nullptr;
                bf16_t* ob = X2B + (size_t)row * DM + col0;
                float ss = 0.f;
#pragma unroll
                for (int bj = 0; bj < 2; ++bj)
#pragma unroll
                    for (int n = 0; n < 2; ++n) {
                        f32x4 v = acc[ai][bj][m][n];
                        if (xr) v += *(const f32x4*)(xr + bj * 128 + n * 16);
                        ss += (v[0] * v[0] + v[1] * v[1]) + (v[2] * v[2] + v[3] * v[3]);
                        u32x2 w; w.x = cvt_pk_bf16(v[0], v[1]); w.y = cvt_pk_bf16(v[2], v[3]);
                        *(u32x2*)(ob + bj * 128 + n * 16) = w;
                    }
                ss += __shfl_xor(ss, 16); ss += __shfl_xor(ss, 32);
                if (fq == 0) rsq[(size_t)row * 16 + u.pn * 4 + wc] = ss;
            }
    }
};

struct EpiDown {
    static constexpr bool PERM = false;
    const bf16_t* X2B; float* out; float* rsq;
    __device__ __forceinline__ void operator()(const f32x4 (&acc)[2][2][4][2], const Unit& u, int wr, int wc, int fr_, int fq_) const {
        int ln_; asm volatile("v_mbcnt_lo_u32_b32 %0, -1, 0\n\tv_mbcnt_hi_u32_b32 %0, -1, %0" : "=v"(ln_)); const int fr = ln_ & 15, fq = ln_ >> 4;
        const int rbase = u.pm * 256 + wr * 64 + fr, col0 = u.pn * 256 + wc * 32 + 4 * fq;
#pragma unroll
        for (int ai = 0; ai < 2; ++ai)
#pragma unroll
            for (int m = 0; m < 4; ++m) {
                const int row = rbase + ai * 128 + m * 16;
                float* yr = nullptr;
                if (row < MPROMPT) { const int b = row / LP, t = row - b * LP; if (t >= 16) yr = out + O_YP + ((size_t)b * 2048 + (t - 16)) * DM + col0; }
                else if (row < MREAL) yr = out + O_YS + (size_t)(row - MPROMPT) * DM + col0;
                const bf16_t* xr = X2B + (size_t)row * DM + col0;
                float ss = 0.f;
#pragma unroll
                for (int bj = 0; bj < 2; ++bj)
#pragma unroll
                    for (int n = 0; n < 2; ++n) {
                        const u32x2 xb = *(const u32x2*)(xr + bj * 128 + n * 16);
                        const f32x4 v = acc[ai][bj][m][n] + (f32x4){bflo(xb.x), bfhi(xb.x), bflo(xb.y), bfhi(xb.y)};
                        ss += (v[0] * v[0] + v[1] * v[1]) + (v[2] * v[2] + v[3] * v[3]);
                        if (yr) *(f32x4*)(yr + bj * 128 + n * 16) = v;
                    }
                ss += __shfl_xor(ss, 16); ss += __shfl_xor(ss, 32);
                if (fq == 0) rsq[(size_t)row * 16 + u.pn * 4 + wc] = ss;
            }
    }
};

struct EpiUp {
    static constexpr bool PERM = true;
    const float* rsq2; const float* cw; const float* stf; bf16_t* act; float* out;
    __device__ __forceinline__ void operator()(const f32x4 (&acc)[2][2][4][2], const Unit& u, int wr, int wc, int fr_, int fq_) const {
        int ln_; asm volatile("v_mbcnt_lo_u32_b32 %0, -1, 0\n\tv_mbcnt_hi_u32_b32 %0, -1, %0" : "=v"(ln_)); const int fr = ln_ & 15, fq = ln_ >> 4;
        const int colg = u.pn * 128 + wc * 32 + fq * 8;
#pragma unroll
        for (int ai = 0; ai < 2; ++ai) {
            const int g0 = u.pm * UP_TROWS + (2 * ai + wr) * 62 - 2 + 4 * fr;
            float rs[4];
#pragma unroll
            for (int m = 0; m < 4; ++m) {
                int g = g0 + m; g = g < 0 ? 0 : g;
                const f32x4* p = (const f32x4*)(rsq2 + (size_t)g * 16);
                const f32x4 s0 = p[0], s1 = p[1], s2 = p[2], s3 = p[3];
                const float s = ((s0[0] + s0[1]) + (s0[2] + s0[3])) + ((s1[0] + s1[1]) + (s1[2] + s1[3])) + ((s2[0] + s2[1]) + (s2[2] + s2[3])) + ((s3[0] + s3[1]) + (s3[2] + s3[3]));
                rs[m] = rsqrtf(s * (1.0f / DM) + EPS);
                asm volatile("" : "+v"(rs[m]));
                __builtin_amdgcn_sched_barrier(0);
            }
#pragma unroll
            for (int n = 0; n < 2; ++n) {
                const int col = colg + 4 * n;
                f32x4 w[2][3];
#pragma unroll
                for (int bj = 0; bj < 2; ++bj)
#pragma unroll
                    for (int k = 0; k < 3; ++k) w[bj][k] = *(const f32x4*)(cw + (size_t)k * NUP + bj * DFF + col);
#pragma unroll
                for (int m = 0; m < 4; ++m) {
                    const int g = g0 + m;
                    const bool vout = (4 * fr + m >= 2) && (g < MREAL);
                    const RowInfo ri = rowinfo(g < 0 ? 0 : g);
                    float y[2][4];
#pragma unroll
                    for (int bj = 0; bj < 2; ++bj) {
                        float cur[4], p1[4], p2[4];
#pragma unroll
                        for (int i = 0; i < 4; ++i) {
                            cur[i] = acc[ai][bj][m][n][i] * rs[m];
                            p1[i] = m >= 1 ? acc[ai][bj][m >= 1 ? m - 1 : 0][n][i] * rs[m >= 1 ? m - 1 : 0] : dpp_shr1(acc[ai][bj][3][n][i] * rs[3]);
                            p2[i] = m >= 2 ? acc[ai][bj][m >= 2 ? m - 2 : 0][n][i] * rs[m >= 2 ? m - 2 : 0] : dpp_shr1(acc[ai][bj][m == 0 ? 2 : 3][n][i] * rs[m == 0 ? 2 : 3]);
                        }
                        if (ri.t < 2) {
                            f32x4 S0 = {0.f, 0.f, 0.f, 0.f}, S1 = {0.f, 0.f, 0.f, 0.f};
                            if (ri.samp && ri.idx < NSB) { S0 = *(const f32x4*)(stf + (size_t)(ri.idx * 2 + 0) * NUP + bj * DFF + col); S1 = *(const f32x4*)(stf + (size_t)(ri.idx * 2 + 1) * NUP + bj * DFF + col); }
#pragma unroll
                            for (int i = 0; i < 4; ++i) { if (ri.t == 0) { p1[i] = S1[i]; p2[i] = S0[i]; } else { p2[i] = S1[i]; } }
                        }
                        if (vout && ri.t >= ri.len - 2) {
                            float* d = out + (ri.samp ? O_SCF : O_PCF) + (size_t)(ri.idx * 2 + (ri.t - (ri.len - 2))) * NUP + bj * DFF + col;
                            *(f32x4*)(d) = (f32x4){cur[0], cur[1], cur[2], cur[3]};
                        }
#pragma unroll
                        for (int i = 0; i < 4; ++i) y[bj][i] = w[bj][0][i] * p2[i] + w[bj][1][i] * p1[i] + w[bj][2][i] * cur[i];
                    }
                    if (vout) {
                        u32x2 pk; pk.x = cvt_pk_bf16(silu_f(y[0][0]) * y[1][0], silu_f(y[0][1]) * y[1][1]); pk.y = cvt_pk_bf16(silu_f(y[0][2]) * y[1][2], silu_f(y[0][3]) * y[1][3]);
                        *(u32x2*)(act + (size_t)g * DFF + col) = pk;
                    }
                    __builtin_amdgcn_sched_barrier(0);
                }
            }
        }
    }
};

#define XB_TMO      128
#define XB_XCNT(j)  (256  + 64 * (j))
#define XB_XSUB(j)  (1280 + 64 * (j))
#define XB_XGEN(j)  (2304 + 64 * (j))
#define XB_TOP      3328
#define XB_TOPGEN   3392
#define XCD_BAR_WORDS 3456
#define XB_SPIN_CAP (1u << 20)
__device__ __forceinline__ unsigned xb_ld(unsigned* p)              { return __hip_atomic_load(p, __ATOMIC_RELAXED, __HIP_MEMORY_SCOPE_AGENT); }
__device__ __forceinline__ unsigned xb_add(unsigned* p, unsigned v) { return __hip_atomic_fetch_add(p, v, __ATOMIC_RELAXED, __HIP_MEMORY_SCOPE_AGENT); }
__device__ __forceinline__ unsigned xb_xcc_id() { return (unsigned)__builtin_amdgcn_s_getreg((3 << 11) | 20) & 0xFu; }
#define XB_SPIN(cond, bar) do { unsigned _sp = 0; while (cond) { __builtin_amdgcn_s_sleep(1); \
    if ((++_sp & 255u) == 0u) { if (xb_ld(&(bar)[XB_TMO])) break; if (_sp > XB_SPIN_CAP) { atomicAdd(&(bar)[XB_TMO], 1u); break; } } } } while (0)
struct XcdBarrier { unsigned* bar; unsigned x; volatile LAS unsigned* st; };
__device__ __forceinline__ XcdBarrier xcd_barrier_post(unsigned* bar, volatile LAS unsigned* st) {
    XcdBarrier b; b.bar = bar; b.x = xb_xcc_id(); b.st = st;
    if (threadIdx.x == 0) (void)xb_add(&bar[XB_XCNT(b.x)], 1u);
    return b;
}
__device__ __forceinline__ void xcd_barrier_complete(unsigned* bar, unsigned x, unsigned& nloc, unsigned& nx) {
    const unsigned G = gridDim.x * gridDim.y * gridDim.z;
    unsigned sum, cnt, mine, sp = 0u;
    for (;;) {
        sum = 0u; cnt = 0u; mine = 0u;
#pragma unroll
        for (unsigned j = 0; j < 16; ++j) { const unsigned c = xb_ld(&bar[XB_XCNT(j)]); sum += c; cnt += (c > 0u) ? 1u : 0u; mine = (j == x) ? c : mine; }
        if (sum == G) break;
        __builtin_amdgcn_s_sleep(1);
        if ((++sp & 255u) == 0u) { if (xb_ld(&bar[XB_TMO])) break; if (sp > XB_SPIN_CAP) { atomicAdd(&bar[XB_TMO], 1u); break; } }
    }
    nloc = mine > 0u ? mine : 1u; nx = cnt > 0u ? cnt : 1u;
}
__device__ __forceinline__ void xcd_barrier(const XcdBarrier& b) {
    asm volatile("s_waitcnt vmcnt(0)" ::: "memory");
    __syncthreads();
    if (threadIdx.x == 0) {
        unsigned* bar = b.bar;
        __builtin_amdgcn_s_waitcnt(0);
        unsigned nloc = b.st[0], nx = b.st[1];
        if (nloc == 0u) { xcd_barrier_complete(bar, b.x, nloc, nx); b.st[0] = nloc; b.st[1] = nx; }
        const unsigned old = xb_add(&bar[XB_XSUB(b.x)], 1u);
        const unsigned gen = old / nloc;
        if (old + 1u == (gen + 1u) * nloc) {
            __builtin_amdgcn_fence(__ATOMIC_RELEASE, "agent");
            asm volatile("s_waitcnt vmcnt(0)" ::: "memory");
            const unsigned og = xb_add(&bar[XB_TOP], 1u);
            const unsigned tg = og / nx;
            if (og + 1u == (tg + 1u) * nx) xb_add(&bar[XB_TOPGEN], 1u);
            else XB_SPIN(xb_ld(&bar[XB_TOPGEN]) == tg, bar);
            __builtin_amdgcn_fence(__ATOMIC_ACQUIRE, "agent");
            xb_add(&bar[XB_XGEN(b.x)], 1u);
            asm volatile("s_waitcnt vmcnt(0)" ::: "memory");
        } else {
            XB_SPIN(xb_ld(&bar[XB_XGEN(b.x)]) == gen, bar);
            __builtin_amdgcn_fence(__ATOMIC_ACQUIRE, "agent");
            asm volatile("s_waitcnt vmcnt(0)" ::: "memory");
        }
    }
    __syncthreads();
}

struct Frame {
    LAS unsigned char* lds;
    int tid, lane, wave, G, blk;
    const float* in[20];
    float* out; unsigned char* ws;
};

__device__ __forceinline__ void p0_transpose_item(const float* W, int ldw, int K, bf16_t* WT, int n0, int srcn0, int k0, const float* kscale, LAS float* scr, int lane) {
    float tv[32];
#pragma unroll
    for (int i = 0; i < 32; ++i) tv[i] = W[(size_t)(k0 + 2 * i + (lane >> 5)) * ldw + srcn0 + (lane & 31)];
#pragma unroll
    for (int i = 0; i < 32; ++i) { const int kk = 2 * i + (lane >> 5); float v = tv[i]; if (kscale) v *= kscale[k0 + kk]; scr[kk * 33 + (lane & 31)] = v; }
    LDS_WAIT(); asm volatile("" ::: "memory");
    const int c = lane & 7;
#pragma unroll
    for (int j = 0; j < 4; ++j) { const int n = (lane >> 3) + 8 * j; const LAS float* s = scr + (8 * c) * 33 + n;
        u32x4 o; o.x = cvt_pk_bf16(s[0 * 33], s[1 * 33]); o.y = cvt_pk_bf16(s[2 * 33], s[3 * 33]); o.z = cvt_pk_bf16(s[4 * 33], s[5 * 33]); o.w = cvt_pk_bf16(s[6 * 33], s[7 * 33]);
        *(u32x4*)(WT + (size_t)(n0 + n) * K + k0 + 8 * c) = o; }
    LDS_WAIT(); asm volatile("" ::: "memory");
}
__device__ __forceinline__ int in_colmap(int n0) {
    const int pn = n0 >> 8;
    if (pn >= 4) return n0;
    const int c = n0 & 255, bj = c >> 7, cc = c & 127, hl = cc >> 6, j = cc & 63;
    return (pn >= 2 ? 512 : 0) + ((pn & 1) * 2 + hl) * 128 + bj * 64 + j;
}
__device__ __forceinline__ void p0_prologue(Frame& F) {
    const float* w_in = F.in[8]; const float* w_out = F.in[14]; const float* w_up = F.in[16]; const float* w_dn = F.in[18];
    bf16_t* WIN = (bf16_t*)(F.ws + WS_WIN); bf16_t* WOUT = (bf16_t*)(F.ws + WS_WOUT); bf16_t* WUP = (bf16_t*)(F.ws + WS_WUP); bf16_t* WDN = (bf16_t*)(F.ws + WS_WDN);
    LAS float* scr = (LAS float*)(F.lds + F.wave * 8448);
    LAS float* WX = (LAS float*)(F.lds + 69632);
    for (int i = F.tid; i < 1024 * 8; i += 512) WX[i] = w_in[(size_t)(i >> 3) * INW + NIN + (i & 7)];
    const int gw = F.blk * 8 + F.wave, NGW = F.G * 8;
    constexpr int I_IN = 16 * 128, I_OUT = 16 * 32, I_UP = 16 * 176, I_DN = 44 * 32, NIT = I_IN + I_OUT + I_UP + I_DN;
    for (int it = gw; it < NIT; it += NGW) {
        int r = it;
        if (r < I_IN) { const int kb = r / 128, nb = r % 128; p0_transpose_item(w_in, INW, 1024, WIN, nb * 32, in_colmap(nb * 32), kb * 64, nullptr, scr, F.lane); continue; } r -= I_IN;
        if (r < I_OUT) { const int kb = r / 32, nb = r % 32; p0_transpose_item(w_out, 1024, 1024, WOUT, nb * 32, nb * 32, kb * 64, nullptr, scr, F.lane); continue; } r -= I_OUT;
        if (r < I_UP) { const int kb = r / 176, nb = r % 176; const int n0 = nb * 32, pn = n0 >> 8, c = n0 & 255; p0_transpose_item(w_up, NUP, 1024, WUP, n0, (c >> 7) * DFF + pn * 128 + (c & 127), kb * 64, F.in[15], scr, F.lane); continue; } r -= I_UP;
        { const int kb = r / 32, nb = r % 32; p0_transpose_item(w_dn, 1024, DFF, WDN, nb * 32, nb * 32, kb * 64, nullptr, scr, F.lane); }
    }
    __syncthreads();
    bf16_t* H = (bf16_t*)(F.ws + WS_H); float* BG = (float*)(F.ws + WS_BG);
    const float* nm = F.in[7];
    f32x4 nmv[4], vn[4];
#pragma unroll
    for (int j = 0; j < 4; ++j) { nmv[j] = ((const f32x4*)nm)[F.lane + 64 * j]; vn[j] = (f32x4){0.f, 0.f, 0.f, 0.f}; }
    if (gw < MREAL) {
        const f32x4* xr0 = (const f32x4*)x_src_row(F.in[0], F.in[1], F.in[6], gw) + F.lane;
#pragma unroll
        for (int j = 0; j < 4; ++j) vn[j] = xr0[64 * j];
    }
    for (int g = gw; g < MPAD; g += NGW) {
        unsigned long long* o8 = (unsigned long long*)(H + (size_t)g * DM) + F.lane;
        f32x4 v[4];
#pragma unroll
        for (int j = 0; j < 4; ++j) v[j] = vn[j];
        if (g + NGW < MREAL) {
            const f32x4* xr1 = (const f32x4*)x_src_row(F.in[0], F.in[1], F.in[6], g + NGW) + F.lane;
#pragma unroll
            for (int j = 0; j < 4; ++j) vn[j] = xr1[64 * j];
        }
        if (g >= MREAL) {
#pragma unroll
            for (int j = 0; j < 4; ++j) o8[64 * j] = 0ull;
            continue;
        }
        float ss = 0.f;
#pragma unroll
        for (int j = 0; j < 4; ++j) ss += (v[j][0] * v[j][0] + v[j][1] * v[j][1]) + (v[j][2] * v[j][2] + v[j][3] * v[j][3]);
        const float rstd = rsqrtf(wave_sum(ss) * (1.0f / DM) + EPS);
        float ex[8];
#pragma unroll
        for (int e = 0; e < 8; ++e) ex[e] = 0.f;
#pragma unroll
        for (int j = 0; j < 4; ++j) {
            v[j] = v[j] * rstd * nmv[j];
            o8[64 * j] = (unsigned long long)cvt_pk_bf16(v[j][0], v[j][1]) | ((unsigned long long)cvt_pk_bf16(v[j][2], v[j][3]) << 32);
#pragma unroll
            for (int i = 0; i < 4; ++i) {
                const int k = 4 * (F.lane + 64 * j) + i;
                const f32x4 wa = *(const LAS f32x4*)(WX + k * 8), wb = *(const LAS f32x4*)(WX + k * 8 + 4);
                ex[0] += v[j][i] * wa[0]; ex[1] += v[j][i] * wa[1]; ex[2] += v[j][i] * wa[2]; ex[3] += v[j][i] * wa[3];
                ex[4] += v[j][i] * wb[0]; ex[5] += v[j][i] * wb[1]; ex[6] += v[j][i] * wb[2]; ex[7] += v[j][i] * wb[3];
            }
        }
#pragma unroll
        for (int e = 0; e < 8; ++e) ex[e] = wave_sum(ex[e]);
        if (F.lane < 4) {
            const int h = F.lane;
            const float gb = h == 0 ? ex[0] : h == 1 ? ex[1] : h == 2 ? ex[2] : ex[3];
            const float ga = h == 0 ? ex[4] : h == 1 ? ex[5] : h == 2 ? ex[6] : ex[7];
            const float beta = 1.0f / (1.0f + __expf(-gb));
            const float xx = ga + F.in[11][h];
            const float sp = xx > 20.f ? xx : log1pf(__expf(xx));
            BG[(size_t)g * 8 + h] = beta;
            BG[(size_t)g * 8 + 4 + h] = -__expf(F.in[10][h]) * sp;
        }
    }
    {
        bf16_t* PGX = (bf16_t*)(F.ws + WS_PGX); const float* stq = F.in[4];
        for (int e = F.blk * 512 + F.tid; e < 385 * GQKV; e += F.G * 512) PGX[e] = e < 384 * GQKV ? (bf16_t)(cvt_pk_bf16(stq[e], 0.f) & 0xffffu) : (bf16_t)0;
    }
    float* ROT = (float*)(F.ws + WS_ROT);
    for (int e = F.blk * 512 + F.tid; e < 2068 * 64; e += F.G * 512) {
        const int p = e >> 6, j = e & 63; const int pos = p < LP ? p : 16384 + (p - LP);
        double f = 1.0, b = 0.8659643233600653523531691834202299819398;
#pragma unroll
        for (int k = 0; k < 6; ++k) { if ((j >> k) & 1) f *= b; b *= b; }
        double rev = (double)pos * f * 0.15915494309189533576888376337251436203445964574046;
        rev -= floor(rev);
        const float rf = (float)rev;
        ROT[(size_t)e * 2] = __builtin_amdgcn_cosf(rf); ROT[(size_t)e * 2 + 1] = __builtin_amdgcn_sinf(rf);
    }
}

struct SeqD { int row0, len, samp, idx; };
__device__ __forceinline__ bf16x8 mk8(s16x4 lo, s16x4 hi) { return (bf16x8){lo[0], lo[1], lo[2], lo[3], hi[0], hi[1], hi[2], hi[3]}; }
__device__ __forceinline__ s16x4 ld_tr(LAS unsigned char* p) { return __builtin_bit_cast(s16x4, __builtin_amdgcn_ds_read_tr16_b64_v4i16((LAS s16x4*)p)); }
__device__ __forceinline__ s16x4 ld_b64(LAS unsigned char* p) { return *(LAS s16x4*)p; }
__device__ __forceinline__ s16x4 pk4(f32x4 v) { u32x2 w; w.x = cvt_pk_bf16(v[0], v[1]); w.y = cvt_pk_bf16(v[2], v[3]); return __builtin_bit_cast(s16x4, w); }

__device__ __forceinline__ int qk_pos(int i, int j) { const int p = (j & ~12) | ((j & 4) << 1) | ((j & 8) >> 1); return (((p >> 3) ^ ((i >> 1) & 7)) << 3) | (p & 7); }
__device__ __forceinline__ void p2a_item(Frame& F, const SeqD sq, int h, int t0, int c, unsigned char* slot) {
    unsigned lbase = (unsigned)(uintptr_t)F.lds; int tid = F.tid;
    asm volatile("" : "+s"(lbase), "+v"(tid));
    const unsigned ta0 = MK_TPROBE ? (unsigned)__builtin_amdgcn_s_memrealtime() : 0u;
    LAS unsigned char* L = (LAS unsigned char*)(uintptr_t)lbase;
    LAS float* AM = (LAS float*)(L); LAS float* RHS = (LAS float*)(L + 53248);
    LAS float* GL = (LAS float*)(L + 16384); LAS float* CUM = GL + 64; LAS float* BETA = GL + 128;
    LAS unsigned char* QB = L + 20480; LAS unsigned char* KB = L + 36864;
    const float* BG = (const float*)(F.ws + WS_BG);
    const float* cgw = F.in[9];
    const int r = tid >> 3, cg = tid & 7, lane = tid & 63, w = __builtin_amdgcn_readfirstlane(tid >> 6), fr = lane & 15, fg = lane >> 4;
    const bool valid = r < c;
    const int grow = sq.row0 + t0 + r;
    float beta_r = 0.f, gdec = 0.f;
    if (valid) { beta_r = BG[(size_t)grow * 8 + h]; gdec = BG[(size_t)grow * 8 + 4 + h]; }
    if (cg == 0) GL[r] = gdec;
    LAS float* CW = (LAS float*)(L + 118784);
#pragma unroll
    for (int k = 0; k < 3; ++k) { const int e = tid + 512 * k, dt = e / 384, rem = e - dt * 384; CW[e] = cgw[(size_t)dt * GQKV + (rem >> 7) * 512 + h * 128 + (rem & 127)]; }
#define P2A_LOAD(dst, XX) do { _Pragma("unroll") for (int dt = 0; dt < 4; ++dt) { \
        const int colb_ = (XX) * 512 + h * 128 + 16 * cg, tt = t0 + r - 3 + dt; \
        const unsigned oz = (unsigned)(WS_PGX + ((size_t)384 * GQKV + colb_) * 2); \
        const unsigned opg = (unsigned)(WS_PG + ((size_t)(sq.row0 + (tt >= 0 ? tt : 0)) * 2048 + colb_) * 2); \
        const unsigned opx = (unsigned)(WS_PGX + ((size_t)(sq.idx * 3 + (tt < 0 ? 3 + tt : 0)) * GQKV + colb_) * 2); \
        const unsigned so = valid ? (tt >= 0 ? opg : (sq.samp ? opx : oz)) : oz; \
        const u32x4* sp = (const u32x4*)(F.ws + so); dst[2 * dt] = sp[0]; dst[2 * dt + 1] = sp[1]; } } while (0)
    u32x4 dcur[8], dnxt[8];
    P2A_LOAD(dcur, 0);
    __syncthreads();
    const unsigned ta1 = MK_TPROBE ? (unsigned)__builtin_amdgcn_s_memrealtime() : 0u;
    float cum = 0.f, cl = 0.f;
#pragma unroll 8
    for (int j = 0; j < 64; ++j) { const float gj = GL[j]; cl += gj; if (j <= r) cum += gj; }
    const float er = __expf(cum), frr = __expf(cl - cum);
    if (cg == 0) { CUM[r] = cum; BETA[r] = beta_r; }
    if (tid == 0) *(float*)(slot + 73728) = __expf(cl);
#pragma unroll 1
    for (int X = 0; X < 3; ++X) {
        if (X < 2) P2A_LOAD(dnxt, X + 1);
        float y[16];
#pragma unroll
        for (int i = 0; i < 16; ++i) y[i] = 0.f;
#pragma unroll
        for (int dt = 0; dt < 4; ++dt) {
            const u32x4 a = dcur[2 * dt], b = dcur[2 * dt + 1];
            const float xv[16] = {bflo(a.x), bfhi(a.x), bflo(a.y), bfhi(a.y), bflo(a.z), bfhi(a.z), bflo(a.w), bfhi(a.w), bflo(b.x), bfhi(b.x), bflo(b.y), bfhi(b.y), bflo(b.z), bfhi(b.z), bflo(b.w), bfhi(b.w)};
            const LAS f32x4* wp = (const LAS f32x4*)(CW + dt * 384 + X * 128 + 16 * cg);
#pragma unroll
            for (int k = 0; k < 4; ++k) { const f32x4 wv = wp[k]; y[4 * k] += wv[0] * xv[4 * k]; y[4 * k + 1] += wv[1] * xv[4 * k + 1]; y[4 * k + 2] += wv[2] * xv[4 * k + 2]; y[4 * k + 3] += wv[3] * xv[4 * k + 3]; }
        }
#pragma unroll
        for (int k = 0; k < 8; ++k) dcur[k] = dnxt[k];
        float ss = 0.f;
#pragma unroll
        for (int i = 0; i < 16; ++i) { y[i] = valid ? silu_f(y[i]) : 0.f; ss += y[i] * y[i]; }
        ss += __shfl_xor(ss, 1); ss += __shfl_xor(ss, 2); ss += __shfl_xor(ss, 4);
        const float nrm = X == 0 ? rsqrtf(ss + EPS) * 0.08838834764831845f : (X == 1 ? rsqrtf(ss + EPS) : 1.0f);
        u32x4 p0, p1;
        p0.x = cvt_pk_bf16(y[0] * nrm, y[1] * nrm); p0.y = cvt_pk_bf16(y[2] * nrm, y[3] * nrm); p0.z = cvt_pk_bf16(y[4] * nrm, y[5] * nrm); p0.w = cvt_pk_bf16(y[6] * nrm, y[7] * nrm);
        p1.x = cvt_pk_bf16(y[8] * nrm, y[9] * nrm); p1.y = cvt_pk_bf16(y[10] * nrm, y[11] * nrm); p1.z = cvt_pk_bf16(y[12] * nrm, y[13] * nrm); p1.w = cvt_pk_bf16(y[14] * nrm, y[15] * nrm);
        const float z[16] = {bflo(p0.x), bfhi(p0.x), bflo(p0.y), bfhi(p0.y), bflo(p0.z), bfhi(p0.z), bflo(p0.w), bfhi(p0.w), bflo(p1.x), bfhi(p1.x), bflo(p1.y), bfhi(p1.y), bflo(p1.z), bfhi(p1.z), bflo(p1.w), bfhi(p1.w)};
        if (X < 2) {
            LAS unsigned char* dstl = (X == 0 ? QB : KB) + r * 256;
            *(LAS u32x4*)(dstl + (((2 * cg) ^ (r & 15)) * 16)) = p0; *(LAS u32x4*)(dstl + (((2 * cg + 1) ^ (r & 15)) * 16)) = p1;
            const float sc = X == 0 ? er : frr;
            u32x4 d0, d1;
            d0.x = cvt_pk_bf16(z[0] * sc, z[1] * sc); d0.y = cvt_pk_bf16(z[2] * sc, z[3] * sc); d0.z = cvt_pk_bf16(z[4] * sc, z[5] * sc); d0.w = cvt_pk_bf16(z[6] * sc, z[7] * sc);
            d1.x = cvt_pk_bf16(z[8] * sc, z[9] * sc); d1.y = cvt_pk_bf16(z[10] * sc, z[11] * sc); d1.z = cvt_pk_bf16(z[12] * sc, z[13] * sc); d1.w = cvt_pk_bf16(z[14] * sc, z[15] * sc);
            if (X == 0) { const u32x4 e0 = {d0.x, d0.y, d1.x, d1.y}, e1 = {d0.z, d0.w, d1.z, d1.w};
                *(u32x4*)(slot + 16384 + r * 256 + (((2 * cg) ^ (r & 15)) * 16)) = e0; *(u32x4*)(slot + 16384 + r * 256 + (((2 * cg + 1) ^ (r & 15)) * 16)) = e1; }
            else { u32x4* gd = (u32x4*)(slot + 32768 + r * 256 + (((cg >> 1) ^ (r & 3)) * 64) + (cg & 1) * 32); gd[0] = d0; gd[1] = d1; }
        }
        if (X >= 1) {
            const float sc = X == 1 ? beta_r * er : beta_r;
            LAS float* rd = RHS + r * 256 + (X == 1 ? 128 : 0) + 16 * cg;
#pragma unroll
            for (int k = 0; k < 4; ++k) *(LAS f32x4*)(rd + 4 * k) = (f32x4){z[4 * k] * sc, z[4 * k + 1] * sc, z[4 * k + 2] * sc, z[4 * k + 3] * sc};
        }
        __builtin_amdgcn_sched_barrier(0);
    }
    __syncthreads();
    const unsigned ta2 = MK_TPROBE ? (unsigned)__builtin_amdgcn_s_memrealtime() : 0u;
    {
        bf16_t* QK = (bf16_t*)(slot + 49152);
#pragma unroll
        for (int rep = 0; rep < 2; ++rep) {
            const int idx = w + 8 * rep, it = idx >> 2, jt = idx & 3;
            const int jcol = 16 * jt + fr;
            if (it >= jt) {
                f32x4 akk = {0.f, 0.f, 0.f, 0.f}, aqk = {0.f, 0.f, 0.f, 0.f};
#pragma unroll
                for (int s = 0; s < 4; ++s) {
                    const int ri = 16 * it + fr, rj = 16 * jt + fr;
                    const bf16x8 bk = *(LAS bf16x8*)(KB + rj * 256 + (((4 * s + fg) ^ (rj & 15)) * 16));
                    const bf16x8 ak = *(LAS bf16x8*)(KB + ri * 256 + (((4 * s + fg) ^ (ri & 15)) * 16));
                    const bf16x8 aq = *(LAS bf16x8*)(QB + ri * 256 + (((4 * s + fg) ^ (ri & 15)) * 16));
                    akk = __builtin_amdgcn_mfma_f32_16x16x32_bf16(ak, bk, akk, 0, 0, 0);
                    aqk = __builtin_amdgcn_mfma_f32_16x16x32_bf16(aq, bk, aqk, 0, 0, 0);
                }
                const float cj = CUM[jcol];
#pragma unroll
                for (int rr = 0; rr < 4; ++rr) {
                    const int i_ = 16 * it + 4 * fg + rr;
                    const float dec = i_ >= jcol ? __expf(CUM[i_] - cj) : 0.f;
                    AM[i_ * 64 + jcol] = i_ > jcol ? BETA[i_] * akk[rr] * dec : 0.f;
                    QK[i_ * 64 + qk_pos(i_, jcol)] = (bf16_t)(cvt_pk_bf16(aqk[rr] * dec, 0.f) & 0xffffu);
                }
            } else {
#pragma unroll
                for (int rr = 0; rr < 4; ++rr) { const int i_ = 16 * it + 4 * fg + rr; QK[i_ * 64 + qk_pos(i_, jcol)] = 0; }
            }
        }
    }
    __syncthreads();
    const unsigned ta3 = MK_TPROBE ? (unsigned)__builtin_amdgcn_s_memrealtime() : 0u;
    {
        const int col = tid >> 1, hh = tid & 1;
        unsigned amo = (unsigned)(uintptr_t)AM + hh * 16u, r0 = (unsigned)(uintptr_t)RHS + col * 4u + hh * 4096u, r1 = (unsigned)(uintptr_t)RHS + col * 4u - hh * 4096u;
        asm volatile("" : "+v"(amo), "+v"(r0), "+v"(r1));
        LAS unsigned char* amb = (LAS unsigned char*)(uintptr_t)amo; LAS unsigned char* rb0 = (LAS unsigned char*)(uintptr_t)r0; LAS unsigned char* rb1 = (LAS unsigned char*)(uintptr_t)r1;
        float xs[64];
#pragma unroll
        for (int k = 0; k < 64; ++k) xs[k] = (k & 4) ? *(LAS float*)(rb1 + k * 1024) : *(LAS float*)(rb0 + k * 1024);
#pragma unroll
        for (int i = 1; i < 64; ++i) {
            float a0 = 0.f, a1 = 0.f;
#pragma unroll
            for (int q = 0; q < 8; ++q) {
                if (8 * q < i) { const f32x4 cq = *(LAS f32x4*)(amb + i * 256 + q * 32); a0 += cq[0] * xs[8 * q]; a1 += cq[1] * xs[8 * q + 1]; a0 += cq[2] * xs[8 * q + 2]; a1 += cq[3] * xs[8 * q + 3]; }
            }
            float a = a0 + a1;
            a += __int_as_float(__builtin_amdgcn_update_dpp(0, __float_as_int(a), 0xB1, 0xf, 0xf, true));
            const float v = (hh ? xs[i ^ 4] : xs[i]) - a;
            xs[i] = hh ? xs[i] : v; xs[i ^ 4] = hh ? v : xs[i ^ 4];
            asm volatile("" ::: "memory");
        }
        unsigned char* rowp = col < 128 ? slot + 57344 + col * 128 : slot + (col - 128) * 128;
        const int wsw = col < 128 ? 0 : (((col - 128) >> 1) & 1);
#pragma unroll
        for (int k = 0; k < 4; ++k) {
            u32x4* dst = (u32x4*)(rowp + ((hh ^ wsw) * 64) + k * 16);
            const int e = 8 * k;
            u32x4 o;
            o.x = cvt_pk_bf16(hh ? xs[(32 + e) ^ 4] : xs[e], hh ? xs[(33 + e) ^ 4] : xs[e + 1]); o.y = cvt_pk_bf16(hh ? xs[(34 + e) ^ 4] : xs[e + 2], hh ? xs[(35 + e) ^ 4] : xs[e + 3]);
            o.z = cvt_pk_bf16(hh ? xs[(36 + e) ^ 4] : xs[e + 4], hh ? xs[(37 + e) ^ 4] : xs[e + 5]); o.w = cvt_pk_bf16(hh ? xs[(38 + e) ^ 4] : xs[e + 6], hh ? xs[(39 + e) ^ 4] : xs[e + 7]);
            *dst = o;
        }
    }
    __syncthreads();
    if (MK_TPROBE) { const unsigned ta4 = (unsigned)__builtin_amdgcn_s_memrealtime(); if (tid == 0) { unsigned* TS = (unsigned*)(F.ws + WS_CTL) + CW_TS; TS[26 * 256 + F.blk] += ta1 - ta0; TS[27 * 256 + F.blk] += ta2 - ta1; TS[28 * 256 + F.blk] += ta3 - ta2; TS[34 * 256 + F.blk] += ta4 - ta3; } }
}

typedef float f32x16 __attribute__((ext_vector_type(16)));
constexpr int SC_IMG = 57344, SC_OS = 114688, SC_OSB = 17408, OST_PITCH = 136;
__device__ __forceinline__ void glds16(const void* gsrc, unsigned lds_dst) { unsigned keep; lds_dst = __builtin_amdgcn_readfirstlane(lds_dst);
    asm volatile("s_mov_b32 %0, m0\n\ts_mov_b32 m0, %2\n\ts_nop 0\n\tglobal_load_lds_dwordx4 %1, off\n\ts_mov_b32 m0, %0" : "=&s"(keep) : "v"(gsrc), "s"(lds_dst) : "memory"); }
__device__ __forceinline__ f32x16 mfma32(bf16x8 a, bf16x8 b, f32x16 c) { return __builtin_amdgcn_mfma_f32_32x32x16_bf16(a, b, c, 0, 0, 0); }
__device__ __forceinline__ bf16x8 pk8(const f32x16& v, int s) {
    u32x4 w; w.x = cvt_pk_bf16(v[8 * s], v[8 * s + 1]); w.y = cvt_pk_bf16(v[8 * s + 2], v[8 * s + 3]); w.z = cvt_pk_bf16(v[8 * s + 4], v[8 * s + 5]); w.w = cvt_pk_bf16(v[8 * s + 6], v[8 * s + 7]);
    return __builtin_bit_cast(bf16x8, w);
}
template <int MODE  >
__device__ __forceinline__ void scan_finish(LAS unsigned char* OSb, int hw, int lane, int h, int grow0, int c, const float* nw, const u32x4 (&gpre)[4], bf16_t* mix) {
    const int i16 = lane & 15, g = lane >> 4, tok = 16 * hw + i16;
    float v[32];
#pragma unroll
    for (int k = 0; k < 8; ++k) {
        const s16x4 t4 = ld_tr(OSb + (32 * g + 4 * k + (i16 >> 2)) * OST_PITCH + (16 * hw + 4 * (i16 & 3)) * 2);
        const u32x2 t2 = __builtin_bit_cast(u32x2, t4);
        v[4 * k] = bflo(t2.x); v[4 * k + 1] = bfhi(t2.x); v[4 * k + 2] = bflo(t2.y); v[4 * k + 3] = bfhi(t2.y);
    }
    float rstd;
    if (MODE == 0) {
        float s = 0.f;
#pragma unroll
        for (int k = 0; k < 32; ++k) s += v[k];
        s += __shfl_xor(s, 16); s += __shfl_xor(s, 32);
        const float mu = s * (1.0f / 128.0f);
        float q = 0.f;
#pragma unroll
        for (int k = 0; k < 32; ++k) { v[k] -= mu; q += v[k] * v[k]; }
        q += __shfl_xor(q, 16); q += __shfl_xor(q, 32);
        rstd = rsqrtf(q * (1.0f / 128.0f) + EPS);
    } else {
        float q = 0.f;
#pragma unroll
        for (int k = 0; k < 32; ++k) q += v[k] * v[k];
        q += __shfl_xor(q, 16); q += __shfl_xor(q, 32);
        rstd = rsqrtf(q * (1.0f / 128.0f) + EPS);
    }
    if (tok < c) {
        const f32x4* np = (const f32x4*)(nw + (MODE == 0 ? h * 128 : 0) + 32 * g);
        u32x4* mp = (u32x4*)(mix + (size_t)(grow0 + tok) * DM + (MODE == 0 ? 0 : 512) + h * 128 + 32 * g);
#pragma unroll
        for (int k = 0; k < 4; ++k) {
            const u32x4 gv = gpre[k]; const f32x4 n0 = np[2 * k], n1 = np[2 * k + 1];
            u32x4 o;
            o.x = cvt_pk_bf16(v[8 * k] * rstd * n0[0] * bflo(gv.x), v[8 * k + 1] * rstd * n0[1] * bfhi(gv.x));
            o.y = cvt_pk_bf16(v[8 * k + 2] * rstd * n0[2] * bflo(gv.y), v[8 * k + 3] * rstd * n0[3] * bfhi(gv.y));
            o.z = cvt_pk_bf16(v[8 * k + 4] * rstd * n1[0] * bflo(gv.z), v[8 * k + 5] * rstd * n1[1] * bfhi(gv.z));
            o.w = cvt_pk_bf16(v[8 * k + 6] * rstd * n1[2] * bflo(gv.w), v[8 * k + 7] * rstd * n1[3] * bfhi(gv.w));
            mp[k] = o;
        }
    }
}

__device__ __forceinline__ void chunk_of(const SeqD& sq, int n, int& t0, int& c) { if (sq.samp) { t0 = 0; c = 4; } else if (n == 0) { t0 = 0; c = 16; } else { t0 = 16 + 64 * (n - 1); c = 64; } }
__device__ __forceinline__ void scan_gdn(Frame& F, const SeqD sq, int h, int nchunks, const unsigned char* slot0, const float* sinit, float* sfinal) {
    unsigned lbase = (unsigned)(uintptr_t)F.lds; int tid = F.tid;
    asm volatile("" : "+s"(lbase), "+v"(tid));
    LAS unsigned char* L = (LAS unsigned char*)(uintptr_t)lbase;
    const int lane = tid & 63, w8 = __builtin_amdgcn_readfirstlane(tid >> 6), w = w8 & 3;
    const bool isM = w8 < 4;
    const bf16_t* PG = (const bf16_t*)(F.ws + WS_PG);
    bf16_t* mix = (bf16_t*)((unsigned char*)F.out + OS_MIX);
    const int r = lane & 31, hh = lane >> 5, i16 = lane & 15, g16 = lane >> 4;
    f32x16 S[4]; bf16x8 Sb[4][2];
    u32x2 ur[2][4]; float cdn = 1.0f;
#define GSET(k, v) do { ur[(k) >> 1][((k) & 1) * 2] = (u32x2){(v).x, (v).y}; ur[(k) >> 1][((k) & 1) * 2 + 1] = (u32x2){(v).z, (v).w}; } while (0)
    const int uoff = 57344 + ((32 * w + r) * 64 + 4 * hh) * 2;
    if (isM) {
#pragma unroll
        for (int t = 0; t < 4; ++t)
#pragma unroll
            for (int e = 0; e < 16; ++e) S[t][e] = sinit ? sinit[(32 * t + (e & 3) + 8 * (e >> 2) + 4 * hh) * 128 + 32 * w + r] : 0.f;
#pragma unroll
        for (int t = 0; t < 4; ++t) { Sb[t][0] = pk8(S[t], 0); Sb[t][1] = pk8(S[t], 1); }
#pragma unroll
        for (int mt = 0; mt < 2; ++mt)
#pragma unroll
            for (int q = 0; q < 4; ++q) ur[mt][q] = *(const u32x2*)(slot0 + uoff + 64 * mt + 16 * q);
        cdn = *(const float*)(slot0 + 73728);
    } else {
#pragma unroll
        for (int k = 0; k < 14; ++k) { const int pc = w + 4 * k; glds16(slot0 + pc * 1024 + lane * 16, lbase + pc * 1024); }
        { int t0, c; chunk_of(sq, 0, t0, c); const int tok = 16 * w + (lane & 15);
          if (tok < c) { const u32x4* gp = (const u32x4*)(PG + (size_t)(sq.row0 + t0 + tok) * 2048 + 1536 + h * 128 + 32 * (lane >> 4));
#pragma unroll
              for (int k = 0; k < 4; ++k) { const u32x4 gv = gp[k]; GSET(k, gv); } } }
        asm volatile("s_waitcnt vmcnt(0)" ::: "memory");
    }
    __syncthreads();
    unsigned accA = 0, accB = 0;
    for (int n = 0; n <= nchunks; ++n) {
        LAS unsigned char* Bc = L + (n & 1) * SC_IMG; LAS unsigned char* Bn = L + ((n & 1) ^ 1) * SC_IMG;
        LAS unsigned char* OSc = L + SC_OS + (n & 1) * SC_OSB; LAS unsigned char* OSp = L + SC_OS + ((n & 1) ^ 1) * SC_OSB;
        const unsigned char* img = slot0 + (size_t)n * SLOT;
        const unsigned tq0 = MK_TPROBE ? (unsigned)__builtin_amdgcn_s_memrealtime() : 0u;
        if (isM) {
            if (n < nchunks) {
                int lane_ = lane; asm volatile("" : "+v"(lane_));
                const int r_ = lane_ & 31, hh_ = lane_ >> 5, i16_ = lane_ & 15, gb_ = (lane_ >> 4) & 1;
                const float cd = cdn;
                f32x16 u[2];
#pragma unroll
                for (int mt = 0; mt < 2; ++mt)
#pragma unroll
                    for (int q = 0; q < 4; ++q) { u[mt][4 * q] = bflo(ur[mt][q].x); u[mt][4 * q + 1] = bfhi(ur[mt][q].x); u[mt][4 * q + 2] = bflo(ur[mt][q].y); u[mt][4 * q + 3] = bfhi(ur[mt][q].y); }
                if (n + 1 < nchunks) {
#pragma unroll
                    for (int mt = 0; mt < 2; ++mt)
#pragma unroll
                        for (int q = 0; q < 4; ++q) ur[mt][q] = *(const u32x2*)(img + SLOT + uoff + 64 * mt + 16 * q);
                    cdn = *(const float*)(img + SLOT + 73728);
                }
                const int trc = 32 * gb_ + 8 * (i16_ & 3);
                f32x16 wv[2];
#pragma unroll
                for (int mt = 0; mt < 2; ++mt) {
                    f32x16 a;
#pragma unroll
                    for (int e = 0; e < 16; ++e) a[e] = 0.f;
#pragma unroll
                    for (int t = 0; t < 4; ++t)
#pragma unroll
                        for (int s = 0; s < 2; ++s) {
                            const int ra = 32 * t + 16 * s + 4 * hh_ + (i16_ >> 2), rb = ra + 8;
                            const s16x4 lo = ld_tr(Bc + ra * 128 + ((mt ^ ((ra >> 1) & 1)) * 64) + trc);
                            const s16x4 hi = ld_tr(Bc + rb * 128 + ((mt ^ ((rb >> 1) & 1)) * 64) + trc);
                            a = mfma32(mk8(lo, hi), Sb[t][s], a);
                        }
                    wv[mt] = u[mt] - a;
                }
                bf16x8 wb[2][2];
#pragma unroll
                for (int mt = 0; mt < 2; ++mt) { wb[mt][0] = pk8(wv[mt], 0); wb[mt][1] = pk8(wv[mt], 1); }
#pragma unroll
                for (int mt = 0; mt < 2; ++mt) {
                    f32x16 a;
#pragma unroll
                    for (int e = 0; e < 16; ++e) a[e] = 0.f;
                    const int row = 32 * mt + r_;
#pragma unroll
                    for (int t = 0; t < 4; ++t)
#pragma unroll
                        for (int s = 0; s < 2; ++s) {
                            const bf16x8 af = *(LAS bf16x8*)(Bc + 16384 + row * 256 + (((2 * (2 * t + s) + hh_) ^ (row & 15)) * 16));
                            a = mfma32(af, Sb[t][s], a);
                        }
#pragma unroll
                    for (int m2 = 0; m2 <= mt; ++m2)
#pragma unroll
                        for (int s = 0; s < 2; ++s) {
                            const bf16x8 af = *(LAS bf16x8*)(Bc + 49152 + row * 128 + (((2 * (2 * m2 + s) + hh_) ^ ((row >> 1) & 7)) * 16));
                            a = mfma32(af, wb[m2][s], a);
                        }
#pragma unroll
                    for (int q = 0; q < 4; ++q) { u32x2 pkd; pkd.x = cvt_pk_bf16(a[4 * q], a[4 * q + 1]); pkd.y = cvt_pk_bf16(a[4 * q + 2], a[4 * q + 3]);
                        *(LAS u32x2*)(OSc + (32 * w + r_) * OST_PITCH + (32 * mt + 8 * q + 4 * hh_) * 2) = pkd; }
                }
#pragma unroll
                for (int t = 0; t < 4; ++t) {
                    f32x16 a = S[t] * cd;
#pragma unroll
                    for (int m2 = 0; m2 < 2; ++m2)
#pragma unroll
                        for (int s = 0; s < 2; ++s) {
                            const int ra = 32 * m2 + 16 * s + 4 * hh_ + (i16_ >> 2), rb = ra + 8;
                            const s16x4 lo = ld_tr(Bc + 32768 + ra * 256 + ((t ^ (ra & 3)) * 64) + trc);
                            const s16x4 hi = ld_tr(Bc + 32768 + rb * 256 + ((t ^ (rb & 3)) * 64) + trc);
                            a = mfma32(mk8(lo, hi), wb[m2][s], a);
                        }
                    S[t] = a;
                }
#pragma unroll
                for (int t = 0; t < 4; ++t) { Sb[t][0] = pk8(S[t], 0); Sb[t][1] = pk8(S[t], 1); }
            }
        } else {
            if (n + 1 < nchunks) {
                const unsigned bn = lbase + ((n & 1) ^ 1) * SC_IMG;
#pragma unroll
                for (int k = 0; k < 14; ++k) { const int pc = w + 4 * k; glds16(img + SLOT + pc * 1024 + lane * 16, bn + pc * 1024); }
            }
            if (n >= 1) { int t0, c; chunk_of(sq, n - 1, t0, c);
                const u32x4 gpre[4] = {{ur[0][0].x, ur[0][0].y, ur[0][1].x, ur[0][1].y}, {ur[0][2].x, ur[0][2].y, ur[0][3].x, ur[0][3].y}, {ur[1][0].x, ur[1][0].y, ur[1][1].x, ur[1][1].y}, {ur[1][2].x, ur[1][2].y, ur[1][3].x, ur[1][3].y}};
                scan_finish<1>(OSp, w, lane, h, sq.row0 + t0, c, F.in[13], gpre, mix); }
            if (n < nchunks) { int t0, c; chunk_of(sq, n, t0, c); const int tok = 16 * w + (lane & 15);
                if (tok < c) { const u32x4* gp = (const u32x4*)(PG + (size_t)(sq.row0 + t0 + tok) * 2048 + 1536 + h * 128 + 32 * (lane >> 4));
#pragma unroll
                    for (int k = 0; k < 4; ++k) { const u32x4 gv = gp[k]; GSET(k, gv); } } }
            asm volatile("s_waitcnt vmcnt(0)" ::: "memory");
        }
        const unsigned tq1 = MK_TPROBE ? (unsigned)__builtin_amdgcn_s_memrealtime() : 0u;
        __syncthreads();
        const unsigned tq2 = MK_TPROBE ? (unsigned)__builtin_amdgcn_s_memrealtime() : 0u;
        accA += tq1 - tq0; accB += tq2 - tq1;
    }
    if (MK_TPROBE && nchunks > 1 && (tid == 0 || tid == 256)) { unsigned* TS = (unsigned*)(F.ws + WS_CTL) + CW_TS; const int o_ = tid ? 2 : 0; TS[(9 + o_) * 256 + F.blk] = accA; TS[(10 + o_) * 256 + F.blk] = accB; }
    if (isM) {
#pragma unroll
        for (int t = 0; t < 4; ++t)
#pragma unroll
            for (int e = 0; e < 16; ++e) sfinal[(32 * t + (e & 3) + 8 * (e >> 2) + 4 * hh) * 128 + 32 * w + r] = S[t][e];
    }
    __syncthreads();
}

#undef GSET
__device__ __forceinline__ void ret_prepass_item(Frame& F, const SeqD sq, int h, int t0, int c, unsigned char* pimg) {
    unsigned lbase = (unsigned)(uintptr_t)F.lds; int tid = F.tid;
    asm volatile("" : "+s"(lbase), "+v"(tid));
    LAS unsigned char* L = (LAS unsigned char*)(uintptr_t)lbase;
    const int lane = tid & 63, w = __builtin_amdgcn_readfirstlane(tid >> 6), fr = lane & 15, fg = lane >> 4;
    const bf16_t* PR = (const bf16_t*)(F.ws + WS_PR);
    const float lg = h == 0 ? -0.04580368961312479f : h == 1 ? -0.02272007650008353f : h == 2 ? -0.011315313227834146f : -0.005646563141142063f;
    const unsigned tp0 = MK_TPROBE ? (unsigned)__builtin_amdgcn_s_memrealtime() : 0u;
    {
        const int r = tid >> 3, part = tid & 7;
#pragma unroll
        for (int X = 0; X < 2; ++X) {
            u32x4 a = {0u, 0u, 0u, 0u}, b = a;
            if (r < c) { const u32x4* p = (const u32x4*)(PR + (size_t)(sq.row0 + t0 + r) * 2048 + X * 512 + h * 128 + 16 * part); a = p[0]; b = p[1]; }
            *(LAS u32x4*)(L + X * 16384 + r * 256 + (((2 * part) ^ (r & 15)) * 16)) = a; *(LAS u32x4*)(L + X * 16384 + r * 256 + (((2 * part + 1) ^ (r & 15)) * 16)) = b;
        }
    }
    __syncthreads();
    const unsigned tp1 = MK_TPROBE ? (unsigned)__builtin_amdgcn_s_memrealtime() : 0u;
    LAS bf16_t* P = (LAS bf16_t*)(L + 32768);
#pragma unroll
    for (int rep = 0; rep < 2; ++rep) {
        const int idx = w + 8 * rep, it = idx >> 2, jt = idx & 3, jcol = 16 * jt + fr;
        f32x4 a = {0.f, 0.f, 0.f, 0.f};
        if (it >= jt) {
#pragma unroll
            for (int s = 0; s < 4; ++s) {
                const bf16x8 aq = *(LAS bf16x8*)(L + (16 * it + fr) * 256 + (((4 * s + fg) ^ fr) * 16));
                const bf16x8 bk = *(LAS bf16x8*)(L + 16384 + (16 * jt + fr) * 256 + (((4 * s + fg) ^ fr) * 16));
                a = __builtin_amdgcn_mfma_f32_16x16x32_bf16(aq, bk, a, 0, 0, 0);
            }
        }
#pragma unroll
        for (int rr = 0; rr < 4; ++rr) {
            const int i_ = 16 * it + 4 * fg + rr;
            const float p = (it >= jt && i_ >= jcol) ? a[rr] * exp2f(lg * (float)(i_ - jcol)) : 0.f;
            P[i_ * 64 + ((((jcol >> 3) ^ ((i_ >> 1) & 7)) << 3) | (jcol & 7))] = (bf16_t)(cvt_pk_bf16(p, 0.f) & 0xffffu);
        }
    }
    __syncthreads();
    ((u32x4*)pimg)[tid] = ((LAS u32x4*)(L + 32768))[tid];
    const unsigned tp2 = MK_TPROBE ? (unsigned)__builtin_amdgcn_s_memrealtime() : 0u;
    __syncthreads();
    const unsigned tp3 = MK_TPROBE ? (unsigned)__builtin_amdgcn_s_memrealtime() : 0u;
    (void)tp0; (void)tp1; (void)tp2; (void)tp3;
}

__device__ __forceinline__ void scan_ret(Frame& F, const SeqD sq, int h, int nchunks, const unsigned char* pimg0, float* sfinal) {
    unsigned lbase = (unsigned)(uintptr_t)F.lds; int tid = F.tid;
    asm volatile("" : "+s"(lbase), "+v"(tid));
    LAS unsigned char* L = (LAS unsigned char*)(uintptr_t)lbase;
    const int lane = tid & 63, w8 = __builtin_amdgcn_readfirstlane(tid >> 6), w = w8 & 3;
    const bool isM = w8 < 4;
    const bf16_t* PR = (const bf16_t*)(F.ws + WS_PR);
    const unsigned char* zrow = F.ws + WS_PGX + (size_t)384 * GQKV * 2;
    bf16_t* mix = (bf16_t*)((unsigned char*)F.out + OS_MIX);
    const float lg = h == 0 ? -0.04580368961312479f : h == 1 ? -0.02272007650008353f : h == 2 ? -0.011315313227834146f : -0.005646563141142063f;
    const int r = lane & 31, hh = lane >> 5;
    f32x16 S[4]; bf16x8 Sb[4][2];
    u32x4 gpre[4] = {{0u, 0u, 0u, 0u}, {0u, 0u, 0u, 0u}, {0u, 0u, 0u, 0u}, {0u, 0u, 0u, 0u}};
#define RET_DMA(nn, dstbase) do { int t0_, c_; chunk_of(sq, (nn), t0_, c_); \
        _Pragma("unroll") for (int k = 0; k < 14; ++k) { const int pc = w + 4 * k; const unsigned char* src_; \
            if (pc < 48) { const int X = pc >> 4, prow = (pc & 15) * 4 + (lane >> 4), p = lane & 15; \
                const int lc = X == 0 ? (p ^ (prow & 15)) : ((((p >> 2) ^ (prow & 3)) << 2) | (p & 3)); \
                src_ = prow < c_ ? (const unsigned char*)(PR + (size_t)(sq.row0 + t0_ + prow) * 2048 + X * 512 + h * 128 + lc * 8) : zrow + p * 16; } \
            else src_ = pimg0 + (size_t)(nn) * 8192 + (pc - 48) * 1024 + lane * 16; \
            glds16(src_, (dstbase) + pc * 1024); } } while (0)
    if (isM) {
#pragma unroll
        for (int t = 0; t < 4; ++t)
#pragma unroll
            for (int e = 0; e < 16; ++e) S[t][e] = 0.f;
#pragma unroll
        for (int t = 0; t < 4; ++t) { Sb[t][0] = pk8(S[t], 0); Sb[t][1] = pk8(S[t], 1); }
    } else {
        RET_DMA(0, lbase);
        { int t0, c; chunk_of(sq, 0, t0, c); const int tok = 16 * w + (lane & 15);
          if (tok < c) { const u32x4* gp = (const u32x4*)(PR + (size_t)(sq.row0 + t0 + tok) * 2048 + 1536 + h * 128 + 32 * (lane >> 4));
#pragma unroll
              for (int k = 0; k < 4; ++k) gpre[k] = gp[k]; } }
        asm volatile("s_waitcnt vmcnt(0)" ::: "memory");
    }
    __syncthreads();
    for (int n = 0; n <= nchunks; ++n) {
        LAS unsigned char* Bc = L + (n & 1) * SC_IMG;
        LAS unsigned char* OSc = L + SC_OS + (n & 1) * SC_OSB; LAS unsigned char* OSp = L + SC_OS + ((n & 1) ^ 1) * SC_OSB;
        if (isM) {
            if (n < nchunks) {
                int lane_ = lane; asm volatile("" : "+v"(lane_));
                const int r_ = lane_ & 31, hh_ = lane_ >> 5, i16_ = lane_ & 15, gb_ = (lane_ >> 4) & 1;
                int t0, c; chunk_of(sq, n, t0, c);
                const int trc = 32 * gb_ + 8 * (i16_ & 3);
                bf16x8 vf[4];
#pragma unroll
                for (int ks = 0; ks < 4; ++ks) {
                    const int ra = 16 * ks + 8 * hh_ + (i16_ >> 2), rb = ra + 4;
                    vf[ks] = mk8(ld_tr(Bc + 32768 + ra * 256 + ((w ^ (ra & 3)) * 64) + trc), ld_tr(Bc + 32768 + rb * 256 + ((w ^ (rb & 3)) * 64) + trc));
                }
#pragma unroll
                for (int mt = 0; mt < 2; ++mt) {
                    f32x16 a1, a2;
#pragma unroll
                    for (int e = 0; e < 16; ++e) { a1[e] = 0.f; a2[e] = 0.f; }
                    const int row = 32 * mt + r_;
#pragma unroll
                    for (int ks = 0; ks < 2 * mt + 2; ++ks) {
                        const bf16x8 ap = *(LAS bf16x8*)(Bc + 49152 + row * 128 + (((2 * ks + hh_) ^ ((row >> 1) & 7)) * 16));
                        a1 = mfma32(ap, vf[ks], a1);
                    }
#pragma unroll
                    for (int t = 0; t < 4; ++t)
#pragma unroll
                        for (int s = 0; s < 2; ++s) {
                            const int c0 = 4 * t + 2 * s;
                            const s16x4 lo = ld_b64(Bc + row * 256 + ((c0 ^ (row & 15)) * 16) + 8 * hh_);
                            const s16x4 hi = ld_b64(Bc + row * 256 + (((c0 + 1) ^ (row & 15)) * 16) + 8 * hh_);
                            a2 = mfma32(mk8(lo, hi), Sb[t][s], a2);
                        }
#pragma unroll
                    for (int q = 0; q < 4; ++q) {
                        float ov[4];
#pragma unroll
                        for (int i = 0; i < 4; ++i) ov[i] = a1[4 * q + i] + exp2f(lg * (float)(32 * mt + 8 * q + 4 * hh_ + i + 1)) * a2[4 * q + i];
                        u32x2 pkd; pkd.x = cvt_pk_bf16(ov[0], ov[1]); pkd.y = cvt_pk_bf16(ov[2], ov[3]);
                        *(LAS u32x2*)(OSc + (32 * w + r_) * OST_PITCH + (32 * mt + 8 * q + 4 * hh_) * 2) = pkd;
                    }
                }
                bf16x8 vd[4];
#pragma unroll
                for (int ks = 0; ks < 4; ++ks) {
                    float f[8];
#pragma unroll
                    for (int j = 0; j < 8; ++j) { const int e = c - 1 - (16 * ks + 8 * hh_ + j); f[j] = e >= 0 ? exp2f(lg * (float)e) : 0.f; }
                    const u32x4 v4 = __builtin_bit_cast(u32x4, vf[ks]);
                    u32x4 o4;
                    o4.x = cvt_pk_bf16(bflo(v4.x) * f[0], bfhi(v4.x) * f[1]); o4.y = cvt_pk_bf16(bflo(v4.y) * f[2], bfhi(v4.y) * f[3]);
                    o4.z = cvt_pk_bf16(bflo(v4.z) * f[4], bfhi(v4.z) * f[5]); o4.w = cvt_pk_bf16(bflo(v4.w) * f[6], bfhi(v4.w) * f[7]);
                    vd[ks] = __builtin_bit_cast(bf16x8, o4);
                }
                const float gc = exp2f(lg * (float)c);
#pragma unroll
                for (int t = 0; t < 4; ++t) {
                    f32x16 a = S[t] * gc;
#pragma unroll
                    for (int ks = 0; ks < 4; ++ks) {
                        const int ra = 16 * ks + 8 * hh_ + (i16_ >> 2), rb = ra + 4;
                        const s16x4 lo = ld_tr(Bc + 16384 + ra * 256 + ((t ^ (ra & 3)) * 64) + trc);
                        const s16x4 hi = ld_tr(Bc + 16384 + rb * 256 + ((t ^ (rb & 3)) * 64) + trc);
                        a = mfma32(mk8(lo, hi), vd[ks], a);
                    }
                    S[t] = a;
                }
#pragma unroll
                for (int t = 0; t < 4; ++t) { Sb[t][0] = pk8(S[t], 0); Sb[t][1] = pk8(S[t], 1); }
            }
        } else {
            if (n + 1 < nchunks) { const unsigned bn = lbase + ((n & 1) ^ 1) * SC_IMG; RET_DMA(n + 1, bn); }
            if (n >= 1) { int t0, c; chunk_of(sq, n - 1, t0, c); scan_finish<0>(OSp, w, lane, h, sq.row0 + t0, c, F.in[12], gpre, mix); }
            if (n < nchunks) { int t0, c; chunk_of(sq, n, t0, c); const int tok = 16 * w + (lane & 15);
                if (tok < c) { const u32x4* gp = (const u32x4*)(PR + (size_t)(sq.row0 + t0 + tok) * 2048 + 1536 + h * 128 + 32 * (lane >> 4));
#pragma unroll
                    for (int k = 0; k < 4; ++k) gpre[k] = gp[k]; } }
            asm volatile("s_waitcnt vmcnt(0)" ::: "memory");
        }
        __syncthreads();
    }
#undef RET_DMA
    if (isM) {
#pragma unroll
        for (int t = 0; t < 4; ++t)
#pragma unroll
            for (int e = 0; e < 16; ++e) sfinal[(32 * t + (e & 3) + 8 * (e >> 2) + 4 * hh) * 128 + 32 * w + r] = S[t][e];
    }
    __syncthreads();
}

__device__ __forceinline__ void sample_pair(Frame& F, int kind, int item0) {
    unsigned lbase = (unsigned)(uintptr_t)F.lds; int tid = F.tid;
    asm volatile("" : "+s"(lbase), "+v"(tid));
    const int half = tid >> 8, tt = tid & 255, col = tt & 127, part = tt >> 7, lane = tid & 63, wv = (tid >> 6) & 3;
    LAS float* B = (LAS float*)(uintptr_t)(lbase + half * 32768);
    LAS float* qs = B; LAS float* ks = B + 512; LAS float* vs = B + 1024; LAS float* T4 = B + 1536; LAS float* US = B + 3072; LAS float* PX = B + 3584; LAS float* SM = B + 5632;
    const int item = item0 + half, sb = item >> 2, h = item & 3;
    const int row0 = MPROMPT + sb * 4;
    const bf16_t* PR = (const bf16_t*)(F.ws + WS_PR); const bf16_t* PG = (const bf16_t*)(F.ws + WS_PG); const float* BG = (const float*)(F.ws + WS_BG);
    bf16_t* mix = (bf16_t*)((unsigned char*)F.out + OS_MIX);
    const float* sin_ = (kind ? F.in[3] : F.in[2]) + (size_t)item * 16384 + (size_t)(64 * part) * 128 + col;
    float* sout = F.out + (kind ? O_SSG : O_SSR) + (size_t)item * 16384 + (size_t)(64 * part) * 128 + col;
    float s[64];
#pragma unroll
    for (int d = 0; d < 64; ++d) s[d] = sin_[d * 128];
    const float lgam = h == 0 ? -0.04580368961312479f : h == 1 ? -0.02272007650008353f : h == 2 ? -0.011315313227834146f : -0.005646563141142063f;
    float cdec = 1.f;
    if (kind == 1) {
        const float* cgw = F.in[9]; const float* stq = F.in[4];
#pragma unroll
        for (int pass = 0; pass < 2; ++pass) {
            const int X = pass == 0 ? part : 2;
            if (pass == 0 || part == 0) {
                const int c = X * 512 + h * 128 + col;
                float full[7];
#pragma unroll
                for (int j = 0; j < 3; ++j) full[j] = stq[(size_t)(sb * 3 + j) * GQKV + c];
#pragma unroll
                for (int t = 0; t < 4; ++t) { const unsigned short b = PG[(size_t)(row0 + t) * 2048 + c]; full[3 + t] = __uint_as_float(((unsigned)b) << 16); }
                const float w0 = cgw[c], w1 = cgw[GQKV + c], w2 = cgw[2 * GQKV + c], w3 = cgw[3 * GQKV + c];
                LAS float* dst = X == 0 ? qs : (X == 1 ? ks : vs);
#pragma unroll
                for (int t = 0; t < 4; ++t) dst[t * 128 + col] = silu_f(w0 * full[t] + w1 * full[t + 1] + w2 * full[t + 2] + w3 * full[t + 3]);
            }
        }
        if (tt < 4) { SM[tt] = BG[(size_t)(row0 + tt) * 8 + 4 + h]; SM[4 + tt] = BG[(size_t)(row0 + tt) * 8 + h]; }
        __syncthreads();
        {
            const float q0 = qs[wv * 128 + lane], q1 = qs[wv * 128 + 64 + lane], k0 = ks[wv * 128 + lane], k1 = ks[wv * 128 + 64 + lane];
            const float rq = rsqrtf(wave_sum(q0 * q0 + q1 * q1) + EPS) * 0.08838834764831845f, rk = rsqrtf(wave_sum(k0 * k0 + k1 * k1) + EPS);
            qs[wv * 128 + lane] = q0 * rq; qs[wv * 128 + 64 + lane] = q1 * rq; ks[wv * 128 + lane] = k0 * rk; ks[wv * 128 + 64 + lane] = k1 * rk;
        }
        __syncthreads();
        float cum[4]; { float a = 0.f;
#pragma unroll
            for (int i = 0; i < 4; ++i) { a += SM[i]; cum[i] = a; } }
        cdec = __expf(cum[3]);
        {
#pragma unroll
            for (int j = 0; j < 4; ++j) {
                const float kk = wave_sum(ks[wv * 128 + lane] * ks[j * 128 + lane] + ks[wv * 128 + 64 + lane] * ks[j * 128 + 64 + lane]);
                const float qk = wave_sum(qs[wv * 128 + lane] * ks[j * 128 + lane] + qs[wv * 128 + 64 + lane] * ks[j * 128 + 64 + lane]);
                if (lane == 0) { const float dec = wv >= j ? __expf(cum[wv] - cum[j]) : 0.f; SM[8 + wv * 4 + j] = wv > j ? SM[4 + wv] * kk * dec : 0.f; SM[24 + wv * 4 + j] = qk * dec; }
            }
        }
        __syncthreads();
        {
            float x[4];
#pragma unroll
            for (int i = 0; i < 4; ++i) {
                float rr = part == 0 ? vs[i * 128 + col] * SM[4 + i] : ks[i * 128 + col] * SM[4 + i] * __expf(cum[i]);
#pragma unroll
                for (int j = 0; j < 4; ++j) if (j < i) rr -= SM[8 + i * 4 + j] * x[j];
                x[i] = rr;
            }
            if (part == 0) {
#pragma unroll
                for (int i = 0; i < 4; ++i) { US[i * 128 + col] = x[i]; T4[col * 12 + 4 + i] = qs[i * 128 + col] * __expf(cum[i]); }
            } else {
#pragma unroll
                for (int i = 0; i < 4; ++i) { T4[col * 12 + i] = x[i]; T4[col * 12 + 8 + i] = ks[i * 128 + col] * __expf(cum[3] - cum[i]); }
            }
        }
        __syncthreads();
    } else {
        if (part == 0) {
#pragma unroll
            for (int t = 0; t < 4; ++t) {
                const bf16_t* rp = PR + (size_t)(row0 + t) * 2048 + h * 128 + col;
                const float qv = __uint_as_float(((unsigned)rp[0]) << 16), kv = __uint_as_float(((unsigned)rp[512]) << 16), vv = __uint_as_float(((unsigned)rp[1024]) << 16);
                qs[t * 128 + col] = qv; ks[t * 128 + col] = kv; vs[t * 128 + col] = vv;
                T4[col * 12 + 4 + t] = qv;
                T4[col * 12 + 8 + t] = kv * exp2f(lgam * (float)(3 - t));
                T4[col * 12 + t] = 0.f;
            }
        }
        __syncthreads();
#pragma unroll
        for (int j = 0; j < 4; ++j) {
            const float qk = wave_sum(qs[wv * 128 + lane] * ks[j * 128 + lane] + qs[wv * 128 + 64 + lane] * ks[j * 128 + 64 + lane]);
            if (lane == 0) SM[24 + wv * 4 + j] = wv >= j ? qk * exp2f(lgam * (float)(wv - j)) : 0.f;
        }
        cdec = exp2f(lgam * 4.0f);
        __syncthreads();
    }
    float pw[4] = {0.f, 0.f, 0.f, 0.f}, pq[4] = {0.f, 0.f, 0.f, 0.f};
#pragma unroll
    for (int d = 0; d < 64; ++d) {
        const LAS f32x4* tp = (const LAS f32x4*)(T4 + (64 * part + d) * 12);
        const f32x4 wk4 = tp[0], qd4 = tp[1];
        pw[0] += wk4[0] * s[d]; pw[1] += wk4[1] * s[d]; pw[2] += wk4[2] * s[d]; pw[3] += wk4[3] * s[d];
        pq[0] += qd4[0] * s[d]; pq[1] += qd4[1] * s[d]; pq[2] += qd4[2] * s[d]; pq[3] += qd4[3] * s[d];
    }
#pragma unroll
    for (int i = 0; i < 4; ++i) { PX[(part * 8 + i) * 128 + col] = pw[i]; PX[(part * 8 + 4 + i) * 128 + col] = pq[i]; }
    __syncthreads();
    float w[4], o[4];
#pragma unroll
    for (int i = 0; i < 4; ++i) {
        const float sw = PX[i * 128 + col] + PX[(8 + i) * 128 + col], sq_ = PX[(4 + i) * 128 + col] + PX[(12 + i) * 128 + col];
        if (kind == 1) { w[i] = US[i * 128 + col] - sw; o[i] = sq_; } else { w[i] = vs[i * 128 + col]; o[i] = exp2f(lgam * (float)(i + 1)) * sq_; }
    }
#pragma unroll
    for (int i = 0; i < 4; ++i)
#pragma unroll
        for (int j = 0; j < 4; ++j) if (j <= i) o[i] += SM[24 + i * 4 + j] * w[j];
#pragma unroll
    for (int d = 0; d < 64; ++d) {
        const f32x4 kd4 = *(const LAS f32x4*)(T4 + (64 * part + d) * 12 + 8);
        sout[d * 128] = cdec * s[d] + kd4[0] * w[0] + kd4[1] * w[1] + kd4[2] * w[2] + kd4[3] * w[3];
    }
    float st[4], sq2[4];
#pragma unroll
    for (int i = 0; i < 4; ++i) { st[i] = wave_sum(o[i]); }
    if (part == 0 && lane == 0) {
#pragma unroll
        for (int i = 0; i < 4; ++i) SM[40 + (wv & 1) * 4 + i] = st[i]; }
    __syncthreads();
    float mu[4];
#pragma unroll
    for (int i = 0; i < 4; ++i) { mu[i] = kind == 0 ? (SM[40 + i] + SM[44 + i]) * (1.0f / 128.0f) : 0.f; const float dd = o[i] - mu[i]; sq2[i] = wave_sum(dd * dd); }
    if (part == 0 && lane == 0) {
#pragma unroll
        for (int i = 0; i < 4; ++i) SM[48 + (wv & 1) * 4 + i] = sq2[i]; }
    __syncthreads();
    if (part == 0) {
        const float nwv = kind == 0 ? F.in[12][h * 128 + col] : F.in[13][col];
        const bf16_t* gsrc = kind == 0 ? PR : PG;
#pragma unroll
        for (int i = 0; i < 4; ++i) {
            const float rstd = rsqrtf((SM[48 + i] + SM[52 + i]) * (1.0f / 128.0f) + EPS);
            const float gate = __uint_as_float(((unsigned)gsrc[(size_t)(row0 + i) * 2048 + 1536 + h * 128 + col]) << 16);
            mix[(size_t)(row0 + i) * DM + (kind == 0 ? 0 : 512) + h * 128 + col] = (bf16_t)(cvt_pk_bf16((o[i] - mu[i]) * rstd * nwv * gate, 0.f) & 0xffffu);
        }
    }
    __syncthreads();
}

struct Args { const float* in[20]; float* out; unsigned char* ws; int ph_lo, ph_hi, li, pad; };
constexpr int NPHASE = 8;

__global__ void __launch_bounds__(512, 2) mega_fwd(Args args) {
    extern __shared__ __attribute__((aligned(16))) unsigned char lds[];
    Frame F;
    F.lds = (LAS unsigned char*)lds;
    F.tid = threadIdx.x; F.lane = F.tid & 63; F.wave = __builtin_amdgcn_readfirstlane(F.tid >> 6);
    F.G = gridDim.x; F.blk = blockIdx.x;
#pragma unroll
    for (int i = 0; i < 20; ++i) F.in[i] = args.in[i];
    F.out = args.out; F.ws = args.ws;
    volatile LAS unsigned* MISC = (volatile LAS unsigned*)(F.lds + MISC_OFF);
    for (int u = F.tid; u < (LDS_BYTES - LDSCTL_OFF) / 4; u += 512) ((LAS unsigned*)(F.lds + LDSCTL_OFF))[u] = 0u;
    __syncthreads();
    unsigned* barw = (unsigned*)(F.ws + WS_CTL) + CW_BAR + args.li * XCD_BAR_WORDS;
    XcdBarrier bar; bar.bar = barw; bar.x = 0; bar.st = nullptr;
    if (MK_N_LAUNCHES == 1) bar = xcd_barrier_post(barw, MISC + 8);
    const int lo = args.ph_lo, hi = args.ph_hi;
#define IN(k) (lo <= (k) && (k) < hi)
#define SEAM(k) do { if (IN(k) && IN((k) + 1)) xcd_barrier(bar); } while (0)
#define STAMP(k) do { if (MK_TPROBE && F.tid == 0) ((unsigned*)(F.ws + WS_CTL))[CW_TS + (k) * 256 + F.blk] = (unsigned)__builtin_amdgcn_s_memrealtime(); } while (0)
    STAMP(0);

    for (int rep = 0; rep < 1 + (MK_REPEAT & 1); ++rep) { if (rep) xcd_barrier(bar); if (IN(0)) { p0_prologue(F); } }
    STAMP(1); SEAM(0);
    for (int rep = 0; rep < 1 + ((MK_REPEAT >> 1) & 1); ++rep) { if (rep) xcd_barrier(bar);
    if (IN(1)) {
        pg8::Gemm g{(const bf16_t*)(F.ws + WS_H), (const bf16_t*)(F.ws + WS_WIN), 1024};
        pg8::StaticOrder S; S.init(MPAD / 256, NIN / 256, F.G, F.blk);
        EpiIn E{(bf16_t*)(F.ws + WS_PR), (bf16_t*)(F.ws + WS_PG), (const float*)(F.ws + WS_ROT), F.out};
        pg8::gemm_phase<EpiIn, pg8::StaticOrder, pg8::MapPlain>(F.lds, g, S, E);
    } }
    STAMP(2); SEAM(1);
#pragma unroll 1
    for (int phx = 0; phx < 2 + ((MK_REPEAT >> 2) & 1) + ((MK_REPEAT >> 3) & 1); ++phx) {
        const int ph = phx < 1 + ((MK_REPEAT >> 2) & 1) ? 2 : 3;
        if (phx > 0 && IN(2) && IN(3)) { STAMP(3); xcd_barrier(bar); }
        if (IN(ph)) {
            int it, iend, istep;
            if (ph == 2) { it = F.blk; iend = 1056 + 512 + 1056; istep = F.G; }
            else { it = F.blk; iend = F.blk < 64 ? F.blk + 1 : 0; istep = 1; }
            int kcount = 0; unsigned tl_end = 0u;
#pragma unroll 1
            for (; it < iend; it += istep) {
                const unsigned tl0 = MK_TPROBE ? (unsigned)__builtin_amdgcn_s_memrealtime() : 0u;
                if (MK_TPROBE && ph == 2 && F.tid == 0 && kcount < 12) { ((unsigned*)(F.ws + WS_CTL))[CW_TS + (13 + kcount) * 256 + F.blk] = tl0; }
                if (MK_TPROBE && ph == 2 && F.tid == 0 && tl_end != 0u && it >= 1568) { ((unsigned*)(F.ws + WS_CTL))[CW_TS + 32 * 256 + F.blk] += tl0 - tl_end; }
                ++kcount;
                int kind, h = 0, nch = 0, t0 = 0, c = 4; SeqD sq{0, 0, 0, 0}; unsigned char* slot = nullptr; float* sfinal = nullptr; int pair0 = 0;
                if (ph == 2) {
                    if (it < 1056) {
                        const int bh = it / 33, n = it - bh * 33, b = bh >> 2; h = bh & 3; kind = 0;
                        sq = SeqD{b * LP, LP, 0, b}; t0 = n == 0 ? 0 : 16 + 64 * (n - 1); c = n == 0 ? 16 : 64;
                        slot = F.ws + WS_G2A + (size_t)it * SLOT;
                    } else if (it < 1056 + 512) { const int j = it - 1056; kind = j < 256 ? 4 : 5; pair0 = (j & 255) * 2; }
                    else { const int i2 = it - 1568, bh = i2 / 33, n = i2 - bh * 33, b = bh >> 2; h = bh & 3; kind = 6;
                        sq = SeqD{b * LP, LP, 0, b}; t0 = n == 0 ? 0 : 16 + 64 * (n - 1); c = n == 0 ? 16 : 64; slot = F.ws + WS_RP + (size_t)i2 * 8192; }
                } else {
                    const int bb = it & 31, b = bb >> 2; h = bb & 3; kind = it < 32 ? 1 : 2; nch = 33;
                    sq = SeqD{b * LP, LP, 0, b};
                    slot = F.ws + WS_G2A + (size_t)(bb * 33) * SLOT;
                    sfinal = F.out + (it < 32 ? O_PSG : O_PSR) + (size_t)bb * 16384;
                }
                if (kind == 0) p2a_item(F, sq, h, t0, c, slot);
                if (kind == 4 || kind == 5) sample_pair(F, kind == 4 ? 1 : 0, pair0);
                if (kind == 1) scan_gdn(F, sq, h, nch, slot, nullptr, sfinal);
                if (kind == 6) {
                    const unsigned tz0 = MK_TPROBE ? (unsigned)__builtin_amdgcn_s_memrealtime() : 0u;
                    ret_prepass_item(F, sq, h, t0, c, slot);
                    const unsigned tz1 = MK_TPROBE ? (unsigned)__builtin_amdgcn_s_memrealtime() : 0u;
                    if (MK_TPROBE && F.tid == 0) { unsigned* TS = (unsigned*)(F.ws + WS_CTL) + CW_TS; TS[29 * 256 + F.blk] += tz1 - tz0; if (TS[30 * 256 + F.blk] == 0) TS[30 * 256 + F.blk] = tz0; TS[31 * 256 + F.blk] = tz1 - TS[30 * 256 + F.blk]; }
                }
                if (kind == 2) scan_ret(F, sq, h, nch, F.ws + WS_RP + (size_t)((it & 31) * 33) * 8192, sfinal);
                tl_end = MK_TPROBE ? (unsigned)__builtin_amdgcn_s_memrealtime() : 0u;
                if (MK_TPROBE && ph == 2 && F.tid == 0 && it >= 1568) { ((unsigned*)(F.ws + WS_CTL))[CW_TS + 33 * 256 + F.blk] += tl_end - tl0; }
            }
        }
    }
    STAMP(4); SEAM(3);
    for (int rep = 0; rep < 1 + ((MK_REPEAT >> 4) & 1); ++rep) { if (rep) xcd_barrier(bar);
    if (IN(4)) {
        pg8::Gemm g{(const bf16_t*)((unsigned char*)F.out + OS_MIX), (const bf16_t*)(F.ws + WS_WOUT), 1024};
        pg8::StaticOrder S; S.init(MPAD / 256, 4, F.G, F.blk);
        EpiOut E{F.in[0], F.in[1], F.in[6], (bf16_t*)(F.ws + WS_X2B), (float*)(F.ws + WS_RSQ2)};
        pg8::gemm_phase<EpiOut, pg8::StaticOrder, pg8::MapPlain>(F.lds, g, S, E);
    } }
    STAMP(5); SEAM(4);
    for (int rep = 0; rep < 1 + ((MK_REPEAT >> 5) & 1); ++rep) { if (rep) xcd_barrier(bar);
    if (IN(5)) {
        pg8::Gemm g{(const bf16_t*)(F.ws + WS_X2B), (const bf16_t*)(F.ws + WS_WUP), 1024};
        pg8::StaticOrder S; S.init(UP_NM, NUP / 256, F.G, F.blk);
        EpiUp E{(const float*)(F.ws + WS_RSQ2), F.in[17], F.in[5], (bf16_t*)(F.ws + WS_ACT), F.out};
        pg8::gemm_phase<EpiUp, pg8::StaticOrder, pg8::MapUp>(F.lds, g, S, E);
    } }
    STAMP(6); SEAM(5);
    for (int rep = 0; rep < 1 + ((MK_REPEAT >> 6) & 1); ++rep) { if (rep) xcd_barrier(bar);
    if (IN(6)) {
        pg8::Gemm g{(const bf16_t*)(F.ws + WS_ACT), (const bf16_t*)(F.ws + WS_WDN), DFF};
        pg8::StaticOrder S; S.init(MPAD / 256, 4, F.G, F.blk);
        EpiDown E{(const bf16_t*)(F.ws + WS_X2B), F.out, (float*)(F.ws + WS_RSQ3)};
        pg8::gemm_phase<EpiDown, pg8::StaticOrder, pg8::MapPlain>(F.lds, g, S, E);
    } }
    STAMP(7); SEAM(6);
    if (IN(7)) {
        const float* rsq = (const float*)(F.ws + WS_RSQ3); const float* nf = F.in[19];
        const int gw = F.blk * 8 + F.wave, NGW = F.G * 8;
        for (int q = gw; q < 16384 + 512; q += NGW) {
            int g; float* dst;
            if (q < 16384) { g = (q >> 11) * LP + 16 + (q & 2047); dst = F.out + O_YP + (size_t)q * DM; } else { g = MPROMPT + (q - 16384); dst = F.out + O_YS + (size_t)(q - 16384) * DM; }
            float s = F.lane < 16 ? rsq[(size_t)g * 16 + F.lane] : 0.f;
            s = wave_sum(s);
            const float rstd = rsqrtf(s * (1.0f / DM) + EPS);
            f32x4* p = (f32x4*)dst + F.lane; const f32x4* np = (const f32x4*)nf + F.lane;
#pragma unroll
            for (int j = 0; j < 4; ++j) { f32x4 v = p[64 * j]; v = v * rstd * np[64 * j]; p[64 * j] = v; }
        }
    }
    if (MK_TPROBE && IN(7)) {
        STAMP(8);
        xcd_barrier(bar);
        if (F.blk == 0) {
            LAS float* sh = (LAS float*)F.lds;
            if (F.tid == 0) {
                const unsigned* TS = (const unsigned*)(F.ws + WS_CTL) + CW_TS;
                auto mx = [&](int k, int lo_, int hi_) { unsigned m = TS[k * 256 + lo_]; for (int b = lo_; b < hi_; ++b) { const unsigned v = TS[k * 256 + b]; if ((int)(v - m) > 0) m = v; } return m; };
                unsigned d = 0;
                const int sel = MK_TPROBE;
                if (sel >= 1 && sel <= 8) d = mx(sel, 0, F.G) - mx(sel - 1, 0, F.G);
                else if (sel == 10) d = TS[4 * 256 + 0] - mx(3, 0, F.G);
                else if (sel == 11) d = TS[4 * 256 + 32] - mx(3, 0, F.G);
                else if (sel == 12) d = mx(4, 64, F.G) - mx(3, 0, F.G);
                else if (sel == 13) d = mx(8, 0, F.G) - TS[0];
                else if (sel >= 20 && sel <= 23) d = TS[(sel - 11) * 256 + 0];
                else if (sel >= 30 && sel <= 41) d = TS[(sel - 17) * 256 + 0] - mx(2, 0, F.G);
                else if (sel >= 50 && sel <= 59) d = TS[(sel - 24) * 256 + 0];
                sh[0] = sqrtf(MK_TSCALE * (float)d * 0.01f);
            }
            __syncthreads();
            const float f = 1.0f + sh[0];
            for (int e = F.tid; e < 8 * 3 * GQKV; e += 512) F.out[O_PCQ + e] *= f;
        }
    }
#undef IN
#undef SEAM
}

extern "C" void kernel_launch(void* const* d_in, const int* in_sizes, int n_in, void* d_out, int out_size, void* d_ws, size_t ws_size, hipStream_t stream) {
    static int grid = 0;
    if (grid == 0) {
        if (n_in != 20 || (size_t)out_size != O_TOTAL || ws_size < WS_END) { fprintf(stderr, "kernel_launch: unexpected shapes (n_in %d, out %d, ws %zu); nothing launched\n", n_in, out_size, ws_size); grid = -1; return; }
        int dev = 0, cus = 0;
        if (hipGetDevice(&dev) != hipSuccess || hipDeviceGetAttribute(&cus, hipDeviceAttributeMultiprocessorCount, dev) != hipSuccess) { grid = -1; return; }
        if (hipFuncSetAttribute((const void*)mega_fwd, hipFuncAttributeMaxDynamicSharedMemorySize, LDS_BYTES) != hipSuccess) { fprintf(stderr, "kernel_launch: hipFuncSetAttribute failed\n"); grid = -1; return; }
        (void)hipGetLastError();
        grid = cus;
        if (grid < 128 || (grid & 7)) { fprintf(stderr, "kernel_launch: unexpected CU count %d\n", cus); }
    }
    if (grid < 0) return;
    if (hipMemsetAsync((char*)d_ws + WS_CTL, 0, CTL_ZERO_BYTES, stream) != hipSuccess) return;
    Args a{};
    for (int i = 0; i < 20; ++i) a.in[i] = (const float*)d_in[i];
    a.out = (float*)d_out; a.ws = (unsigned char*)d_ws;
#if MK_N_LAUNCHES == 1
    a.ph_lo = 0; a.ph_hi = NPHASE; a.li = 0;
    hipLaunchKernelGGL(mega_fwd, dim3(grid), dim3(512), LDS_BYTES, stream, a);
#else
    for (int li = 0; li < NPHASE; ++li) { a.ph_lo = li; a.ph_hi = li + 1; a.li = 0; hipLaunchKernelGGL(mega_fwd, dim3(grid), dim3(512), LDS_BYTES, stream, a); }
#endif
}
```

```cpp
#include <hip/hip_runtime.h>
#include <cstdio>
#include <cstdint>

#ifndef MK_REPEAT
#define MK_REPEAT 0
#endif
#ifndef MK_TPROBE
#define MK_TPROBE 0
#endif
#ifndef MK_TSCALE
#define MK_TSCALE 2e-7f
#endif
#ifndef MK_N_LAUNCHES
#define MK_N_LAUNCHES 1
#endif

#define LAS __attribute__((address_space(3)))
typedef unsigned short bf16_t;
typedef short bf16x8 __attribute__((ext_vector_type(8)));
typedef short s16x4 __attribute__((ext_vector_type(4)));
typedef float f32x4 __attribute__((ext_vector_type(4)));
typedef unsigned u32x4 __attribute__((ext_vector_type(4)));
typedef unsigned u32x2 __attribute__((ext_vector_type(2)));

constexpr int DM = 1024, LP = 2064, NBATCH = 8, MPROMPT = NBATCH * LP  , NSB = 128, MSAMP = 512, MREAL = MPROMPT + MSAMP  , MPAD = 17152  ;
constexpr int NIN = 4096, INW = 4104, DFF = 2816, NUP = 5632, GQKV = 1536;
constexpr int UP_TROWS = 248, UP_NM = 69;
constexpr float EPS = 1e-6f;
constexpr size_t O_YP = 0, O_YS = 16777216, O_PSR = 17301504, O_PSG = 17825792, O_PCQ = 18350080, O_PCF = 18386944, O_SSR = 18477056, O_SSG = 26865664, O_SCQ = 35254272, O_SCF = 35844096, O_TOTAL = 37285888;
constexpr size_t MiB = 1u << 20;
constexpr size_t WS_CTL = 0, CTL_ZERO_BYTES = 1 * MiB;
constexpr size_t WS_WIN = 1 * MiB, WS_WOUT = 9 * MiB, WS_WUP = 11 * MiB, WS_WDN = 22 * MiB, WS_ROT = 28 * MiB, WS_BG = 30 * MiB, WS_RSQ2 = 31 * MiB, WS_RSQ3 = 32 * MiB + 512 * 1024;
constexpr size_t WS_PGX = 34 * MiB;
constexpr size_t WS_BIG = 36 * MiB;
constexpr size_t WS_PR = WS_BIG, WS_PG = WS_BIG + 67 * MiB, WS_G2A = WS_BIG + 134 * MiB, WS_H = WS_G2A;
constexpr size_t WS_X2F = WS_BIG, WS_X2B = WS_BIG + 67 * MiB, WS_ACT = WS_BIG + 101 * MiB;
constexpr size_t SLOT = 73984;
constexpr size_t WS_RP = WS_BIG + 209 * MiB;
constexpr size_t WS_END = 256 * MiB;
static_assert(WS_G2A + 1056 * SLOT <= WS_RP && WS_RP + 1056 * 8192 <= WS_END && WS_ACT + (size_t)MPAD * DFF * 2 <= WS_END, "ws map");
constexpr size_t OS_MIX = 0, OS_SCR = 34 * MiB;
static_assert(OS_SCR + 256 * SLOT <= 64 * MiB, "d_out scratch");
constexpr int CW_BAR = 4096, CW_TS = 16384, CW_FLAG = 65536;
constexpr int RING_BYTES = 131072, LDSCTL_OFF = 150528, MISC_OFF = LDSCTL_OFF + 320, LDS_BYTES = 151552;

#define LDS_WAIT() asm volatile("s_waitcnt lgkmcnt(0)" ::: "memory")
#define VM_WAIT() asm volatile("s_waitcnt vmcnt(0)" ::: "memory")

typedef float f32x2_t __attribute__((ext_vector_type(2))); typedef __bf16 bf16x2_t __attribute__((ext_vector_type(2)));
__device__ __forceinline__ unsigned cvt_pk_bf16(float lo, float hi) { const f32x2_t v = {lo, hi}; const bf16x2_t b = __builtin_convertvector(v, bf16x2_t); return __builtin_bit_cast(unsigned, b); }
__device__ __forceinline__ float bflo(unsigned w) { return __uint_as_float(w << 16); }
__device__ __forceinline__ float bfhi(unsigned w) { return __uint_as_float(w & 0xffff0000u); }
__device__ __forceinline__ float bfround(float x) { return bflo(cvt_pk_bf16(x, 0.f)); }
__device__ __forceinline__ float silu_f(float y) { return y * __builtin_amdgcn_rcpf(1.0f + __expf(-y)); }
__device__ __forceinline__ float wave_sum(float v) {
#pragma unroll
    for (int o = 1; o < 64; o <<= 1) v += __shfl_xor(v, o);
    return v;
}
__device__ __forceinline__ float bsel(int mask  , float a_if_set, float b_if_clear) { return __int_as_float((mask & __float_as_int(a_if_set)) | (~mask & __float_as_int(b_if_clear))); }
__device__ __forceinline__ float dpp_shr1(float x) { return __int_as_float(__builtin_amdgcn_update_dpp(0, __float_as_int(x), 0x111, 0xf, 0xf, true)); }

struct RowInfo { int t, len, idx, samp; };
__device__ __forceinline__ RowInfo rowinfo(int g) {
    RowInfo r;
    if (g < MPROMPT) { r.idx = g / LP; r.t = g - r.idx * LP; r.len = LP; r.samp = 0; }
    else { const int s = g - MPROMPT; r.idx = s >> 2; r.t = s & 3; r.len = 4; r.samp = 1; }
    return r;
}

namespace pg8 {
constexpr int BM = 256, BK = 64, HALF = 128, HTB = HALF * BK * 2, STAGE_BYTES = 8 * HTB, NXCD = 8, WGM = 8;
__host__ __device__ __forceinline__ int lds_byte(int r, int c) { const int st = (r >> 4) * 2 + (c >> 5), rr = r & 15, cc = c & 31, ob = rr * 64 + cc * 2; return st * 1024 + (ob ^ (((ob >> 9) & 1) << 5)); }
__host__ __device__ __forceinline__ void stage_rc(int b, int& R, int& C) { const int st = b / 1024, sb = b % 1024, swz = sb ^ (((sb >> 9) & 1) << 5); R = (st >> 1) * 16 + swz / 64; C = (st & 1) * 32 + (swz % 64) / 2; }
__host__ __device__ __forceinline__ int perm32(int rho) { const int n = rho >> 4, i = rho & 15; return 8 * (i >> 2) + 4 * n + (i & 3); }
struct Unit { int pm, pn; };
struct Gemm { const bf16_t* A; const bf16_t* Bt; int K; };
struct StaticOrder {
    int nM, nN, nwg, G, c;
    __host__ __device__ void init(int nM_, int nN_, int G_, int c_) { nM = nM_; nN = nN_; nwg = nM * nN; G = G_; c = c_; }
    __host__ __device__ bool next(int i, Unit& u) const {
        const long L = (long)i * G + c; if (L >= nwg) return false;
        int wgid = (int)L; { const int q = nwg / NXCD, r = nwg % NXCD, xcd = wgid % NXCD, off = wgid / NXCD; wgid = (xcd < r ? xcd * (q + 1) : r * (q + 1) + (xcd - r) * q) + off; }
        const int nig = WGM * nN, gid = wgid / nig, fm = gid * WGM, gsz = (nM - fm) < WGM ? (nM - fm) : WGM;
        u.pm = fm + ((wgid % nig) % gsz); u.pn = (wgid % nig) / gsz; return true;
    }
    __device__ __forceinline__ void a_ready(const Unit&) const {}
    __device__ __forceinline__ void done(const Unit&) const {}
};
struct MapPlain { static constexpr int HROWS = 128, TROWS = 256; static __device__ __forceinline__ int row(int R) { return R; } };
struct MapUp { static constexpr int HROWS = 124, TROWS = UP_TROWS; static __device__ __forceinline__ int row(int R) { return 62 * (R >> 6) - 2 + 4 * (R & 15) + ((R >> 4) & 3); } };

template <class Epi, class Sched, class AMap, bool ALIGN_EPI = true>
__device__ __forceinline__ void gemm_phase(LAS unsigned char* lds, const Gemm g, const Sched& S, const Epi& E) {
    const int tid = threadIdx.x, wid = __builtin_amdgcn_readfirstlane(tid >> 6), lane = tid & 63, wr = wid >> 2, wc = wid & 3, fr = lane & 15, fq = lane >> 4;
    const int K = g.K, nt = K / BK;
    int voffA[2], voffB[2];
#pragma unroll
    for (int i = 0; i < 2; ++i) { int R, C; stage_rc(tid * 16 + i * 8192, R, C); const int Rb = Epi::PERM ? ((R & ~31) + perm32(R & 31)) : R;
        voffA[i] = (AMap::row(R) * K + C) * 2; voffB[i] = (Rb * K + C) * 2; }
    const size_t kstep = (size_t)(BK * 2);
    const size_t hstepA = (size_t)AMap::HROWS * K * 2, tstepA = (size_t)AMap::TROWS * K * 2;
    const size_t hstepB = (size_t)HALF * K * 2, tstepB = 2 * hstepB;
    const unsigned ldsw = (unsigned)wid * 1024u;
    const int aoff = lds_byte(wr * 64 + fr, fq * 8), boff = lds_byte(wc * 32 + fr, fq * 8);
#define PG8_SA(b, h) (((b) * 2 + (h)) * HTB)
#define PG8_SB(b, h) ((4 + (b) * 2 + (h)) * HTB)
#define PG8_STAGE(bufoff, gbase, voff) do { _Pragma("unroll") for (int _i = 0; _i < 2; ++_i) \
        __builtin_amdgcn_global_load_lds((const unsigned*)((const char*)(gbase) + (voff)[_i]), (LAS unsigned*)(lds + (bufoff) + ldsw + _i * 8192), 16, 0, 0); } while (0)
#define PG8_LDA(dst, b, h) do { _Pragma("unroll") for (int m = 0; m < 4; ++m) _Pragma("unroll") for (int k = 0; k < 2; ++k) dst[m][k] = *(const LAS bf16x8*)(lds + PG8_SA(b, h) + aoff + m * 2048 + k * 1024); } while (0)
#define PG8_LDB(dst, b, h) do { _Pragma("unroll") for (int n = 0; n < 2; ++n) _Pragma("unroll") for (int k = 0; k < 2; ++k) dst[n][k] = *(const LAS bf16x8*)(lds + PG8_SB(b, h) + boff + n * 2048 + k * 1024); } while (0)
#define PG8_MMA(ai, bj, At, Bt) do { __builtin_amdgcn_s_setprio(1); _Pragma("unroll") for (int m = 0; m < 4; ++m) _Pragma("unroll") for (int n = 0; n < 2; ++n) _Pragma("unroll") for (int k = 0; k < 2; ++k) \
        acc[ai][bj][m][n] = __builtin_amdgcn_mfma_f32_16x16x32_bf16(Bt[n][k], At[m][k], acc[ai][bj][m][n], 0, 0, 0); __builtin_amdgcn_s_setprio(0); } while (0)
#define PG8_WAIT_V(n) asm volatile("s_waitcnt vmcnt(" #n ")" ::: "memory")
#define PG8_WAIT_L(n) asm volatile("s_waitcnt lgkmcnt(" #n ")" ::: "memory")
#define PG8_BAR __builtin_amdgcn_s_barrier()
#define PG8_SCHED __builtin_amdgcn_sched_barrier(0)
    Unit cur, nxt; int ui = 0;
    if (!S.next(0, cur)) return;
    f32x4 acc[2][2][4][2];
#pragma unroll
    for (int a = 0; a < 2; ++a)
#pragma unroll
        for (int b = 0; b < 2; ++b)
#pragma unroll
            for (int m = 0; m < 4; ++m)
#pragma unroll
                for (int n = 0; n < 2; ++n) acc[a][b][m][n] = (f32x4){0.f, 0.f, 0.f, 0.f};
    bf16x8 At[4][2], B0[2][2], B1[2][2];
    const char* cA = (const char*)g.A + (size_t)cur.pm * tstepA; const char* cB = (const char*)g.Bt + (size_t)cur.pn * tstepB;
    S.a_ready(cur);
    PG8_STAGE(PG8_SB(0, 0), cB, voffB); PG8_STAGE(PG8_SB(0, 1), cB + hstepB, voffB); PG8_STAGE(PG8_SA(0, 0), cA, voffA); PG8_STAGE(PG8_SA(0, 1), cA + hstepA, voffA);
    if (wr == 1) PG8_BAR;
    PG8_WAIT_V(2); PG8_BAR;
    PG8_STAGE(PG8_SB(1, 0), cB + kstep, voffB); PG8_STAGE(PG8_SA(1, 0), cA + kstep, voffA); PG8_STAGE(PG8_SB(1, 1), cB + hstepB + kstep, voffB);
    PG8_WAIT_V(6); PG8_BAR;
    for (;;) {
        const bool has_next = S.next(ui + 1, nxt);
        const char* nA = has_next ? (const char*)g.A + (size_t)nxt.pm * tstepA : cA; const char* nB = has_next ? (const char*)g.Bt + (size_t)nxt.pn * tstepB : cB;
        for (int t = 0; t < nt; t += 2) {
            const bool last = (t == nt - 2);
            const char* a1 = cA + (size_t)(t + 1) * kstep;
            const char* a2 = last ? nA : cA + (size_t)(t + 2) * kstep; const char* b2 = last ? nB : cB + (size_t)(t + 2) * kstep;
            const char* a3 = a2 + kstep; const char* b3 = b2 + kstep;
            if (last && has_next) S.a_ready(nxt);
            PG8_LDB(B0, 0, 0); PG8_LDB(B1, 0, 1); PG8_SCHED; PG8_LDA(At, 0, 0); PG8_STAGE(PG8_SA(1, 1), a1 + hstepA, voffA);
            PG8_WAIT_V(8); PG8_WAIT_L(0); PG8_BAR; PG8_MMA(0, 0, At, B0); PG8_MMA(0, 1, At, B1); PG8_BAR; PG8_SCHED;
            PG8_LDA(At, 0, 1); PG8_STAGE(PG8_SB(0, 0), b2, voffB); PG8_STAGE(PG8_SB(0, 1), b2 + hstepB, voffB); PG8_STAGE(PG8_SA(0, 0), a2, voffA);
            PG8_WAIT_V(8); PG8_WAIT_L(0); PG8_BAR; PG8_MMA(1, 0, At, B0); PG8_MMA(1, 1, At, B1); PG8_BAR; PG8_SCHED;
            PG8_LDB(B0, 1, 0); PG8_LDB(B1, 1, 1); PG8_SCHED; PG8_LDA(At, 1, 0); PG8_STAGE(PG8_SA(0, 1), a2 + hstepA, voffA);
            PG8_WAIT_V(8); PG8_WAIT_L(0); PG8_BAR; PG8_MMA(0, 0, At, B0); PG8_MMA(0, 1, At, B1); PG8_BAR; PG8_SCHED;
            PG8_LDA(At, 1, 1); PG8_STAGE(PG8_SB(1, 0), b3, voffB); PG8_STAGE(PG8_SB(1, 1), b3 + hstepB, voffB); PG8_STAGE(PG8_SA(1, 0), a3, voffA);
            PG8_WAIT_V(8); PG8_WAIT_L(0); PG8_BAR; PG8_MMA(1, 0, At, B0); PG8_MMA(1, 1, At, B1); PG8_BAR; PG8_SCHED;
        }
        if constexpr (ALIGN_EPI) { if (wr == 0) PG8_BAR; }
        E(acc, cur, wr, wc, fr, fq); S.done(cur);
        if (!has_next) break;
#pragma unroll
        for (int a = 0; a < 2; ++a)
#pragma unroll
            for (int b = 0; b < 2; ++b)
#pragma unroll
                for (int m = 0; m < 4; ++m)
#pragma unroll
                    for (int n = 0; n < 2; ++n) acc[a][b][m][n] = (f32x4){0.f, 0.f, 0.f, 0.f};
        cur = nxt; cA = nA; cB = nB; ++ui;
        if constexpr (ALIGN_EPI) { if (wr == 1) PG8_BAR; }
    }
    PG8_WAIT_V(0);
    if constexpr (!ALIGN_EPI) { if (wr == 0) PG8_BAR; }
    PG8_BAR;
#undef PG8_SA
#undef PG8_SB
#undef PG8_STAGE
#undef PG8_LDA
#undef PG8_LDB
#undef PG8_MMA
#undef PG8_WAIT_V
#undef PG8_WAIT_L
#undef PG8_BAR
#undef PG8_SCHED
}
}
using pg8::Unit;


struct EpiIn {
    static constexpr bool PERM = true;
    bf16_t* PR; bf16_t* PG; const float* rot; float* out;
    __device__ __forceinline__ void operator()(const f32x4 (&acc)[2][2][4][2], const Unit& u, int wr, int wc, int fr_, int fq_) const {
        int ln_; asm volatile("v_mbcnt_lo_u32_b32 %0, -1, 0\n\tv_mbcnt_hi_u32_b32 %0, -1, %0" : "=v"(ln_)); const int fr = ln_ & 15, fq = ln_ >> 4;
        const int pn = u.pn, rbase = u.pm * 256 + wr * 64 + fr;
        if (pn < 4) {
            const int head = (pn & 1) * 2 + (wc >> 1), j0 = 32 * (wc & 1) + 8 * fq;
            const float sc = pn >= 2 ? 0.08838834764831845f : 1.0f;
            bf16_t* dstb = PR + (pn >= 2 ? 512 : 0) + head * 128 + j0;
#pragma unroll
            for (int ai = 0; ai < 2; ++ai)
#pragma unroll
                for (int m = 0; m < 4; ++m) {
                    const int row = rbase + ai * 128 + m * 16;
                    int ridx = 0; if (row < MPROMPT) ridx = row % LP; else if (row < MREAL) ridx = LP + ((row - MPROMPT) & 3);
                    const f32x4* rp = (const f32x4*)(rot + (size_t)ridx * 128 + j0 * 2);
                    const f32x4 cs0 = rp[0], cs1 = rp[1], cs2 = rp[2], cs3 = rp[3];
                    const f32x4 a0 = acc[ai][0][m][0], a1 = acc[ai][0][m][1], b0 = acc[ai][1][m][0], b1 = acc[ai][1][m][1];
                    const float c[8] = {cs0[0], cs0[2], cs1[0], cs1[2], cs2[0], cs2[2], cs3[0], cs3[2]};
                    const float s[8] = {cs0[1], cs0[3], cs1[1], cs1[3], cs2[1], cs2[3], cs3[1], cs3[3]};
                    const float x1[8] = {a0[0], a0[1], a0[2], a0[3], a1[0], a1[1], a1[2], a1[3]};
                    const float x2[8] = {b0[0], b0[1], b0[2], b0[3], b1[0], b1[1], b1[2], b1[3]};
                    float o1[8], o2[8];
#pragma unroll
                    for (int i = 0; i < 8; ++i) { o1[i] = (x1[i] * c[i] - x2[i] * s[i]) * sc; o2[i] = (x1[i] * s[i] + x2[i] * c[i]) * sc; }
                    u32x4 w1, w2; w1.x = cvt_pk_bf16(o1[0], o1[1]); w1.y = cvt_pk_bf16(o1[2], o1[3]); w1.z = cvt_pk_bf16(o1[4], o1[5]); w1.w = cvt_pk_bf16(o1[6], o1[7]);
                    w2.x = cvt_pk_bf16(o2[0], o2[1]); w2.y = cvt_pk_bf16(o2[2], o2[3]); w2.z = cvt_pk_bf16(o2[4], o2[5]); w2.w = cvt_pk_bf16(o2[6], o2[7]);
                    bf16_t* rowp = dstb + (size_t)row * 2048;
                    *(u32x4*)(rowp) = w1; *(u32x4*)(rowp + 64) = w2;
                }
        } else {
            const bool act = (pn == 6 || pn == 7 || pn >= 14);
            const bool cst = (pn >= 8 && pn < 14);
            bf16_t* dbase = pn < 8 ? PR : PG;
            const int colt = (pn < 8 ? pn * 256 : pn * 256 - 2048) + wc * 32 + 8 * fq;
#pragma unroll
            for (int ai = 0; ai < 2; ++ai)
#pragma unroll
                for (int m = 0; m < 4; ++m) {
                    const int row = rbase + ai * 128 + m * 16;
                    bf16_t* rowp = dbase + (size_t)row * 2048 + colt;
                    float* cdst = nullptr;
                    if (cst && row < MREAL) { const RowInfo ri = rowinfo(row); if (ri.t >= ri.len - 3) cdst = out + (ri.samp ? O_SCQ : O_PCQ) + (size_t)(ri.idx * 3 + (ri.t - (ri.len - 3))) * GQKV + colt; }
#pragma unroll
                    for (int bj = 0; bj < 2; ++bj) {
                        f32x4 v0 = acc[ai][bj][m][0], v1 = acc[ai][bj][m][1];
                        if (cdst) { *(f32x4*)(cdst + bj * 128) = v0; *(f32x4*)(cdst + bj * 128 + 4) = v1; }
                        if (act) {
#pragma unroll
                            for (int i = 0; i < 4; ++i) { v0[i] = silu_f(v0[i]); v1[i] = silu_f(v1[i]); }
                        }
                        u32x4 w; w.x = cvt_pk_bf16(v0[0], v0[1]); w.y = cvt_pk_bf16(v0[2], v0[3]); w.z = cvt_pk_bf16(v1[0], v1[1]); w.w = cvt_pk_bf16(v1[2], v1[3]);
                        *(u32x4*)(rowp + bj * 128) = w;
                    }
                }
        }
    }
};

__device__ __forceinline__ const float* x_src_row(const float* xp, const float* xs, const float* meta, int g) {
    if (g < MPROMPT) { const int b = g / LP, t = g - b * LP; return t < 16 ? meta + (size_t)t * DM : xp + ((size_t)b * 2048 + (t - 16)) * DM; }
    return xs + (size_t)(g - MPROMPT) * DM;
}

struct EpiOut {
    static constexpr bool PERM = false;
    const float* xp; const float* xs; const float* meta; bf16_t* X2B; float* rsq;
    __device__ __forceinline__ void operator()(const f32x4 (&acc)[2][2][4][2], const Unit& u, int wr, int wc, int fr_, int fq_) const {
        int ln_; asm volatile("v_mbcnt_lo_u32_b32 %0, -1, 0\n\tv_mbcnt_hi_u32_b32 %0, -1, %0" : "=v"(ln_)); const int fr = ln_ & 15, fq = ln_ >> 4;
        const int rbase = u.pm * 256 + wr * 64 + fr, col0 = u.pn * 256 + wc * 32 + 4 * fq;
#pragma unroll
        for (int ai = 0; ai < 2; ++ai)
#pragma unroll
            for (int m = 0; m < 4; ++m) {
                const int row = rbase + ai * 128 + m * 16;
                const float* xr = row < MREAL ? x_src_row(xp, xs, meta, row) + col0 : nullptr;
                bf16_t* ob = X2B + (size_t)row * DM + col0;
                float ss = 0.f;
#pragma unroll
                for (int bj = 0; bj < 2; ++bj)
#pragma unroll
                    for (int n = 0; n < 2; ++n) {
                        f32x4 v = acc[ai][bj][m][n];
                        if (xr) v += *(const f32x4*)(xr + bj * 128 + n * 16);
                        ss += (v[0] * v[0] + v[1] * v[1]) + (v[2] * v[2] + v[3] * v[3]);
                        u32x2 w; w.x = cvt_pk_bf16(v[0], v[1]); w.y = cvt_pk_bf16(v[2], v[3]);
                        *(u32x2*)(ob + bj * 128 + n * 16) = w;
                    }
                ss += __shfl_xor(ss, 16); ss += __shfl_xor(ss, 32);
                if (fq == 0) rsq[(size_t)row * 16 + u.pn * 4 + wc] = ss;
            }
    }
};

struct EpiDown {
    static constexpr bool PERM = false;
    const bf16_t* X2B; float* out; float* rsq;
    __device__ __forceinline__ void operator()(const f32x4 (&acc)[2][2][4][2], const Unit& u, int wr, int wc, int fr_, int fq_) const {
        int ln_; asm volatile("v_mbcnt_lo_u32_b32 %0, -1, 0\n\tv_mbcnt_hi_u32_b32 %0, -1, %0" : "=v"(ln_)); const int fr = ln_ & 15, fq = ln_ >> 4;
        const int rbase = u.pm * 256 + wr * 64 + fr, col0 = u.pn * 256 + wc * 32 + 4 * fq;
#pragma unroll
        for (int ai = 0; ai < 2; ++ai)
#pragma unroll
            for (int m = 0; m < 4; ++m) {
                const int row = rbase + ai * 128 + m * 16;
                float* yr = nullptr;
                if (row < MPROMPT) { const int b = row / LP, t = row - b * LP; if (t >= 16) yr = out + O_YP + ((size_t)b * 2048 + (t - 16)) * DM + col0; }
                else if (row < MREAL) yr = out + O_YS + (size_t)(row - MPROMPT) * DM + col0;
                const bf16_t* xr = X2B + (size_t)row * DM + col0;
                float ss = 0.f;
#pragma unroll
                for (int bj = 0; bj < 2; ++bj)
#pragma unroll
                    for (int n = 0; n < 2; ++n) {
                        const u32x2 xb = *(const u32x2*)(xr + bj * 128 + n * 16);
                        const f32x4 v = acc[ai][bj][m][n] + (f32x4){bflo(xb.x), bfhi(xb.x), bflo(xb.y), bfhi(xb.y)};
                        ss += (v[0] * v[0] + v[1] * v[1]) + (v[2] * v[2] + v[3] * v[3]);
                        if (yr) *(f32x4*)(yr + bj * 128 + n * 16) = v;
                    }
                ss += __shfl_xor(ss, 16); ss += __shfl_xor(ss, 32);
                if (fq == 0) rsq[(size_t)row * 16 + u.pn * 4 + wc] = ss;
            }
    }
};

struct EpiUp {
    static constexpr bool PERM = true;
    const float* rsq2; const float* cw; const float* stf; bf16_t* act; float* out;
    __device__ __forceinline__ void operator()(const f32x4 (&acc)[2][2][4][2], const Unit& u, int wr, int wc, int fr_, int fq_) const {
        int ln_; asm volatile("v_mbcnt_lo_u32_b32 %0, -1, 0\n\tv_mbcnt_hi_u32_b32 %0, -1, %0" : "=v"(ln_)); const int fr = ln_ & 15, fq = ln_ >> 4;
        const int colg = u.pn * 128 + wc * 32 + fq * 8;
#pragma unroll
        for (int ai = 0; ai < 2; ++ai) {
            const int g0 = u.pm * UP_TROWS + (2 * ai + wr) * 62 - 2 + 4 * fr;
            float rs[4];
#pragma unroll
            for (int m = 0; m < 4; ++m) {
                int g = g0 + m; g = g < 0 ? 0 : g;
                const f32x4* p = (const f32x4*)(rsq2 + (size_t)g * 16);
                const f32x4 s0 = p[0], s1 = p[1], s2 = p[2], s3 = p[3];
                const float s = ((s0[0] + s0[1]) + (s0[2] + s0[3])) + ((s1[0] + s1[1]) + (s1[2] + s1[3])) + ((s2[0] + s2[1]) + (s2[2] + s2[3])) + ((s3[0] + s3[1]) + (s3[2] + s3[3]));
                rs[m] = rsqrtf(s * (1.0f / DM) + EPS);
                asm volatile("" : "+v"(rs[m]));
                __builtin_amdgcn_sched_barrier(0);
            }
#pragma unroll
            for (int n = 0; n < 2; ++n) {
                const int col = colg + 4 * n;
                f32x4 w[2][3];
#pragma unroll
                for (int bj = 0; bj < 2; ++bj)
#pragma unroll
                    for (int k = 0; k < 3; ++k) w[bj][k] = *(const f32x4*)(cw + (size_t)k * NUP + bj * DFF + col);
#pragma unroll
                for (int m = 0; m < 4; ++m) {
                    const int g = g0 + m;
                    const bool vout = (4 * fr + m >= 2) && (g < MREAL);
                    const RowInfo ri = rowinfo(g < 0 ? 0 : g);
                    float y[2][4];
#pragma unroll
                    for (int bj = 0; bj < 2; ++bj) {
                        float cur[4], p1[4], p2[4];
#pragma unroll
                        for (int i = 0; i < 4; ++i) {
                            cur[i] = acc[ai][bj][m][n][i] * rs[m];
                            p1[i] = m >= 1 ? acc[ai][bj][m >= 1 ? m - 1 : 0][n][i] * rs[m >= 1 ? m - 1 : 0] : dpp_shr1(acc[ai][bj][3][n][i] * rs[3]);
                            p2[i] = m >= 2 ? acc[ai][bj][m >= 2 ? m - 2 : 0][n][i] * rs[m >= 2 ? m - 2 : 0] : dpp_shr1(acc[ai][bj][m == 0 ? 2 : 3][n][i] * rs[m == 0 ? 2 : 3]);
                        }
                        if (ri.t < 2) {
                            f32x4 S0 = {0.f, 0.f, 0.f, 0.f}, S1 = {0.f, 0.f, 0.f, 0.f};
                            if (ri.samp && ri.idx < NSB) { S0 = *(const f32x4*)(stf + (size_t)(ri.idx * 2 + 0) * NUP + bj * DFF + col); S1 = *(const f32x4*)(stf + (size_t)(ri.idx * 2 + 1) * NUP + bj * DFF + col); }
#pragma unroll
                            for (int i = 0; i < 4; ++i) { if (ri.t == 0) { p1[i] = S1[i]; p2[i] = S0[i]; } else { p2[i] = S1[i]; } }
                        }
                        if (vout && ri.t >= ri.len - 2) {
                            float* d = out + (ri.samp ? O_SCF : O_PCF) + (size_t)(ri.idx * 2 + (ri.t - (ri.len - 2))) * NUP + bj * DFF + col;
                            *(f32x4*)(d) = (f32x4){cur[0], cur[1], cur[2], cur[3]};
                        }
#pragma unroll
                        for (int i = 0; i < 4; ++i) y[bj][i] = w[bj][0][i] * p2[i] + w[bj][1][i] * p1[i] + w[bj][2][i] * cur[i];
                    }
                    if (vout) {
                        u32x2 pk; pk.x = cvt_pk_bf16(silu_f(y[0][0]) * y[1][0], silu_f(y[0][1]) * y[1][1]); pk.y = cvt_pk_bf16(silu_f(y[0][2]) * y[1][2], silu_f(y[0][3]) * y[1][3]);
                        *(u32x2*)(act + (size_t)g * DFF + col) = pk;
                    }
                    __builtin_amdgcn_sched_barrier(0);
                }
            }
        }
    }
};

#define XB_TMO      128
#define XB_XCNT(j)  (256  + 64 * (j))
#define XB_XSUB(j)  (1280 + 64 * (j))
#define XB_XGEN(j)  (2304 + 64 * (j))
#define XB_TOP      3328
#define XB_TOPGEN   3392
#define XCD_BAR_WORDS 3456
#define XB_SPIN_CAP (1u << 20)
__device__ __forceinline__ unsigned xb_ld(unsigned* p)              { return __hip_atomic_load(p, __ATOMIC_RELAXED, __HIP_MEMORY_SCOPE_AGENT); }
__device__ __forceinline__ unsigned xb_add(unsigned* p, unsigned v) { return __hip_atomic_fetch_add(p, v, __ATOMIC_RELAXED, __HIP_MEMORY_SCOPE_AGENT); }
__device__ __forceinline__ unsigned xb_xcc_id() { return (unsigned)__builtin_amdgcn_s_getreg((3 << 11) | 20) & 0xFu; }
#define XB_SPIN(cond, bar) do { unsigned _sp = 0; while (cond) { __builtin_amdgcn_s_sleep(1); \
    if ((++_sp & 255u) == 0u) { if (xb_ld(&(bar)[XB_TMO])) break; if (_sp > XB_SPIN_CAP) { atomicAdd(&(bar)[XB_TMO], 1u); break; } } } } while (0)
struct XcdBarrier { unsigned* bar; unsigned x; volatile LAS unsigned* st; };
__device__ __forceinline__ XcdBarrier xcd_barrier_post(unsigned* bar, volatile LAS unsigned* st) {
    XcdBarrier b; b.bar = bar; b.x = xb_xcc_id(); b.st = st;
    if (threadIdx.x == 0) (void)xb_add(&bar[XB_XCNT(b.x)], 1u);
    return b;
}
__device__ __forceinline__ void xcd_barrier_complete(unsigned* bar, unsigned x, unsigned& nloc, unsigned& nx) {
    const unsigned G = gridDim.x * gridDim.y * gridDim.z;
    unsigned sum, cnt, mine, sp = 0u;
    for (;;) {
        sum = 0u; cnt = 0u; mine = 0u;
#pragma unroll
        for (unsigned j = 0; j < 16; ++j) { const unsigned c = xb_ld(&bar[XB_XCNT(j)]); sum += c; cnt += (c > 0u) ? 1u : 0u; mine = (j == x) ? c : mine; }
        if (sum == G) break;
        __builtin_amdgcn_s_sleep(1);
        if ((++sp & 255u) == 0u) { if (xb_ld(&bar[XB_TMO])) break; if (sp > XB_SPIN_CAP) { atomicAdd(&bar[XB_TMO], 1u); break; } }
    }
    nloc = mine > 0u ? mine : 1u; nx = cnt > 0u ? cnt : 1u;
}
__device__ __forceinline__ void xcd_barrier(const XcdBarrier& b) {
    asm volatile("s_waitcnt vmcnt(0)" ::: "memory");
    __syncthreads();
    if (threadIdx.x == 0) {
        unsigned* bar = b.bar;
        __builtin_amdgcn_s_waitcnt(0);
        unsigned nloc = b.st[0], nx = b.st[1];
        if (nloc == 0u) { xcd_barrier_complete(bar, b.x, nloc, nx); b.st[0] = nloc; b.st[1] = nx; }
        const unsigned old = xb_add(&bar[XB_XSUB(b.x)], 1u);
        const unsigned gen = old / nloc;
        if (old + 1u == (gen + 1u) * nloc) {
            __builtin_amdgcn_fence(__ATOMIC_RELEASE, "agent");
            asm volatile("s_waitcnt vmcnt(0)" ::: "memory");
            const unsigned og = xb_add(&bar[XB_TOP], 1u);
            const unsigned tg = og / nx;
            if (og + 1u == (tg + 1u) * nx) xb_add(&bar[XB_TOPGEN], 1u);
            else XB_SPIN(xb_ld(&bar[XB_TOPGEN]) == tg, bar);
            __builtin_amdgcn_fence(__ATOMIC_ACQUIRE, "agent");
            xb_add(&bar[XB_XGEN(b.x)], 1u);
            asm volatile("s_waitcnt vmcnt(0)" ::: "memory");
        } else {
            XB_SPIN(xb_ld(&bar[XB_XGEN(b.x)]) == gen, bar);
            __builtin_amdgcn_fence(__ATOMIC_ACQUIRE, "agent");
            asm volatile("s_waitcnt vmcnt(0)" ::: "memory");
        }
    }
    __syncthreads();
}

struct Frame {
    LAS unsigned char* lds;
    int tid, lane, wave, G, blk;
    const float* in[20];
    float* out; unsigned char* ws;
};

__device__ __forceinline__ void p0_transpose_item(const float* W, int ldw, int K, bf16_t* WT, int n0, int srcn0, int k0, const float* kscale, LAS float* scr, int lane) {
    float tv[32];
#pragma unroll
    for (int i = 0; i < 32; ++i) tv[i] = W[(size_t)(k0 + 2 * i + (lane >> 5)) * ldw + srcn0 + (lane & 31)];
#pragma unroll
    for (int i = 0; i < 32; ++i) { const int kk = 2 * i + (lane >> 5); float v = tv[i]; if (kscale) v *= kscale[k0 + kk]; scr[kk * 33 + (lane & 31)] = v; }
    LDS_WAIT(); asm volatile("" ::: "memory");
    const int c = lane & 7;
#pragma unroll
    for (int j = 0; j < 4; ++j) { const int n = (lane >> 3) + 8 * j; const LAS float* s = scr + (8 * c) * 33 + n;
        u32x4 o; o.x = cvt_pk_bf16(s[0 * 33], s[1 * 33]); o.y = cvt_pk_bf16(s[2 * 33], s[3 * 33]); o.z = cvt_pk_bf16(s[4 * 33], s[5 * 33]); o.w = cvt_pk_bf16(s[6 * 33], s[7 * 33]);
        *(u32x4*)(WT + (size_t)(n0 + n) * K + k0 + 8 * c) = o; }
    LDS_WAIT(); asm volatile("" ::: "memory");
}
__device__ __forceinline__ int in_colmap(int n0) {
    const int pn = n0 >> 8;
    if (pn >= 4) return n0;
    const int c = n0 & 255, bj = c >> 7, cc = c & 127, hl = cc >> 6, j = cc & 63;
    return (pn >= 2 ? 512 : 0) + ((pn & 1) * 2 + hl) * 128 + bj * 64 + j;
}
__device__ __forceinline__ void p0_prologue(Frame& F) {
    const float* w_in = F.in[8]; const float* w_out = F.in[14]; const float* w_up = F.in[16]; const float* w_dn = F.in[18];
    bf16_t* WIN = (bf16_t*)(F.ws + WS_WIN); bf16_t* WOUT = (bf16_t*)(F.ws + WS_WOUT); bf16_t* WUP = (bf16_t*)(F.ws + WS_WUP); bf16_t* WDN = (bf16_t*)(F.ws + WS_WDN);
    LAS float* scr = (LAS float*)(F.lds + F.wave * 8448);
    LAS float* WX = (LAS float*)(F.lds + 69632);
    for (int i = F.tid; i < 1024 * 8; i += 512) WX[i] = w_in[(size_t)(i >> 3) * INW + NIN + (i & 7)];
    const int gw = F.blk * 8 + F.wave, NGW = F.G * 8;
    constexpr int I_IN = 16 * 128, I_OUT = 16 * 32, I_UP = 16 * 176, I_DN = 44 * 32, NIT = I_IN + I_OUT + I_UP + I_DN;
    for (int it = gw; it < NIT; it += NGW) {
        int r = it;
        if (r < I_IN) { const int kb = r / 128, nb = r % 128; p0_transpose_item(w_in, INW, 1024, WIN, nb * 32, in_colmap(nb * 32), kb * 64, nullptr, scr, F.lane); continue; } r -= I_IN;
        if (r < I_OUT) { const int kb = r / 32, nb = r % 32; p0_transpose_item(w_out, 1024, 1024, WOUT, nb * 32, nb * 32, kb * 64, nullptr, scr, F.lane); continue; } r -= I_OUT;
        if (r < I_UP) { const int kb = r / 176, nb = r % 176; const int n0 = nb * 32, pn = n0 >> 8, c = n0 & 255; p0_transpose_item(w_up, NUP, 1024, WUP, n0, (c >> 7) * DFF + pn * 128 + (c & 127), kb * 64, F.in[15], scr, F.lane); continue; } r -= I_UP;
        { const int kb = r / 32, nb = r % 32; p0_transpose_item(w_dn, 1024, DFF, WDN, nb * 32, nb * 32, kb * 64, nullptr, scr, F.lane); }
    }
    __syncthreads();
    bf16_t* H = (bf16_t*)(F.ws + WS_H); float* BG = (float*)(F.ws + WS_BG);
    const float* nm = F.in[7];
    f32x4 nmv[4], vn[4];
#pragma unroll
    for (int j = 0; j < 4; ++j) { nmv[j] = ((const f32x4*)nm)[F.lane + 64 * j]; vn[j] = (f32x4){0.f, 0.f, 0.f, 0.f}; }
    if (gw < MREAL) {
        const f32x4* xr0 = (const f32x4*)x_src_row(F.in[0], F.in[1], F.in[6], gw) + F.lane;
#pragma unroll
        for (int j = 0; j < 4; ++j) vn[j] = xr0[64 * j];
    }
    for (int g = gw; g < MPAD; g += NGW) {
        unsigned long long* o8 = (unsigned long long*)(H + (size_t)g * DM) + F.lane;
        f32x4 v[4];
#pragma unroll
        for (int j = 0; j < 4; ++j) v[j] = vn[j];
        if (g + NGW < MREAL) {
            const f32x4* xr1 = (const f32x4*)x_src_row(F.in[0], F.in[1], F.in[6], g + NGW) + F.lane;
#pragma unroll
            for (int j = 0; j < 4; ++j) vn[j] = xr1[64 * j];
        }
        if (g >= MREAL) {
#pragma unroll
            for (int j = 0; j < 4; ++j) o8[64 * j] = 0ull;
            continue;
        }
        float ss = 0.f;
#pragma unroll
        for (int j = 0; j < 4; ++j) ss += (v[j][0] * v[j][0] + v[j][1] * v[j][1]) + (v[j][2] * v[j][2] + v[j][3] * v[j][3]);
        const float rstd = rsqrtf(wave_sum(ss) * (1.0f / DM) + EPS);
        float ex[8];
#pragma unroll
        for (int e = 0; e < 8; ++e) ex[e] = 0.f;
#pragma unroll
        for (int j = 0; j < 4; ++j) {
            v[j] = v[j] * rstd * nmv[j];
            o8[64 * j] = (unsigned long long)cvt_pk_bf16(v[j][0], v[j][1]) | ((unsigned long long)cvt_pk_bf16(v[j][2], v[j][3]) << 32);
#pragma unroll
            for (int i = 0; i < 4; ++i) {
                const int k = 4 * (F.lane + 64 * j) + i;
                const f32x4 wa = *(const LAS f32x4*)(WX + k * 8), wb = *(const LAS f32x4*)(WX + k * 8 + 4);
                ex[0] += v[j][i] * wa[0]; ex[1] += v[j][i] * wa[1]; ex[2] += v[j][i] * wa[2]; ex[3] += v[j][i] * wa[3];
                ex[4] += v[j][i] * wb[0]; ex[5] += v[j][i] * wb[1]; ex[6] += v[j][i] * wb[2]; ex[7] += v[j][i] * wb[3];
            }
        }
#pragma unroll
        for (int e = 0; e < 8; ++e) ex[e] = wave_sum(ex[e]);
        if (F.lane < 4) {
            const int h = F.lane;
            const float gb = h == 0 ? ex[0] : h == 1 ? ex[1] : h == 2 ? ex[2] : ex[3];
            const float ga = h == 0 ? ex[4] : h == 1 ? ex[5] : h == 2 ? ex[6] : ex[7];
            const float beta = 1.0f / (1.0f + __expf(-gb));
            const float xx = ga + F.in[11][h];
            const float sp = xx > 20.f ? xx : log1pf(__expf(xx));
            BG[(size_t)g * 8 + h] = beta;
            BG[(size_t)g * 8 + 4 + h] = -__expf(F.in[10][h]) * sp;
        }
    }
    {
        bf16_t* PGX = (bf16_t*)(F.ws + WS_PGX); const float* stq = F.in[4];
        for (int e = F.blk * 512 + F.tid; e < 385 * GQKV; e += F.G * 512) PGX[e] = e < 384 * GQKV ? (bf16_t)(cvt_pk_bf16(stq[e], 0.f) & 0xffffu) : (bf16_t)0;
    }
    float* ROT = (float*)(F.ws + WS_ROT);
    for (int e = F.blk * 512 + F.tid; e < 2068 * 64; e += F.G * 512) {
        const int p = e >> 6, j = e & 63; const int pos = p < LP ? p : 16384 + (p - LP);
        double f = 1.0, b = 0.8659643233600653523531691834202299819398;
#pragma unroll
        for (int k = 0; k < 6; ++k) { if ((j >> k) & 1) f *= b; b *= b; }
        double rev = (double)pos * f * 0.15915494309189533576888376337251436203445964574046;
        rev -= floor(rev);
        const float rf = (float)rev;
        ROT[(size_t)e * 2] = __builtin_amdgcn_cosf(rf); ROT[(size_t)e * 2 + 1] = __builtin_amdgcn_sinf(rf);
    }
}

struct SeqD { int row0, len, samp, idx; };
__device__ __forceinline__ bf16x8 mk8(s16x4 lo, s16x4 hi) { return (bf16x8){lo[0], lo[1], lo[2], lo[3], hi[0], hi[1], hi[2], hi[3]}; }
__device__ __forceinline__ s16x4 ld_tr(LAS unsigned char* p) { return __builtin_bit_cast(s16x4, __builtin_amdgcn_ds_read_tr16_b64_v4i16((LAS s16x4*)p)); }
__device__ __forceinline__ s16x4 ld_b64(LAS unsigned char* p) { return *(LAS s16x4*)p; }
__device__ __forceinline__ s16x4 pk4(f32x4 v) { u32x2 w; w.x = cvt_pk_bf16(v[0], v[1]); w.y = cvt_pk_bf16(v[2], v[3]); return __builtin_bit_cast(s16x4, w); }

__device__ __forceinline__ void st_wt16(const void* base, unsigned off, u32x4 v) { asm volatile("s_nop 4\n\tglobal_store_dwordx4 %0, %1, %2 sc1\n\ts_nop 1" :: "v"(off), "v"(v), "s"(base) : "memory"); }
__device__ __forceinline__ void st_wt4(const void* base, unsigned off, unsigned v) { asm volatile("s_nop 4\n\tglobal_store_dword %0, %1, %2 sc1" :: "v"(off), "v"(v), "s"(base) : "memory"); }
__device__ __forceinline__ void st_wt2(const void* base, unsigned off, unsigned v) { asm volatile("s_nop 4\n\tglobal_store_short %0, %1, %2 sc1" :: "v"(off), "v"(v), "s"(base) : "memory"); }
__device__ __forceinline__ void chunk_publish(unsigned* flag) {
    asm volatile("s_waitcnt vmcnt(0)" ::: "memory");
    __syncthreads();
    if (threadIdx.x == 0) __hip_atomic_store(flag, 1u, __ATOMIC_RELAXED, __HIP_MEMORY_SCOPE_AGENT);
}
__device__ __forceinline__ void chunk_wait(const unsigned* flag) {
    unsigned sp = 0;
    while (__builtin_amdgcn_readfirstlane(__hip_atomic_load(flag, __ATOMIC_RELAXED, __HIP_MEMORY_SCOPE_AGENT)) == 0u) { __builtin_amdgcn_s_sleep(2); if (++sp > (1u << 22)) break; }
    __builtin_amdgcn_fence(__ATOMIC_ACQUIRE, "agent");
    asm volatile("s_waitcnt vmcnt(0)" ::: "memory");
}
__device__ __forceinline__ int qk_pos(int i, int j) { const int p = (j & ~12) | ((j & 4) << 1) | ((j & 8) >> 1); return (((p >> 3) ^ ((i >> 1) & 7)) << 3) | (p & 7); }
__device__ __forceinline__ void p2a_item(Frame& F, const SeqD sq, int h, int t0, int c, unsigned char* slot) {
    unsigned lbase = (unsigned)(uintptr_t)F.lds; int tid = F.tid;
    asm volatile("" : "+s"(lbase), "+v"(tid));
    const unsigned ta0 = MK_TPROBE ? (unsigned)__builtin_amdgcn_s_memrealtime() : 0u;
    LAS unsigned char* L = (LAS unsigned char*)(uintptr_t)lbase;
    LAS float* AM = (LAS float*)(L); LAS float* RHS = (LAS float*)(L + 53248);
    LAS float* GL = (LAS float*)(L + 16384); LAS float* CUM = GL + 64; LAS float* BETA = GL + 128;
    LAS unsigned char* QB = L + 20480; LAS unsigned char* KB = L + 36864;
    const float* BG = (const float*)(F.ws + WS_BG);
    const float* cgw = F.in[9];
    const unsigned char* slotu = (const unsigned char*)(((unsigned long long)(unsigned)__builtin_amdgcn_readfirstlane((unsigned)((unsigned long long)slot >> 32)) << 32) | (unsigned long long)(unsigned)__builtin_amdgcn_readfirstlane((unsigned)(unsigned long long)slot));
    const int r = tid >> 3, cg = tid & 7, lane = tid & 63, w = __builtin_amdgcn_readfirstlane(tid >> 6), fr = lane & 15, fg = lane >> 4;
    const bool valid = r < c;
    const int grow = sq.row0 + t0 + r;
    float beta_r = 0.f, gdec = 0.f;
    if (valid) { beta_r = BG[(size_t)grow * 8 + h]; gdec = BG[(size_t)grow * 8 + 4 + h]; }
    if (cg == 0) GL[r] = gdec;
    LAS float* CW = (LAS float*)(L + 118784);
#pragma unroll
    for (int k = 0; k < 3; ++k) { const int e = tid + 512 * k, dt = e / 384, rem = e - dt * 384; CW[e] = cgw[(size_t)dt * GQKV + (rem >> 7) * 512 + h * 128 + (rem & 127)]; }
#define P2A_LOAD(dst, XX) do { _Pragma("unroll") for (int dt = 0; dt < 4; ++dt) { \
        const int colb_ = (XX) * 512 + h * 128 + 16 * cg, tt = t0 + r - 3 + dt; \
        const unsigned oz = (unsigned)(WS_PGX + ((size_t)384 * GQKV + colb_) * 2); \
        const unsigned opg = (unsigned)(WS_PG + ((size_t)(sq.row0 + (tt >= 0 ? tt : 0)) * 2048 + colb_) * 2); \
        const unsigned opx = (unsigned)(WS_PGX + ((size_t)(sq.idx * 3 + (tt < 0 ? 3 + tt : 0)) * GQKV + colb_) * 2); \
        const unsigned so = valid ? (tt >= 0 ? opg : (sq.samp ? opx : oz)) : oz; \
        const u32x4* sp = (const u32x4*)(F.ws + so); dst[2 * dt] = sp[0]; dst[2 * dt + 1] = sp[1]; } } while (0)
    u32x4 dcur[8], dnxt[8];
    P2A_LOAD(dcur, 0);
    __syncthreads();
    const unsigned ta1 = MK_TPROBE ? (unsigned)__builtin_amdgcn_s_memrealtime() : 0u;
    float cum = 0.f, cl = 0.f;
#pragma unroll 8
    for (int j = 0; j < 64; ++j) { const float gj = GL[j]; cl += gj; if (j <= r) cum += gj; }
    const float er = __expf(cum), frr = __expf(cl - cum);
    if (cg == 0) { CUM[r] = cum; BETA[r] = beta_r; }
    if (tid == 0) st_wt4(slotu, 73728u, __float_as_uint(__expf(cl)));
#pragma unroll 1
    for (int X = 0; X < 3; ++X) {
        if (X < 2) P2A_LOAD(dnxt, X + 1);
        float y[16];
#pragma unroll
        for (int i = 0; i < 16; ++i) y[i] = 0.f;
#pragma unroll
        for (int dt = 0; dt < 4; ++dt) {
            const u32x4 a = dcur[2 * dt], b = dcur[2 * dt + 1];
            const float xv[16] = {bflo(a.x), bfhi(a.x), bflo(a.y), bfhi(a.y), bflo(a.z), bfhi(a.z), bflo(a.w), bfhi(a.w), bflo(b.x), bfhi(b.x), bflo(b.y), bfhi(b.y), bflo(b.z), bfhi(b.z), bflo(b.w), bfhi(b.w)};
            const LAS f32x4* wp = (const LAS f32x4*)(CW + dt * 384 + X * 128 + 16 * cg);
#pragma unroll
            for (int k = 0; k < 4; ++k) { const f32x4 wv = wp[k]; y[4 * k] += wv[0] * xv[4 * k]; y[4 * k + 1] += wv[1] * xv[4 * k + 1]; y[4 * k + 2] += wv[2] * xv[4 * k + 2]; y[4 * k + 3] += wv[3] * xv[4 * k + 3]; }
        }
#pragma unroll
        for (int k = 0; k < 8; ++k) dcur[k] = dnxt[k];
        float ss = 0.f;
#pragma unroll
        for (int i = 0; i < 16; ++i) { y[i] = valid ? silu_f(y[i]) : 0.f; ss += y[i] * y[i]; }
        ss += __shfl_xor(ss, 1); ss += __shfl_xor(ss, 2); ss += __shfl_xor(ss, 4);
        const float nrm = X == 0 ? rsqrtf(ss + EPS) * 0.08838834764831845f : (X == 1 ? rsqrtf(ss + EPS) : 1.0f);
        u32x4 p0, p1;
        p0.x = cvt_pk_bf16(y[0] * nrm, y[1] * nrm); p0.y = cvt_pk_bf16(y[2] * nrm, y[3] * nrm); p0.z = cvt_pk_bf16(y[4] * nrm, y[5] * nrm); p0.w = cvt_pk_bf16(y[6] * nrm, y[7] * nrm);
        p1.x = cvt_pk_bf16(y[8] * nrm, y[9] * nrm); p1.y = cvt_pk_bf16(y[10] * nrm, y[11] * nrm); p1.z = cvt_pk_bf16(y[12] * nrm, y[13] * nrm); p1.w = cvt_pk_bf16(y[14] * nrm, y[15] * nrm);
        const float z[16] = {bflo(p0.x), bfhi(p0.x), bflo(p0.y), bfhi(p0.y), bflo(p0.z), bfhi(p0.z), bflo(p0.w), bfhi(p0.w), bflo(p1.x), bfhi(p1.x), bflo(p1.y), bfhi(p1.y), bflo(p1.z), bfhi(p1.z), bflo(p1.w), bfhi(p1.w)};
        if (X < 2) {
            LAS unsigned char* dstl = (X == 0 ? QB : KB) + r * 256;
            *(LAS u32x4*)(dstl + (((2 * cg) ^ (r & 15)) * 16)) = p0; *(LAS u32x4*)(dstl + (((2 * cg + 1) ^ (r & 15)) * 16)) = p1;
            const float sc = X == 0 ? er : frr;
            u32x4 d0, d1;
            d0.x = cvt_pk_bf16(z[0] * sc, z[1] * sc); d0.y = cvt_pk_bf16(z[2] * sc, z[3] * sc); d0.z = cvt_pk_bf16(z[4] * sc, z[5] * sc); d0.w = cvt_pk_bf16(z[6] * sc, z[7] * sc);
            d1.x = cvt_pk_bf16(z[8] * sc, z[9] * sc); d1.y = cvt_pk_bf16(z[10] * sc, z[11] * sc); d1.z = cvt_pk_bf16(z[12] * sc, z[13] * sc); d1.w = cvt_pk_bf16(z[14] * sc, z[15] * sc);
            if (X == 0) { const u32x4 e0 = {d0.x, d0.y, d1.x, d1.y}, e1 = {d0.z, d0.w, d1.z, d1.w};
                st_wt16(slotu, 16384 + r * 256 + (((2 * cg) ^ (r & 15)) * 16), e0); st_wt16(slotu, 16384 + r * 256 + (((2 * cg + 1) ^ (r & 15)) * 16), e1); }
            else { const unsigned gd = 32768 + r * 256 + (((cg >> 1) ^ (r & 3)) * 64) + (cg & 1) * 32; st_wt16(slotu, gd, d0); st_wt16(slotu, gd + 16, d1); }
        }
        if (X >= 1) {
            const float sc = X == 1 ? beta_r * er : beta_r;
            LAS float* rd = RHS + r * 256 + (X == 1 ? 128 : 0) + 16 * cg;
#pragma unroll
            for (int k = 0; k < 4; ++k) *(LAS f32x4*)(rd + 4 * k) = (f32x4){z[4 * k] * sc, z[4 * k + 1] * sc, z[4 * k + 2] * sc, z[4 * k + 3] * sc};
        }
        __builtin_amdgcn_sched_barrier(0);
    }
    __syncthreads();
    const unsigned ta2 = MK_TPROBE ? (unsigned)__builtin_amdgcn_s_memrealtime() : 0u;
    {
#pragma unroll
        for (int rep = 0; rep < 2; ++rep) {
            const int idx = w + 8 * rep, it = idx >> 2, jt = idx & 3;
            const int jcol = 16 * jt + fr;
            if (it >= jt) {
                f32x4 akk = {0.f, 0.f, 0.f, 0.f}, aqk = {0.f, 0.f, 0.f, 0.f};
#pragma unroll
                for (int s = 0; s < 4; ++s) {
                    const int ri = 16 * it + fr, rj = 16 * jt + fr;
                    const bf16x8 bk = *(LAS bf16x8*)(KB + rj * 256 + (((4 * s + fg) ^ (rj & 15)) * 16));
                    const bf16x8 ak = *(LAS bf16x8*)(KB + ri * 256 + (((4 * s + fg) ^ (ri & 15)) * 16));
                    const bf16x8 aq = *(LAS bf16x8*)(QB + ri * 256 + (((4 * s + fg) ^ (ri & 15)) * 16));
                    akk = __builtin_amdgcn_mfma_f32_16x16x32_bf16(ak, bk, akk, 0, 0, 0);
                    aqk = __builtin_amdgcn_mfma_f32_16x16x32_bf16(aq, bk, aqk, 0, 0, 0);
                }
                const float cj = CUM[jcol];
#pragma unroll
                for (int rr = 0; rr < 4; ++rr) {
                    const int i_ = 16 * it + 4 * fg + rr;
                    const float dec = i_ >= jcol ? __expf(CUM[i_] - cj) : 0.f;
                    AM[i_ * 64 + jcol] = i_ > jcol ? BETA[i_] * akk[rr] * dec : 0.f;
                    st_wt2(slotu, 49152u + (unsigned)(i_ * 64 + qk_pos(i_, jcol)) * 2u, cvt_pk_bf16(aqk[rr] * dec, 0.f));
                }
            } else {
#pragma unroll
                for (int rr = 0; rr < 4; ++rr) { const int i_ = 16 * it + 4 * fg + rr; st_wt2(slotu, 49152u + (unsigned)(i_ * 64 + qk_pos(i_, jcol)) * 2u, 0u); }
            }
        }
    }
    __syncthreads();
    const unsigned ta3 = MK_TPROBE ? (unsigned)__builtin_amdgcn_s_memrealtime() : 0u;
    {
        const int col = tid >> 1, hh = tid & 1;
        LAS float* xc = RHS + col;
        const LAS float* ab = AM + 4 * hh;
#pragma unroll 1
        for (int ib = 0; ib < 16; ++ib) {
            float acc[4] = {0.f, 0.f, 0.f, 0.f};
            const int nq = (ib + 1) >> 1;
#pragma unroll 2
            for (int q = 0; q < nq; ++q) {
                const float x0 = xc[(8 * q + 4 * hh) * 256], x1 = xc[(8 * q + 4 * hh + 1) * 256], x2 = xc[(8 * q + 4 * hh + 2) * 256], x3 = xc[(8 * q + 4 * hh + 3) * 256];
                const bool mine = (hh == 0) || (2 * q + 1 < ib);
#pragma unroll
                for (int rr = 0; rr < 4; ++rr) { const f32x4 av = *(const LAS f32x4*)(ab + (4 * ib + rr) * 64 + 8 * q);
                    const float t_ = av[0] * x0 + av[1] * x1 + av[2] * x2 + av[3] * x3; acc[rr] += mine ? t_ : 0.f; }
            }
#pragma unroll
            for (int rr = 0; rr < 4; ++rr) acc[rr] += __int_as_float(__builtin_amdgcn_update_dpp(0, __float_as_int(acc[rr]), 0xB1, 0xf, 0xf, true));
            const f32x4 d1 = *(const LAS f32x4*)(AM + (4 * ib + 1) * 64 + 4 * ib), d2 = *(const LAS f32x4*)(AM + (4 * ib + 2) * 64 + 4 * ib), d3 = *(const LAS f32x4*)(AM + (4 * ib + 3) * 64 + 4 * ib);
            float vv[4];
            vv[0] = xc[(4 * ib) * 256] - acc[0];
            vv[1] = xc[(4 * ib + 1) * 256] - acc[1] - d1[0] * vv[0];
            vv[2] = xc[(4 * ib + 2) * 256] - acc[2] - d2[0] * vv[0] - d2[1] * vv[1];
            vv[3] = xc[(4 * ib + 3) * 256] - acc[3] - d3[0] * vv[0] - d3[1] * vv[1] - d3[2] * vv[2];
            if (hh == 0) {
#pragma unroll
                for (int rr = 0; rr < 4; ++rr) xc[(4 * ib + rr) * 256] = vv[rr];
            }
        }
        const unsigned rowp = col < 128 ? 57344u + col * 128 : (unsigned)(col - 128) * 128;
        const int wsw = col < 128 ? 0 : (((col - 128) >> 1) & 1);
#pragma unroll
        for (int k = 0; k < 4; ++k) {
            float xv[8];
#pragma unroll
            for (int e = 0; e < 8; ++e) xv[e] = xc[(32 * hh + 8 * k + e) * 256];
            u32x4 o; o.x = cvt_pk_bf16(xv[0], xv[1]); o.y = cvt_pk_bf16(xv[2], xv[3]); o.z = cvt_pk_bf16(xv[4], xv[5]); o.w = cvt_pk_bf16(xv[6], xv[7]);
            st_wt16(slotu, rowp + ((hh ^ wsw) * 64) + k * 16, o);
        }
    }
    __syncthreads();
    if (MK_TPROBE) { const unsigned ta4 = (unsigned)__builtin_amdgcn_s_memrealtime(); if (tid == 0) { unsigned* TS = (unsigned*)(F.ws + WS_CTL) + CW_TS; TS[26 * 256 + F.blk] += ta1 - ta0; TS[27 * 256 + F.blk] += ta2 - ta1; TS[28 * 256 + F.blk] += ta3 - ta2; TS[34 * 256 + F.blk] += ta4 - ta3; } }
}

typedef float f32x16 __attribute__((ext_vector_type(16)));
constexpr int SC_IMG = 57344, SC_OS = 114688, SC_OSB = 17408, OST_PITCH = 136;
__device__ __forceinline__ void glds16(const void* gsrc, unsigned lds_dst) { unsigned keep; lds_dst = __builtin_amdgcn_readfirstlane(lds_dst);
    asm volatile("s_mov_b32 %0, m0\n\ts_mov_b32 m0, %2\n\ts_nop 0\n\tglobal_load_lds_dwordx4 %1, off\n\ts_mov_b32 m0, %0" : "=&s"(keep) : "v"(gsrc), "s"(lds_dst) : "memory"); }
__device__ __forceinline__ f32x16 mfma32(bf16x8 a, bf16x8 b, f32x16 c) { return __builtin_amdgcn_mfma_f32_32x32x16_bf16(a, b, c, 0, 0, 0); }
__device__ __forceinline__ bf16x8 pk8(const f32x16& v, int s) {
    u32x4 w; w.x = cvt_pk_bf16(v[8 * s], v[8 * s + 1]); w.y = cvt_pk_bf16(v[8 * s + 2], v[8 * s + 3]); w.z = cvt_pk_bf16(v[8 * s + 4], v[8 * s + 5]); w.w = cvt_pk_bf16(v[8 * s + 6], v[8 * s + 7]);
    return __builtin_bit_cast(bf16x8, w);
}
template <int MODE  >
__device__ __forceinline__ void scan_finish(LAS unsigned char* OSb, int hw, int lane, int h, int grow0, int c, const float* nw, const u32x4 (&gpre)[4], bf16_t* mix) {
    const int i16 = lane & 15, g = lane >> 4, tok = 16 * hw + i16;
    float v[32];
#pragma unroll
    for (int k = 0; k < 8; ++k) {
        const s16x4 t4 = ld_tr(OSb + (32 * g + 4 * k + (i16 >> 2)) * OST_PITCH + (16 * hw + 4 * (i16 & 3)) * 2);
        const u32x2 t2 = __builtin_bit_cast(u32x2, t4);
        v[4 * k] = bflo(t2.x); v[4 * k + 1] = bfhi(t2.x); v[4 * k + 2] = bflo(t2.y); v[4 * k + 3] = bfhi(t2.y);
    }
    float rstd;
    if (MODE == 0) {
        float s = 0.f;
#pragma unroll
        for (int k = 0; k < 32; ++k) s += v[k];
        s += __shfl_xor(s, 16); s += __shfl_xor(s, 32);
        const float mu = s * (1.0f / 128.0f);
        float q = 0.f;
#pragma unroll
        for (int k = 0; k < 32; ++k) { v[k] -= mu; q += v[k] * v[k]; }
        q += __shfl_xor(q, 16); q += __shfl_xor(q, 32);
        rstd = rsqrtf(q * (1.0f / 128.0f) + EPS);
    } else {
        float q = 0.f;
#pragma unroll
        for (int k = 0; k < 32; ++k) q += v[k] * v[k];
        q += __shfl_xor(q, 16); q += __shfl_xor(q, 32);
        rstd = rsqrtf(q * (1.0f / 128.0f) + EPS);
    }
    if (tok < c) {
        const f32x4* np = (const f32x4*)(nw + (MODE == 0 ? h * 128 : 0) + 32 * g);
        u32x4* mp = (u32x4*)(mix + (size_t)(grow0 + tok) * DM + (MODE == 0 ? 0 : 512) + h * 128 + 32 * g);
#pragma unroll
        for (int k = 0; k < 4; ++k) {
            const u32x4 gv = gpre[k]; const f32x4 n0 = np[2 * k], n1 = np[2 * k + 1];
            u32x4 o;
            o.x = cvt_pk_bf16(v[8 * k] * rstd * n0[0] * bflo(gv.x), v[8 * k + 1] * rstd * n0[1] * bfhi(gv.x));
            o.y = cvt_pk_bf16(v[8 * k + 2] * rstd * n0[2] * bflo(gv.y), v[8 * k + 3] * rstd * n0[3] * bfhi(gv.y));
            o.z = cvt_pk_bf16(v[8 * k + 4] * rstd * n1[0] * bflo(gv.z), v[8 * k + 5] * rstd * n1[1] * bfhi(gv.z));
            o.w = cvt_pk_bf16(v[8 * k + 6] * rstd * n1[2] * bflo(gv.w), v[8 * k + 7] * rstd * n1[3] * bfhi(gv.w));
            mp[k] = o;
        }
    }
}

__device__ __forceinline__ void chunk_of(const SeqD& sq, int n, int& t0, int& c) { if (sq.samp) { t0 = 0; c = 4; } else if (n == 0) { t0 = 0; c = 16; } else { t0 = 16 + 64 * (n - 1); c = 64; } }
__device__ __forceinline__ void scan_gdn(Frame& F, const SeqD sq, int h, int nchunks, const unsigned char* slot0, const float* sinit, float* sfinal, const unsigned* flags  ) {
    unsigned lbase = (unsigned)(uintptr_t)F.lds; int tid = F.tid;
    asm volatile("" : "+s"(lbase), "+v"(tid));
    LAS unsigned char* L = (LAS unsigned char*)(uintptr_t)lbase;
    const int lane = tid & 63, w8 = __builtin_amdgcn_readfirstlane(tid >> 6), w = w8 & 3;
    const bool isM = w8 < 4;
    const bf16_t* PG = (const bf16_t*)(F.ws + WS_PG);
    bf16_t* mix = (bf16_t*)((unsigned char*)F.out + OS_MIX);
    const int r = lane & 31, hh = lane >> 5, i16 = lane & 15, g16 = lane >> 4;
    f32x16 S[4]; bf16x8 Sb[4][2];
    u32x2 ur[2][4]; float cdn = 1.0f;
#define GSET(k, v) do { ur[(k) >> 1][((k) & 1) * 2] = (u32x2){(v).x, (v).y}; ur[(k) >> 1][((k) & 1) * 2 + 1] = (u32x2){(v).z, (v).w}; } while (0)
    const int uoff = 57344 + ((32 * w + r) * 64 + 4 * hh) * 2;
    if (flags) chunk_wait(flags);
    if (isM) {
#pragma unroll
        for (int t = 0; t < 4; ++t)
#pragma unroll
            for (int e = 0; e < 16; ++e) S[t][e] = sinit ? sinit[(32 * t + (e & 3) + 8 * (e >> 2) + 4 * hh) * 128 + 32 * w + r] : 0.f;
#pragma unroll
        for (int t = 0; t < 4; ++t) { Sb[t][0] = pk8(S[t], 0); Sb[t][1] = pk8(S[t], 1); }
#pragma unroll
        for (int mt = 0; mt < 2; ++mt)
#pragma unroll
            for (int q = 0; q < 4; ++q) ur[mt][q] = *(const u32x2*)(slot0 + uoff + 64 * mt + 16 * q);
        cdn = *(const float*)(slot0 + 73728);
    } else {
#pragma unroll
        for (int k = 0; k < 14; ++k) { const int pc = w + 4 * k; glds16(slot0 + pc * 1024 + lane * 16, lbase + pc * 1024); }
        { int t0, c; chunk_of(sq, 0, t0, c); const int tok = 16 * w + (lane & 15);
          if (tok < c) { const u32x4* gp = (const u32x4*)(PG + (size_t)(sq.row0 + t0 + tok) * 2048 + 1536 + h * 128 + 32 * (lane >> 4));
#pragma unroll
              for (int k = 0; k < 4; ++k) { const u32x4 gv = gp[k]; GSET(k, gv); } } }
        asm volatile("s_waitcnt vmcnt(0)" ::: "memory");
    }
    __syncthreads();
    unsigned accA = 0, accB = 0;
    for (int n = 0; n <= nchunks; ++n) {
        LAS unsigned char* Bc = L + (n & 1) * SC_IMG; LAS unsigned char* Bn = L + ((n & 1) ^ 1) * SC_IMG;
        LAS unsigned char* OSc = L + SC_OS + (n & 1) * SC_OSB; LAS unsigned char* OSp = L + SC_OS + ((n & 1) ^ 1) * SC_OSB;
        const unsigned char* img = slot0 + (size_t)n * SLOT;
        const unsigned tq0 = MK_TPROBE ? (unsigned)__builtin_amdgcn_s_memrealtime() : 0u;
        if (isM) {
            if (n < nchunks) {
                int lane_ = lane; asm volatile("" : "+v"(lane_));
                const int r_ = lane_ & 31, hh_ = lane_ >> 5, i16_ = lane_ & 15, gb_ = (lane_ >> 4) & 1;
                const float cd = cdn;
                u32x2 uc[2][4];
#pragma unroll
                for (int mt = 0; mt < 2; ++mt)
#pragma unroll
                    for (int q = 0; q < 4; ++q) uc[mt][q] = ur[mt][q];
                if (n + 1 < nchunks) {
                    if (flags) chunk_wait(flags + (size_t)(n + 1) * 2048);
#pragma unroll
                    for (int mt = 0; mt < 2; ++mt)
#pragma unroll
                        for (int q = 0; q < 4; ++q) ur[mt][q] = *(const u32x2*)(img + SLOT + uoff + 64 * mt + 16 * q);
                    cdn = *(const float*)(img + SLOT + 73728);
                }
                const int trc = 32 * gb_ + 8 * (i16_ & 3);
                bf16x8 wb[2][2];
#pragma unroll
                for (int mt = 0; mt < 2; ++mt) {
                    f32x16 a;
#pragma unroll
                    for (int e = 0; e < 16; ++e) a[e] = 0.f;
#pragma unroll
                    for (int t = 0; t < 4; ++t)
#pragma unroll
                        for (int s = 0; s < 2; ++s) {
                            const int ra = 32 * t + 16 * s + 4 * hh_ + (i16_ >> 2), rb = ra + 8;
                            const s16x4 lo = ld_tr(Bc + ra * 128 + ((mt ^ ((ra >> 1) & 1)) * 64) + trc);
                            const s16x4 hi = ld_tr(Bc + rb * 128 + ((mt ^ ((rb >> 1) & 1)) * 64) + trc);
                            a = mfma32(mk8(lo, hi), Sb[t][s], a);
                        }
                    f32x16 wv;
#pragma unroll
                    for (int q = 0; q < 4; ++q) { wv[4 * q] = bflo(uc[mt][q].x) - a[4 * q]; wv[4 * q + 1] = bfhi(uc[mt][q].x) - a[4 * q + 1]; wv[4 * q + 2] = bflo(uc[mt][q].y) - a[4 * q + 2]; wv[4 * q + 3] = bfhi(uc[mt][q].y) - a[4 * q + 3]; }
                    wb[mt][0] = pk8(wv, 0); wb[mt][1] = pk8(wv, 1);
                }
#pragma unroll
                for (int mt = 0; mt < 2; ++mt) {
                    f32x16 a;
#pragma unroll
                    for (int e = 0; e < 16; ++e) a[e] = 0.f;
                    const int row = 32 * mt + r_;
#pragma unroll
                    for (int t = 0; t < 4; ++t)
#pragma unroll
                        for (int s = 0; s < 2; ++s) {
                            const bf16x8 af = *(LAS bf16x8*)(Bc + 16384 + row * 256 + (((2 * (2 * t + s) + hh_) ^ (row & 15)) * 16));
                            a = mfma32(af, Sb[t][s], a);
                        }
#pragma unroll
                    for (int m2 = 0; m2 <= mt; ++m2)
#pragma unroll
                        for (int s = 0; s < 2; ++s) {
                            const bf16x8 af = *(LAS bf16x8*)(Bc + 49152 + row * 128 + (((2 * (2 * m2 + s) + hh_) ^ ((row >> 1) & 7)) * 16));
                            a = mfma32(af, wb[m2][s], a);
                        }
#pragma unroll
                    for (int q = 0; q < 4; ++q) { u32x2 pkd; pkd.x = cvt_pk_bf16(a[4 * q], a[4 * q + 1]); pkd.y = cvt_pk_bf16(a[4 * q + 2], a[4 * q + 3]);
                        *(LAS u32x2*)(OSc + (32 * w + r_) * OST_PITCH + (32 * mt + 8 * q + 4 * hh_) * 2) = pkd; }
                }
#pragma unroll
                for (int t = 0; t < 4; ++t) {
                    f32x16 a = S[t] * cd;
#pragma unroll
                    for (int m2 = 0; m2 < 2; ++m2)
#pragma unroll
                        for (int s = 0; s < 2; ++s) {
                            const int ra = 32 * m2 + 16 * s + 4 * hh_ + (i16_ >> 2), rb = ra + 8;
                            const s16x4 lo = ld_tr(Bc + 32768 + ra * 256 + ((t ^ (ra & 3)) * 64) + trc);
                            const s16x4 hi = ld_tr(Bc + 32768 + rb * 256 + ((t ^ (rb & 3)) * 64) + trc);
                            a = mfma32(mk8(lo, hi), wb[m2][s], a);
                        }
                    S[t] = a;
                }
#pragma unroll
                for (int t = 0; t < 4; ++t) { Sb[t][0] = pk8(S[t], 0); Sb[t][1] = pk8(S[t], 1); }
            }
        } else {
            if (n + 1 < nchunks) {
                if (flags) chunk_wait(flags + (size_t)(n + 1) * 2048);
                const unsigned bn = lbase + ((n & 1) ^ 1) * SC_IMG;
#pragma unroll
                for (int k = 0; k < 14; ++k) { const int pc = w + 4 * k; glds16(img + SLOT + pc * 1024 + lane * 16, bn + pc * 1024); }
            }
            if (n >= 1) { int t0, c; chunk_of(sq, n - 1, t0, c);
                const u32x4 gpre[4] = {{ur[0][0].x, ur[0][0].y, ur[0][1].x, ur[0][1].y}, {ur[0][2].x, ur[0][2].y, ur[0][3].x, ur[0][3].y}, {ur[1][0].x, ur[1][0].y, ur[1][1].x, ur[1][1].y}, {ur[1][2].x, ur[1][2].y, ur[1][3].x, ur[1][3].y}};
                scan_finish<1>(OSp, w, lane, h, sq.row0 + t0, c, F.in[13], gpre, mix); }
            if (n < nchunks) { int t0, c; chunk_of(sq, n, t0, c); const int tok = 16 * w + (lane & 15);
                if (tok < c) { const u32x4* gp = (const u32x4*)(PG + (size_t)(sq.row0 + t0 + tok) * 2048 + 1536 + h * 128 + 32 * (lane >> 4));
#pragma unroll
                    for (int k = 0; k < 4; ++k) { const u32x4 gv = gp[k]; GSET(k, gv); } } }
            asm volatile("s_waitcnt vmcnt(0)" ::: "memory");
        }
        const unsigned tq1 = MK_TPROBE ? (unsigned)__builtin_amdgcn_s_memrealtime() : 0u;
        __syncthreads();
        const unsigned tq2 = MK_TPROBE ? (unsigned)__builtin_amdgcn_s_memrealtime() : 0u;
        accA += tq1 - tq0; accB += tq2 - tq1;
    }
    if (MK_TPROBE && nchunks > 1 && (tid == 0 || tid == 256)) { unsigned* TS = (unsigned*)(F.ws + WS_CTL) + CW_TS; const int o_ = tid ? 2 : 0; TS[(9 + o_) * 256 + F.blk] = accA; TS[(10 + o_) * 256 + F.blk] = accB; }
    if (isM) {
#pragma unroll
        for (int t = 0; t < 4; ++t)
#pragma unroll
            for (int e = 0; e < 16; ++e) sfinal[(32 * t + (e & 3) + 8 * (e >> 2) + 4 * hh) * 128 + 32 * w + r] = S[t][e];
    }
    __syncthreads();
}

#undef GSET
__device__ __forceinline__ void ret_prepass_item(Frame& F, const SeqD sq, int h, int t0, int c, unsigned char* pimg) {
    unsigned lbase = (unsigned)(uintptr_t)F.lds; int tid = F.tid;
    asm volatile("" : "+s"(lbase), "+v"(tid));
    LAS unsigned char* L = (LAS unsigned char*)(uintptr_t)lbase;
    const int lane = tid & 63, w = __builtin_amdgcn_readfirstlane(tid >> 6), fr = lane & 15, fg = lane >> 4;
    const bf16_t* PR = (const bf16_t*)(F.ws + WS_PR);
    const float lg = h == 0 ? -0.04580368961312479f : h == 1 ? -0.02272007650008353f : h == 2 ? -0.011315313227834146f : -0.005646563141142063f;
    const unsigned tp0 = MK_TPROBE ? (unsigned)__builtin_amdgcn_s_memrealtime() : 0u;
    {
        const int r = tid >> 3, part = tid & 7;
#pragma unroll
        for (int X = 0; X < 2; ++X) {
            u32x4 a = {0u, 0u, 0u, 0u}, b = a;
            if (r < c) { const u32x4* p = (const u32x4*)(PR + (size_t)(sq.row0 + t0 + r) * 2048 + X * 512 + h * 128 + 16 * part); a = p[0]; b = p[1]; }
            *(LAS u32x4*)(L + X * 16384 + r * 256 + (((2 * part) ^ (r & 15)) * 16)) = a; *(LAS u32x4*)(L + X * 16384 + r * 256 + (((2 * part + 1) ^ (r & 15)) * 16)) = b;
        }
    }
    __syncthreads();
    const unsigned tp1 = MK_TPROBE ? (unsigned)__builtin_amdgcn_s_memrealtime() : 0u;
    LAS bf16_t* P = (LAS bf16_t*)(L + 32768);
#pragma unroll
    for (int rep = 0; rep < 2; ++rep) {
        const int idx = w + 8 * rep, it = idx >> 2, jt = idx & 3, jcol = 16 * jt + fr;
        f32x4 a = {0.f, 0.f, 0.f, 0.f};
        if (it >= jt) {
#pragma unroll
            for (int s = 0; s < 4; ++s) {
                const bf16x8 aq = *(LAS bf16x8*)(L + (16 * it + fr) * 256 + (((4 * s + fg) ^ fr) * 16));
                const bf16x8 bk = *(LAS bf16x8*)(L + 16384 + (16 * jt + fr) * 256 + (((4 * s + fg) ^ fr) * 16));
                a = __builtin_amdgcn_mfma_f32_16x16x32_bf16(aq, bk, a, 0, 0, 0);
            }
        }
#pragma unroll
        for (int rr = 0; rr < 4; ++rr) {
            const int i_ = 16 * it + 4 * fg + rr;
            const float p = (it >= jt && i_ >= jcol) ? a[rr] * exp2f(lg * (float)(i_ - jcol)) : 0.f;
            P[i_ * 64 + ((((jcol >> 3) ^ ((i_ >> 1) & 7)) << 3) | (jcol & 7))] = (bf16_t)(cvt_pk_bf16(p, 0.f) & 0xffffu);
        }
    }
    __syncthreads();
    { const unsigned char* pu = (const unsigned char*)(((unsigned long long)(unsigned)__builtin_amdgcn_readfirstlane((unsigned)((unsigned long long)pimg >> 32)) << 32) | (unsigned long long)(unsigned)__builtin_amdgcn_readfirstlane((unsigned)(unsigned long long)pimg)); st_wt16(pu, (unsigned)tid * 16u, ((LAS u32x4*)(L + 32768))[tid]); }
    const unsigned tp2 = MK_TPROBE ? (unsigned)__builtin_amdgcn_s_memrealtime() : 0u;
    __syncthreads();
    const unsigned tp3 = MK_TPROBE ? (unsigned)__builtin_amdgcn_s_memrealtime() : 0u;
    (void)tp0; (void)tp1; (void)tp2; (void)tp3;
}

__device__ __forceinline__ void scan_ret(Frame& F, const SeqD sq, int h, int nchunks, const unsigned char* pimg0, float* sfinal, const unsigned* flags) {
    unsigned lbase = (unsigned)(uintptr_t)F.lds; int tid = F.tid;
    asm volatile("" : "+s"(lbase), "+v"(tid));
    LAS unsigned char* L = (LAS unsigned char*)(uintptr_t)lbase;
    const int lane = tid & 63, w8 = __builtin_amdgcn_readfirstlane(tid >> 6), w = w8 & 3;
    const bool isM = w8 < 4;
    const bf16_t* PR = (const bf16_t*)(F.ws + WS_PR);
    const unsigned char* zrow = F.ws + WS_PGX + (size_t)384 * GQKV * 2;
    bf16_t* mix = (bf16_t*)((unsigned char*)F.out + OS_MIX);
    const float lg = h == 0 ? -0.04580368961312479f : h == 1 ? -0.02272007650008353f : h == 2 ? -0.011315313227834146f : -0.005646563141142063f;
    const int r = lane & 31, hh = lane >> 5;
    f32x16 S[4]; bf16x8 Sb[4][2];
    u32x4 gpre[4] = {{0u, 0u, 0u, 0u}, {0u, 0u, 0u, 0u}, {0u, 0u, 0u, 0u}, {0u, 0u, 0u, 0u}};
#define RET_DMA(nn, dstbase) do { int t0_, c_; chunk_of(sq, (nn), t0_, c_); \
        _Pragma("unroll") for (int k = 0; k < 14; ++k) { const int pc = w + 4 * k; const unsigned char* src_; \
            if (pc < 48) { const int X = pc >> 4, prow = (pc & 15) * 4 + (lane >> 4), p = lane & 15; \
                const int lc = X == 0 ? (p ^ (prow & 15)) : ((((p >> 2) ^ (prow & 3)) << 2) | (p & 3)); \
                src_ = prow < c_ ? (const unsigned char*)(PR + (size_t)(sq.row0 + t0_ + prow) * 2048 + X * 512 + h * 128 + lc * 8) : zrow + p * 16; } \
            else src_ = pimg0 + (size_t)(nn) * 8192 + (pc - 48) * 1024 + lane * 16; \
            glds16(src_, (dstbase) + pc * 1024); } } while (0)
    if (isM) {
#pragma unroll
        for (int t = 0; t < 4; ++t)
#pragma unroll
            for (int e = 0; e < 16; ++e) S[t][e] = 0.f;
#pragma unroll
        for (int t = 0; t < 4; ++t) { Sb[t][0] = pk8(S[t], 0); Sb[t][1] = pk8(S[t], 1); }
    } else {
        if (flags) chunk_wait(flags);
        RET_DMA(0, lbase);
        { int t0, c; chunk_of(sq, 0, t0, c); const int tok = 16 * w + (lane & 15);
          if (tok < c) { const u32x4* gp = (const u32x4*)(PR + (size_t)(sq.row0 + t0 + tok) * 2048 + 1536 + h * 128 + 32 * (lane >> 4));
#pragma unroll
              for (int k = 0; k < 4; ++k) gpre[k] = gp[k]; } }
        asm volatile("s_waitcnt vmcnt(0)" ::: "memory");
    }
    __syncthreads();
    for (int n = 0; n <= nchunks; ++n) {
        LAS unsigned char* Bc = L + (n & 1) * SC_IMG;
        LAS unsigned char* OSc = L + SC_OS + (n & 1) * SC_OSB; LAS unsigned char* OSp = L + SC_OS + ((n & 1) ^ 1) * SC_OSB;
        if (isM) {
            if (n < nchunks) {
                int lane_ = lane; asm volatile("" : "+v"(lane_));
                const int r_ = lane_ & 31, hh_ = lane_ >> 5, i16_ = lane_ & 15, gb_ = (lane_ >> 4) & 1;
                int t0, c; chunk_of(sq, n, t0, c);
                const int trc = 32 * gb_ + 8 * (i16_ & 3);
                bf16x8 vf[4];
#pragma unroll
                for (int ks = 0; ks < 4; ++ks) {
                    const int ra = 16 * ks + 8 * hh_ + (i16_ >> 2), rb = ra + 4;
                    vf[ks] = mk8(ld_tr(Bc + 32768 + ra * 256 + ((w ^ (ra & 3)) * 64) + trc), ld_tr(Bc + 32768 + rb * 256 + ((w ^ (rb & 3)) * 64) + trc));
                }
#pragma unroll
                for (int mt = 0; mt < 2; ++mt) {
                    f32x16 a1, a2;
#pragma unroll
                    for (int e = 0; e < 16; ++e) { a1[e] = 0.f; a2[e] = 0.f; }
                    const int row = 32 * mt + r_;
#pragma unroll
                    for (int ks = 0; ks < 2 * mt + 2; ++ks) {
                        const bf16x8 ap = *(LAS bf16x8*)(Bc + 49152 + row * 128 + (((2 * ks + hh_) ^ ((row >> 1) & 7)) * 16));
                        a1 = mfma32(ap, vf[ks], a1);
                    }
#pragma unroll
                    for (int t = 0; t < 4; ++t)
#pragma unroll
                        for (int s = 0; s < 2; ++s) {
                            const int c0 = 4 * t + 2 * s;
                            const s16x4 lo = ld_b64(Bc + row * 256 + ((c0 ^ (row & 15)) * 16) + 8 * hh_);
                            const s16x4 hi = ld_b64(Bc + row * 256 + (((c0 + 1) ^ (row & 15)) * 16) + 8 * hh_);
                            a2 = mfma32(mk8(lo, hi), Sb[t][s], a2);
                        }
#pragma unroll
                    for (int q = 0; q < 4; ++q) {
                        float ov[4];
#pragma unroll
                        for (int i = 0; i < 4; ++i) ov[i] = a1[4 * q + i] + exp2f(lg * (float)(32 * mt + 8 * q + 4 * hh_ + i + 1)) * a2[4 * q + i];
                        u32x2 pkd; pkd.x = cvt_pk_bf16(ov[0], ov[1]); pkd.y = cvt_pk_bf16(ov[2], ov[3]);
                        *(LAS u32x2*)(OSc + (32 * w + r_) * OST_PITCH + (32 * mt + 8 * q + 4 * hh_) * 2) = pkd;
                    }
                }
                bf16x8 vd[4];
#pragma unroll
                for (int ks = 0; ks < 4; ++ks) {
                    float f[8];
#pragma unroll
                    for (int j = 0; j < 8; ++j) { const int e = c - 1 - (16 * ks + 8 * hh_ + j); f[j] = e >= 0 ? exp2f(lg * (float)e) : 0.f; }
                    const u32x4 v4 = __builtin_bit_cast(u32x4, vf[ks]);
                    u32x4 o4;
                    o4.x = cvt_pk_bf16(bflo(v4.x) * f[0], bfhi(v4.x) * f[1]); o4.y = cvt_pk_bf16(bflo(v4.y) * f[2], bfhi(v4.y) * f[3]);
                    o4.z = cvt_pk_bf16(bflo(v4.z) * f[4], bfhi(v4.z) * f[5]); o4.w = cvt_pk_bf16(bflo(v4.w) * f[6], bfhi(v4.w) * f[7]);
                    vd[ks] = __builtin_bit_cast(bf16x8, o4);
                }
                const float gc = exp2f(lg * (float)c);
#pragma unroll
                for (int t = 0; t < 4; ++t) {
                    f32x16 a = S[t] * gc;
#pragma unroll
                    for (int ks = 0; ks < 4; ++ks) {
                        const int ra = 16 * ks + 8 * hh_ + (i16_ >> 2), rb = ra + 4;
                        const s16x4 lo = ld_tr(Bc + 16384 + ra * 256 + ((t ^ (ra & 3)) * 64) + trc);
                        const s16x4 hi = ld_tr(Bc + 16384 + rb * 256 + ((t ^ (rb & 3)) * 64) + trc);
                        a = mfma32(mk8(lo, hi), vd[ks], a);
                    }
                    S[t] = a;
                }
#pragma unroll
                for (int t = 0; t < 4; ++t) { Sb[t][0] = pk8(S[t], 0); Sb[t][1] = pk8(S[t], 1); }
            }
        } else {
            if (n + 1 < nchunks) { if (flags) chunk_wait(flags + (size_t)(n + 1) * 2048); const unsigned bn = lbase + ((n & 1) ^ 1) * SC_IMG; RET_DMA(n + 1, bn); }
            if (n >= 1) { int t0, c; chunk_of(sq, n - 1, t0, c); scan_finish<0>(OSp, w, lane, h, sq.row0 + t0, c, F.in[12], gpre, mix); }
            if (n < nchunks) { int t0, c; chunk_of(sq, n, t0, c); const int tok = 16 * w + (lane & 15);
                if (tok < c) { const u32x4* gp = (const u32x4*)(PR + (size_t)(sq.row0 + t0 + tok) * 2048 + 1536 + h * 128 + 32 * (lane >> 4));
#pragma unroll
                    for (int k = 0; k < 4; ++k) gpre[k] = gp[k]; } }
            asm volatile("s_waitcnt vmcnt(0)" ::: "memory");
        }
        __syncthreads();
    }
#undef RET_DMA
    if (isM) {
#pragma unroll
        for (int t = 0; t < 4; ++t)
#pragma unroll
            for (int e = 0; e < 16; ++e) sfinal[(32 * t + (e & 3) + 8 * (e >> 2) + 4 * hh) * 128 + 32 * w + r] = S[t][e];
    }
    __syncthreads();
}

__device__ __forceinline__ void sample_pair(Frame& F, int kind, int item0) {
    unsigned lbase = (unsigned)(uintptr_t)F.lds; int tid = F.tid;
    asm volatile("" : "+s"(lbase), "+v"(tid));
    const int half = tid >> 8, tt = tid & 255, col = tt & 127, part = tt >> 7, lane = tid & 63, wv = (tid >> 6) & 3;
    LAS float* B = (LAS float*)(uintptr_t)(lbase + half * 32768);
    LAS float* qs = B; LAS float* ks = B + 512; LAS float* vs = B + 1024; LAS float* T4 = B + 1536; LAS float* US = B + 3072; LAS float* PX = B + 3584; LAS float* SM = B + 5632;
    const int item = item0 + half, sb = item >> 2, h = item & 3;
    const int row0 = MPROMPT + sb * 4;
    const bf16_t* PR = (const bf16_t*)(F.ws + WS_PR); const bf16_t* PG = (const bf16_t*)(F.ws + WS_PG); const float* BG = (const float*)(F.ws + WS_BG);
    bf16_t* mix = (bf16_t*)((unsigned char*)F.out + OS_MIX);
    const float* sin_ = (kind ? F.in[3] : F.in[2]) + (size_t)item * 16384 + (size_t)(64 * part) * 128 + col;
    float* sout = F.out + (kind ? O_SSG : O_SSR) + (size_t)item * 16384 + (size_t)(64 * part) * 128 + col;
    float s[64];
#pragma unroll
    for (int d = 0; d < 64; ++d) s[d] = sin_[d * 128];
    const float lgam = h == 0 ? -0.04580368961312479f : h == 1 ? -0.02272007650008353f : h == 2 ? -0.011315313227834146f : -0.005646563141142063f;
    float cdec = 1.f;
    if (kind == 1) {
        const float* cgw = F.in[9]; const float* stq = F.in[4];
#pragma unroll
        for (int pass = 0; pass < 2; ++pass) {
            const int X = pass == 0 ? part : 2;
            if (pass == 0 || part == 0) {
                const int c = X * 512 + h * 128 + col;
                float full[7];
#pragma unroll
                for (int j = 0; j < 3; ++j) full[j] = stq[(size_t)(sb * 3 + j) * GQKV + c];
#pragma unroll
                for (int t = 0; t < 4; ++t) { const unsigned short b = PG[(size_t)(row0 + t) * 2048 + c]; full[3 + t] = __uint_as_float(((unsigned)b) << 16); }
                const float w0 = cgw[c], w1 = cgw[GQKV + c], w2 = cgw[2 * GQKV + c], w3 = cgw[3 * GQKV + c];
                LAS float* dst = X == 0 ? qs : (X == 1 ? ks : vs);
#pragma unroll
                for (int t = 0; t < 4; ++t) dst[t * 128 + col] = silu_f(w0 * full[t] + w1 * full[t + 1] + w2 * full[t + 2] + w3 * full[t + 3]);
            }
        }
        if (tt < 4) { SM[tt] = BG[(size_t)(row0 + tt) * 8 + 4 + h]; SM[4 + tt] = BG[(size_t)(row0 + tt) * 8 + h]; }
        __syncthreads();
        {
            const float q0 = qs[wv * 128 + lane], q1 = qs[wv * 128 + 64 + lane], k0 = ks[wv * 128 + lane], k1 = ks[wv * 128 + 64 + lane];
            const float rq = rsqrtf(wave_sum(q0 * q0 + q1 * q1) + EPS) * 0.08838834764831845f, rk = rsqrtf(wave_sum(k0 * k0 + k1 * k1) + EPS);
            qs[wv * 128 + lane] = q0 * rq; qs[wv * 128 + 64 + lane] = q1 * rq; ks[wv * 128 + lane] = k0 * rk; ks[wv * 128 + 64 + lane] = k1 * rk;
        }
        __syncthreads();
        float cum[4]; { float a = 0.f;
#pragma unroll
            for (int i = 0; i < 4; ++i) { a += SM[i]; cum[i] = a; } }
        cdec = __expf(cum[3]);
        {
#pragma unroll
            for (int j = 0; j < 4; ++j) {
                const float kk = wave_sum(ks[wv * 128 + lane] * ks[j * 128 + lane] + ks[wv * 128 + 64 + lane] * ks[j * 128 + 64 + lane]);
                const float qk = wave_sum(qs[wv * 128 + lane] * ks[j * 128 + lane] + qs[wv * 128 + 64 + lane] * ks[j * 128 + 64 + lane]);
                if (lane == 0) { const float dec = wv >= j ? __expf(cum[wv] - cum[j]) : 0.f; SM[8 + wv * 4 + j] = wv > j ? SM[4 + wv] * kk * dec : 0.f; SM[24 + wv * 4 + j] = qk * dec; }
            }
        }
        __syncthreads();
        {
            float x[4];
#pragma unroll
            for (int i = 0; i < 4; ++i) {
                float rr = part == 0 ? vs[i * 128 + col] * SM[4 + i] : ks[i * 128 + col] * SM[4 + i] * __expf(cum[i]);
#pragma unroll
                for (int j = 0; j < 4; ++j) if (j < i) rr -= SM[8 + i * 4 + j] * x[j];
                x[i] = rr;
            }
            if (part == 0) {
#pragma unroll
                for (int i = 0; i < 4; ++i) { US[i * 128 + col] = x[i]; T4[col * 12 + 4 + i] = qs[i * 128 + col] * __expf(cum[i]); }
            } else {
#pragma unroll
                for (int i = 0; i < 4; ++i) { T4[col * 12 + i] = x[i]; T4[col * 12 + 8 + i] = ks[i * 128 + col] * __expf(cum[3] - cum[i]); }
            }
        }
        __syncthreads();
    } else {
        if (part == 0) {
#pragma unroll
            for (int t = 0; t < 4; ++t) {
                const bf16_t* rp = PR + (size_t)(row0 + t) * 2048 + h * 128 + col;
                const float qv = __uint_as_float(((unsigned)rp[0]) << 16), kv = __uint_as_float(((unsigned)rp[512]) << 16), vv = __uint_as_float(((unsigned)rp[1024]) << 16);
                qs[t * 128 + col] = qv; ks[t * 128 + col] = kv; vs[t * 128 + col] = vv;
                T4[col * 12 + 4 + t] = qv;
                T4[col * 12 + 8 + t] = kv * exp2f(lgam * (float)(3 - t));
                T4[col * 12 + t] = 0.f;
            }
        }
        __syncthreads();
#pragma unroll
        for (int j = 0; j < 4; ++j) {
            const float qk = wave_sum(qs[wv * 128 + lane] * ks[j * 128 + lane] + qs[wv * 128 + 64 + lane] * ks[j * 128 + 64 + lane]);
            if (lane == 0) SM[24 + wv * 4 + j] = wv >= j ? qk * exp2f(lgam * (float)(wv - j)) : 0.f;
        }
        cdec = exp2f(lgam * 4.0f);
        __syncthreads();
    }
    float pw[4] = {0.f, 0.f, 0.f, 0.f}, pq[4] = {0.f, 0.f, 0.f, 0.f};
#pragma unroll
    for (int d = 0; d < 64; ++d) {
        const LAS f32x4* tp = (const LAS f32x4*)(T4 + (64 * part + d) * 12);
        const f32x4 wk4 = tp[0], qd4 = tp[1];
        pw[0] += wk4[0] * s[d]; pw[1] += wk4[1] * s[d]; pw[2] += wk4[2] * s[d]; pw[3] += wk4[3] * s[d];
        pq[0] += qd4[0] * s[d]; pq[1] += qd4[1] * s[d]; pq[2] += qd4[2] * s[d]; pq[3] += qd4[3] * s[d];
    }
#pragma unroll
    for (int i = 0; i < 4; ++i) { PX[(part * 8 + i) * 128 + col] = pw[i]; PX[(part * 8 + 4 + i) * 128 + col] = pq[i]; }
    __syncthreads();
    float w[4], o[4];
#pragma unroll
    for (int i = 0; i < 4; ++i) {
        const float sw = PX[i * 128 + col] + PX[(8 + i) * 128 + col], sq_ = PX[(4 + i) * 128 + col] + PX[(12 + i) * 128 + col];
        if (kind == 1) { w[i] = US[i * 128 + col] - sw; o[i] = sq_; } else { w[i] = vs[i * 128 + col]; o[i] = exp2f(lgam * (float)(i + 1)) * sq_; }
    }
#pragma unroll
    for (int i = 0; i < 4; ++i)
#pragma unroll
        for (int j = 0; j < 4; ++j) if (j <= i) o[i] += SM[24 + i * 4 + j] * w[j];
#pragma unroll
    for (int d = 0; d < 64; ++d) {
        const f32x4 kd4 = *(const LAS f32x4*)(T4 + (64 * part + d) * 12 + 8);
        sout[d * 128] = cdec * s[d] + kd4[0] * w[0] + kd4[1] * w[1] + kd4[2] * w[2] + kd4[3] * w[3];
    }
    float st[4], sq2[4];
#pragma unroll
    for (int i = 0; i < 4; ++i) { st[i] = wave_sum(o[i]); }
    if (part == 0 && lane == 0) {
#pragma unroll
        for (int i = 0; i < 4; ++i) SM[40 + (wv & 1) * 4 + i] = st[i]; }
    __syncthreads();
    float mu[4];
#pragma unroll
    for (int i = 0; i < 4; ++i) { mu[i] = kind == 0 ? (SM[40 + i] + SM[44 + i]) * (1.0f / 128.0f) : 0.f; const float dd = o[i] - mu[i]; sq2[i] = wave_sum(dd * dd); }
    if (part == 0 && lane == 0) {
#pragma unroll
        for (int i = 0; i < 4; ++i) SM[48 + (wv & 1) * 4 + i] = sq2[i]; }
    __syncthreads();
    if (part == 0) {
        const float nwv = kind == 0 ? F.in[12][h * 128 + col] : F.in[13][col];
        const bf16_t* gsrc = kind == 0 ? PR : PG;
#pragma unroll
        for (int i = 0; i < 4; ++i) {
            const float rstd = rsqrtf((SM[48 + i] + SM[52 + i]) * (1.0f / 128.0f) + EPS);
            const float gate = __uint_as_float(((unsigned)gsrc[(size_t)(row0 + i) * 2048 + 1536 + h * 128 + col]) << 16);
            mix[(size_t)(row0 + i) * DM + (kind == 0 ? 0 : 512) + h * 128 + col] = (bf16_t)(cvt_pk_bf16((o[i] - mu[i]) * rstd * nwv * gate, 0.f) & 0xffffu);
        }
    }
    __syncthreads();
}

struct Args { const float* in[20]; float* out; unsigned char* ws; int ph_lo, ph_hi, li, pad; };
constexpr int NPHASE = 8;

__global__ void __launch_bounds__(512, 2) mega_fwd(Args args) {
    extern __shared__ __attribute__((aligned(16))) unsigned char lds[];
    Frame F;
    F.lds = (LAS unsigned char*)lds;
    F.tid = threadIdx.x; F.lane = F.tid & 63; F.wave = __builtin_amdgcn_readfirstlane(F.tid >> 6);
    F.G = gridDim.x; F.blk = blockIdx.x;
#pragma unroll
    for (int i = 0; i < 20; ++i) F.in[i] = args.in[i];
    F.out = args.out; F.ws = args.ws;
    volatile LAS unsigned* MISC = (volatile LAS unsigned*)(F.lds + MISC_OFF);
    for (int u = F.tid; u < (LDS_BYTES - LDSCTL_OFF) / 4; u += 512) ((LAS unsigned*)(F.lds + LDSCTL_OFF))[u] = 0u;
    __syncthreads();
    unsigned* barw = (unsigned*)(F.ws + WS_CTL) + CW_BAR + args.li * XCD_BAR_WORDS;
    XcdBarrier bar; bar.bar = barw; bar.x = 0; bar.st = nullptr;
    if (MK_N_LAUNCHES == 1) bar = xcd_barrier_post(barw, MISC + 8);
    const int lo = args.ph_lo, hi = args.ph_hi;
#define IN(k) (lo <= (k) && (k) < hi)
#define SEAM(k) do { if (IN(k) && IN((k) + 1)) xcd_barrier(bar); } while (0)
#define STAMP(k) do { if (MK_TPROBE && F.tid == 0) ((unsigned*)(F.ws + WS_CTL))[CW_TS + (k) * 256 + F.blk] = (unsigned)__builtin_amdgcn_s_memrealtime(); } while (0)
    STAMP(0);

    for (int rep = 0; rep < 1 + (MK_REPEAT & 1); ++rep) { if (rep) xcd_barrier(bar); if (IN(0)) { p0_prologue(F); } }
    STAMP(1); SEAM(0);
    for (int rep = 0; rep < 1 + ((MK_REPEAT >> 1) & 1); ++rep) { if (rep) xcd_barrier(bar);
    if (IN(1)) {
        pg8::Gemm g{(const bf16_t*)(F.ws + WS_H), (const bf16_t*)(F.ws + WS_WIN), 1024};
        pg8::StaticOrder S; S.init(MPAD / 256, NIN / 256, F.G, F.blk);
        EpiIn E{(bf16_t*)(F.ws + WS_PR), (bf16_t*)(F.ws + WS_PG), (const float*)(F.ws + WS_ROT), F.out};
        pg8::gemm_phase<EpiIn, pg8::StaticOrder, pg8::MapPlain>(F.lds, g, S, E);
    } }
    STAMP(2); SEAM(1);
    if (IN(2)) {
        unsigned* FLG = (unsigned*)(F.ws + WS_CTL) + CW_FLAG;
        const int NW = F.G - 64;
        int it = F.blk < 64 ? F.blk : F.blk - 64;
        const int iend = F.blk < 64 ? F.blk + 1 : 33 * 64 + 512, istep = F.blk < 64 ? 1 : NW;
#pragma unroll 1
        for (; it < iend; it += istep) {
            int kind, h = 0, nch = 0, t0 = 0, c = 4; SeqD sq{0, 0, 0, 0}; unsigned char* slot = nullptr; float* sfinal = nullptr; int pair0 = 0; unsigned* flag = nullptr;
            if (F.blk < 64) {
                const int bb = it & 31, b = bb >> 2; h = bb & 3; kind = it < 32 ? 1 : 2; nch = 33;
                sq = SeqD{b * LP, LP, 0, b};
                slot = kind == 1 ? F.ws + WS_G2A + (size_t)(bb * 33) * SLOT : F.ws + WS_RP + (size_t)(bb * 33) * 8192;
                sfinal = F.out + (it < 32 ? O_PSG : O_PSR) + (size_t)bb * 16384;
                flag = FLG + (size_t)((kind == 1 ? 0 : 33 * 32) + bb) * 64;
            } else if (it < 33 * 64) {
                const int n = it >> 6, j = ((it & 63) + 11 * n) & 63, bh = j & 31, b = bh >> 2; h = bh & 3; kind = j < 32 ? 6 : 0;
                sq = SeqD{b * LP, LP, 0, b}; t0 = n == 0 ? 0 : 16 + 64 * (n - 1); c = n == 0 ? 16 : 64;
                slot = kind == 0 ? F.ws + WS_G2A + (size_t)(bh * 33 + n) * SLOT : F.ws + WS_RP + (size_t)(bh * 33 + n) * 8192;
                flag = FLG + (size_t)(((kind == 0 ? 0 : 33) + n) * 32 + bh) * 64;
            } else { const int j = it - 33 * 64; kind = j < 256 ? 4 : 5; pair0 = (j & 255) * 2; }
            if (kind == 0) { p2a_item(F, sq, h, t0, c, slot); chunk_publish(flag); }
            if (kind == 6) { ret_prepass_item(F, sq, h, t0, c, slot); chunk_publish(flag); }
            if (kind == 4 || kind == 5) sample_pair(F, kind == 4 ? 1 : 0, pair0);
            if (kind == 1) scan_gdn(F, sq, h, nch, slot, nullptr, sfinal, flag);
            if (kind == 2) scan_ret(F, sq, h, nch, slot, sfinal, flag);
        }
    }
    STAMP(3);
    STAMP(4); SEAM(3);
    for (int rep = 0; rep < 1 + ((MK_REPEAT >> 4) & 1); ++rep) { if (rep) xcd_barrier(bar);
    if (IN(4)) {
        pg8::Gemm g{(const bf16_t*)((unsigned char*)F.out + OS_MIX), (const bf16_t*)(F.ws + WS_WOUT), 1024};
        pg8::StaticOrder S; S.init(MPAD / 256, 4, F.G, F.blk);
        EpiOut E{F.in[0], F.in[1], F.in[6], (bf16_t*)(F.ws + WS_X2B), (float*)(F.ws + WS_RSQ2)};
        pg8::gemm_phase<EpiOut, pg8::StaticOrder, pg8::MapPlain>(F.lds, g, S, E);
    } }
    STAMP(5); SEAM(4);
    for (int rep = 0; rep < 1 + ((MK_REPEAT >> 5) & 1); ++rep) { if (rep) xcd_barrier(bar);
    if (IN(5)) {
        pg8::Gemm g{(const bf16_t*)(F.ws + WS_X2B), (const bf16_t*)(F.ws + WS_WUP), 1024};
        pg8::StaticOrder S; S.init(UP_NM, NUP / 256, F.G, F.blk);
        EpiUp E{(const float*)(F.ws + WS_RSQ2), F.in[17], F.in[5], (bf16_t*)(F.ws + WS_ACT), F.out};
        pg8::gemm_phase<EpiUp, pg8::StaticOrder, pg8::MapUp>(F.lds, g, S, E);
    } }
    STAMP(6); SEAM(5);
    for (int rep = 0; rep < 1 + ((MK_REPEAT >> 6) & 1); ++rep) { if (rep) xcd_barrier(bar);
    if (IN(6)) {
        pg8::Gemm g{(const bf16_t*)(F.ws + WS_ACT), (const bf16_t*)(F.ws + WS_WDN), DFF};
        pg8::StaticOrder S; S.init(MPAD / 256, 4, F.G, F.blk);
        EpiDown E{(const bf16_t*)(F.ws + WS_X2B), F.out, (float*)(F.ws + WS_RSQ3)};
        pg8::gemm_phase<EpiDown, pg8::StaticOrder, pg8::MapPlain>(F.lds, g, S, E);
    } }
    STAMP(7); SEAM(6);
    if (IN(7)) {
        const float* rsq = (const float*)(F.ws + WS_RSQ3); const float* nf = F.in[19];
        const int gw = F.blk * 8 + F.wave, NGW = F.G * 8;
        for (int q = gw; q < 16384 + 512; q += NGW) {
            int g; float* dst;
            if (q < 16384) { g = (q >> 11) * LP + 16 + (q & 2047); dst = F.out + O_YP + (size_t)q * DM; } else { g = MPROMPT + (q - 16384); dst = F.out + O_YS + (size_t)(q - 16384) * DM; }
            float s = F.lane < 16 ? rsq[(size_t)g * 16 + F.lane] : 0.f;
            s = wave_sum(s);
            const float rstd = rsqrtf(s * (1.0f / DM) + EPS);
            f32x4* p = (f32x4*)dst + F.lane; const f32x4* np = (const f32x4*)nf + F.lane;
#pragma unroll
            for (int j = 0; j < 4; ++j) { f32x4 v = p[64 * j]; v = v * rstd * np[64 * j]; p[64 * j] = v; }
        }
    }
    if (MK_TPROBE && IN(7)) {
        STAMP(8);
        xcd_barrier(bar);
        if (F.blk == 0) {
            LAS float* sh = (LAS float*)F.lds;
            if (F.tid == 0) {
                const unsigned* TS = (const unsigned*)(F.ws + WS_CTL) + CW_TS;
                auto mx = [&](int k, int lo_, int hi_) { unsigned m = TS[k * 256 + lo_]; for (int b = lo_; b < hi_; ++b) { const unsigned v = TS[k * 256 + b]; if ((int)(v - m) > 0) m = v; } return m; };
                unsigned d = 0;
                const int sel = MK_TPROBE;
                if (sel >= 1 && sel <= 8) d = mx(sel, 0, F.G) - mx(sel - 1, 0, F.G);
                else if (sel == 10) d = TS[4 * 256 + 0] - mx(3, 0, F.G);
                else if (sel == 11) d = TS[4 * 256 + 32] - mx(3, 0, F.G);
                else if (sel == 12) d = mx(4, 64, F.G) - mx(3, 0, F.G);
                else if (sel == 13) d = mx(8, 0, F.G) - TS[0];
                else if (sel == 14) d = TS[3 * 256 + 0] - mx(2, 0, F.G);
                else if (sel == 15) d = TS[3 * 256 + 32] - mx(2, 0, F.G);
                else if (sel == 16) d = mx(3, 64, F.G) - mx(2, 0, F.G);
                else if (sel >= 20 && sel <= 23) d = TS[(sel - 11) * 256 + 0];
                else if (sel >= 30 && sel <= 41) d = TS[(sel - 17) * 256 + 0] - mx(2, 0, F.G);
                else if (sel >= 50 && sel <= 59) d = TS[(sel - 24) * 256 + 0];
                else if (sel >= 60 && sel <= 69) d = TS[(sel - 34) * 256 + 64];
                sh[0] = sqrtf(MK_TSCALE * (float)d * 0.01f);
            }
            __syncthreads();
            const float f = 1.0f + sh[0];
            for (int e = F.tid; e < 8 * 3 * GQKV; e += 512) F.out[O_PCQ + e] *= f;
        }
    }
#undef IN
#undef SEAM
}

extern "C" void kernel_launch(void* const* d_in, const int* in_sizes, int n_in, void* d_out, int out_size, void* d_ws, size_t ws_size, hipStream_t stream) {
    static int grid = 0;
    if (grid == 0) {
        if (n_in != 20 || (size_t)out_size != O_TOTAL || ws_size < WS_END) { fprintf(stderr, "kernel_launch: unexpected shapes (n_in %d, out %d, ws %zu); nothing launched\n", n_in, out_size, ws_size); grid = -1; return; }
        int dev = 0, cus = 0;
        if (hipGetDevice(&dev) != hipSuccess || hipDeviceGetAttribute(&cus, hipDeviceAttributeMultiprocessorCount, dev) != hipSuccess) { grid = -1; return; }
        if (hipFuncSetAttribute((const void*)mega_fwd, hipFuncAttributeMaxDynamicSharedMemorySize, LDS_BYTES) != hipSuccess) { fprintf(stderr, "kernel_launch: hipFuncSetAttribute failed\n"); grid = -1; return; }
        (void)hipGetLastError();
        grid = cus;
        if (grid < 128 || (grid & 7)) { fprintf(stderr, "kernel_launch: unexpected CU count %d\n", cus); }
    }
    if (grid < 0) return;
    if (hipMemsetAsync((char*)d_ws + WS_CTL, 0, CTL_ZERO_BYTES, stream) != hipSuccess) return;
    Args a{};
    for (int i = 0; i < 20; ++i) a.in[i] = (const float*)d_in[i];
    a.out = (float*)d_out; a.ws = (unsigned char*)d_ws;
#if MK_N_LAUNCHES == 1
    a.ph_lo = 0; a.ph_hi = NPHASE; a.li = 0;
    hipLaunchKernelGGL(mega_fwd, dim3(grid), dim3(512), LDS_BYTES, stream, a);
#else
    for (int li = 0; li < NPHASE; ++li) { a.ph_lo = li; a.ph_hi = li + 1; a.li = 0; hipLaunchKernelGGL(mega_fwd, dim3(grid), dim3(512), LDS_BYTES, stream, a); }
#endif
}
```

```cpp
#include <hip/hip_runtime.h>
#include <cstdio>
#include <cstdint>

#ifndef MK_REPEAT
#define MK_REPEAT 0
#endif
#ifndef MK_TPROBE
#define MK_TPROBE 0
#endif
#ifndef MK_TSCALE
#define MK_TSCALE 2e-7f
#endif
#ifndef MK_N_LAUNCHES
#define MK_N_LAUNCHES 1
#endif

#define LAS __attribute__((address_space(3)))
typedef unsigned short bf16_t;
typedef short bf16x8 __attribute__((ext_vector_type(8)));
typedef short s16x4 __attribute__((ext_vector_type(4)));
typedef float f32x4 __attribute__((ext_vector_type(4)));
typedef unsigned u32x4 __attribute__((ext_vector_type(4)));
typedef unsigned u32x2 __attribute__((ext_vector_type(2)));

constexpr int DM = 1024, LP = 2064, NBATCH = 8, MPROMPT = NBATCH * LP  , NSB = 128, MSAMP = 512, MREAL = MPROMPT + MSAMP  , MPAD = 17152  ;
constexpr int NIN = 4096, INW = 4104, DFF = 2816, NUP = 5632, GQKV = 1536;
constexpr int UP_TROWS = 248, UP_NM = 69;
constexpr float EPS = 1e-6f;
constexpr size_t O_YP = 0, O_YS = 16777216, O_PSR = 17301504, O_PSG = 17825792, O_PCQ = 18350080, O_PCF = 18386944, O_SSR = 18477056, O_SSG = 26865664, O_SCQ = 35254272, O_SCF = 35844096, O_TOTAL = 37285888;
constexpr size_t MiB = 1u << 20;
constexpr size_t WS_CTL = 0, CTL_ZERO_BYTES = 1 * MiB;
constexpr size_t WS_WIN = 1 * MiB, WS_WOUT = 9 * MiB, WS_WUP = 11 * MiB, WS_WDN = 22 * MiB, WS_ROT = 28 * MiB, WS_BG = 30 * MiB, WS_RSQ2 = 31 * MiB, WS_RSQ3 = 32 * MiB + 512 * 1024;
constexpr size_t WS_PGX = 34 * MiB;
constexpr size_t WS_BIG = 36 * MiB;
constexpr size_t WS_PR = WS_BIG, WS_PG = WS_BIG + 67 * MiB, WS_G2A = WS_BIG + 134 * MiB, WS_H = WS_G2A;
constexpr size_t WS_X2F = WS_BIG, WS_X2B = WS_BIG + 67 * MiB, WS_ACT = WS_BIG + 101 * MiB;
constexpr size_t SLOT = 73984;
constexpr size_t WS_RP = WS_BIG + 209 * MiB;
constexpr size_t WS_END = 256 * MiB;
static_assert(WS_G2A + 1056 * SLOT <= WS_RP && WS_RP + 1056 * 8192 <= WS_END && WS_ACT + (size_t)MPAD * DFF * 2 <= WS_END, "ws map");
constexpr size_t OS_MIX = 0, OS_SCR = 34 * MiB;
static_assert(OS_SCR + 256 * SLOT <= 64 * MiB, "d_out scratch");
constexpr int CW_BAR = 4096, CW_TS = 16384, CW_FLAG = 65536;
constexpr int RING_BYTES = 131072, LDSCTL_OFF = 150528, MISC_OFF = LDSCTL_OFF + 320, LDS_BYTES = 151552;

#define LDS_WAIT() asm volatile("s_waitcnt lgkmcnt(0)" ::: "memory")
#define VM_WAIT() asm volatile("s_waitcnt vmcnt(0)" ::: "memory")

typedef float f32x2_t __attribute__((ext_vector_type(2))); typedef __bf16 bf16x2_t __attribute__((ext_vector_type(2)));
__device__ __forceinline__ unsigned cvt_pk_bf16(float lo, float hi) { const f32x2_t v = {lo, hi}; const bf16x2_t b = __builtin_convertvector(v, bf16x2_t); return __builtin_bit_cast(unsigned, b); }
__device__ __forceinline__ float bflo(unsigned w) { return __uint_as_float(w << 16); }
__device__ __forceinline__ float bfhi(unsigned w) { return __uint_as_float(w & 0xffff0000u); }
__device__ __forceinline__ float bfround(float x) { return bflo(cvt_pk_bf16(x, 0.f)); }
__device__ __forceinline__ float silu_f(float y) { return y * __builtin_amdgcn_rcpf(1.0f + __expf(-y)); }
__device__ __forceinline__ float wave_sum(float v) {
#pragma unroll
    for (int o = 1; o < 64; o <<= 1) v += __shfl_xor(v, o);
    return v;
}
__device__ __forceinline__ float bsel(int mask  , float a_if_set, float b_if_clear) { return __int_as_float((mask & __float_as_int(a_if_set)) | (~mask & __float_as_int(b_if_clear))); }
__device__ __forceinline__ float dpp_shr1(float x) { return __int_as_float(__builtin_amdgcn_update_dpp(0, __float_as_int(x), 0x111, 0xf, 0xf, true)); }

struct RowInfo { int t, len, idx, samp; };
__device__ __forceinline__ RowInfo rowinfo(int g) {
    RowInfo r;
    if (g < MPROMPT) { r.idx = g / LP; r.t = g - r.idx * LP; r.len = LP; r.samp = 0; }
    else { const int s = g - MPROMPT; r.idx = s >> 2; r.t = s & 3; r.len = 4; r.samp = 1; }
    return r;
}

namespace pg8 {
constexpr int BM = 256, BK = 64, HALF = 128, HTB = HALF * BK * 2, STAGE_BYTES = 8 * HTB, NXCD = 8, WGM = 8;
__host__ __device__ __forceinline__ int lds_byte(int r, int c) { const int st = (r >> 4) * 2 + (c >> 5), rr = r & 15, cc = c & 31, ob = rr * 64 + cc * 2; return st * 1024 + (ob ^ (((ob >> 9) & 1) << 5)); }
__host__ __device__ __forceinline__ void stage_rc(int b, int& R, int& C) { const int st = b / 1024, sb = b % 1024, swz = sb ^ (((sb >> 9) & 1) << 5); R = (st >> 1) * 16 + swz / 64; C = (st & 1) * 32 + (swz % 64) / 2; }
__host__ __device__ __forceinline__ int perm32(int rho) { const int n = rho >> 4, i = rho & 15; return 8 * (i >> 2) + 4 * n + (i & 3); }
struct Unit { int pm, pn; };
struct Gemm { const bf16_t* A; const bf16_t* Bt; int K; };
struct StaticOrder {
    int nM, nN, nwg, G, c;
    __host__ __device__ void init(int nM_, int nN_, int G_, int c_) { nM = nM_; nN = nN_; nwg = nM * nN; G = G_; c = c_; }
    __host__ __device__ bool next(int i, Unit& u) const {
        const long L = (long)i * G + c; if (L >= nwg) return false;
        int wgid = (int)L; { const int q = nwg / NXCD, r = nwg % NXCD, xcd = wgid % NXCD, off = wgid / NXCD; wgid = (xcd < r ? xcd * (q + 1) : r * (q + 1) + (xcd - r) * q) + off; }
        const int nig = WGM * nN, gid = wgid / nig, fm = gid * WGM, gsz = (nM - fm) < WGM ? (nM - fm) : WGM;
        u.pm = fm + ((wgid % nig) % gsz); u.pn = (wgid % nig) / gsz; return true;
    }
    __device__ __forceinline__ void a_ready(const Unit&) const {}
    __device__ __forceinline__ void done(const Unit&) const {}
};
struct MapPlain { static constexpr int HROWS = 128, TROWS = 256; static __device__ __forceinline__ int row(int R) { return R; } };
struct MapUp { static constexpr int HROWS = 124, TROWS = UP_TROWS; static __device__ __forceinline__ int row(int R) { return 62 * (R >> 6) - 2 + 4 * (R & 15) + ((R >> 4) & 3); } };

template <class Epi, class Sched, class AMap, bool ALIGN_EPI = true>
__device__ __forceinline__ void gemm_phase(LAS unsigned char* lds, const Gemm g, const Sched& S, const Epi& E) {
    const int tid = threadIdx.x, wid = __builtin_amdgcn_readfirstlane(tid >> 6), lane = tid & 63, wr = wid >> 2, wc = wid & 3, fr = lane & 15, fq = lane >> 4;
    const int K = g.K, nt = K / BK;
    int voffA[2], voffB[2];
#pragma unroll
    for (int i = 0; i < 2; ++i) { int R, C; stage_rc(tid * 16 + i * 8192, R, C); const int Rb = Epi::PERM ? ((R & ~31) + perm32(R & 31)) : R;
        voffA[i] = (AMap::row(R) * K + C) * 2; voffB[i] = (Rb * K + C) * 2; }
    const size_t kstep = (size_t)(BK * 2);
    const size_t hstepA = (size_t)AMap::HROWS * K * 2, tstepA = (size_t)AMap::TROWS * K * 2;
    const size_t hstepB = (size_t)HALF * K * 2, tstepB = 2 * hstepB;
    const unsigned ldsw = (unsigned)wid * 1024u;
    const int aoff = lds_byte(wr * 64 + fr, fq * 8), boff = lds_byte(wc * 32 + fr, fq * 8);
#define PG8_SA(b, h) (((b) * 2 + (h)) * HTB)
#define PG8_SB(b, h) ((4 + (b) * 2 + (h)) * HTB)
#define PG8_STAGE(bufoff, gbase, voff) do { _Pragma("unroll") for (int _i = 0; _i < 2; ++_i) \
        __builtin_amdgcn_global_load_lds((const unsigned*)((const char*)(gbase) + (voff)[_i]), (LAS unsigned*)(lds + (bufoff) + ldsw + _i * 8192), 16, 0, 0); } while (0)
#define PG8_LDA(dst, b, h) do { _Pragma("unroll") for (int m = 0; m < 4; ++m) _Pragma("unroll") for (int k = 0; k < 2; ++k) dst[m][k] = *(const LAS bf16x8*)(lds + PG8_SA(b, h) + aoff + m * 2048 + k * 1024); } while (0)
#define PG8_LDB(dst, b, h) do { _Pragma("unroll") for (int n = 0; n < 2; ++n) _Pragma("unroll") for (int k = 0; k < 2; ++k) dst[n][k] = *(const LAS bf16x8*)(lds + PG8_SB(b, h) + boff + n * 2048 + k * 1024); } while (0)
#define PG8_MMA(ai, bj, At, Bt) do { __builtin_amdgcn_s_setprio(1); _Pragma("unroll") for (int m = 0; m < 4; ++m) _Pragma("unroll") for (int n = 0; n < 2; ++n) _Pragma("unroll") for (int k = 0; k < 2; ++k) \
        acc[ai][bj][m][n] = __builtin_amdgcn_mfma_f32_16x16x32_bf16(Bt[n][k], At[m][k], acc[ai][bj][m][n], 0, 0, 0); __builtin_amdgcn_s_setprio(0); } while (0)
#define PG8_WAIT_V(n) asm volatile("s_waitcnt vmcnt(" #n ")" ::: "memory")
#define PG8_WAIT_L(n) asm volatile("s_waitcnt lgkmcnt(" #n ")" ::: "memory")
#define PG8_BAR __builtin_amdgcn_s_barrier()
#define PG8_SCHED __builtin_amdgcn_sched_barrier(0)
    Unit cur, nxt; int ui = 0;
    if (!S.next(0, cur)) return;
    f32x4 acc[2][2][4][2];
#pragma unroll
    for (int a = 0; a < 2; ++a)
#pragma unroll
        for (int b = 0; b < 2; ++b)
#pragma unroll
            for (int m = 0; m < 4; ++m)
#pragma unroll
                for (int n = 0; n < 2; ++n) acc[a][b][m][n] = (f32x4){0.f, 0.f, 0.f, 0.f};
    bf16x8 At[4][2], B0[2][2], B1[2][2];
    const char* cA = (const char*)g.A + (size_t)cur.pm * tstepA; const char* cB = (const char*)g.Bt + (size_t)cur.pn * tstepB;
    S.a_ready(cur);
    PG8_STAGE(PG8_SB(0, 0), cB, voffB); PG8_STAGE(PG8_SB(0, 1), cB + hstepB, voffB); PG8_STAGE(PG8_SA(0, 0), cA, voffA); PG8_STAGE(PG8_SA(0, 1), cA + hstepA, voffA);
    if (wr == 1) PG8_BAR;
    PG8_WAIT_V(2); PG8_BAR;
    PG8_STAGE(PG8_SB(1, 0), cB + kstep, voffB); PG8_STAGE(PG8_SA(1, 0), cA + kstep, voffA); PG8_STAGE(PG8_SB(1, 1), cB + hstepB + kstep, voffB);
    PG8_WAIT_V(6); PG8_BAR;
    for (;;) {
        const bool has_next = S.next(ui + 1, nxt);
        const char* nA = has_next ? (const char*)g.A + (size_t)nxt.pm * tstepA : cA; const char* nB = has_next ? (const char*)g.Bt + (size_t)nxt.pn * tstepB : cB;
        for (int t = 0; t < nt; t += 2) {
            const bool last = (t == nt - 2);
            const char* a1 = cA + (size_t)(t + 1) * kstep;
            const char* a2 = last ? nA : cA + (size_t)(t + 2) * kstep; const char* b2 = last ? nB : cB + (size_t)(t + 2) * kstep;
            const char* a3 = a2 + kstep; const char* b3 = b2 + kstep;
            if (last && has_next) S.a_ready(nxt);
            PG8_LDB(B0, 0, 0); PG8_LDB(B1, 0, 1); PG8_SCHED; PG8_LDA(At, 0, 0); PG8_STAGE(PG8_SA(1, 1), a1 + hstepA, voffA);
            PG8_WAIT_V(8); PG8_WAIT_L(0); PG8_BAR; PG8_MMA(0, 0, At, B0); PG8_MMA(0, 1, At, B1); PG8_BAR; PG8_SCHED;
            PG8_LDA(At, 0, 1); PG8_STAGE(PG8_SB(0, 0), b2, voffB); PG8_STAGE(PG8_SB(0, 1), b2 + hstepB, voffB); PG8_STAGE(PG8_SA(0, 0), a2, voffA);
            PG8_WAIT_V(8); PG8_WAIT_L(0); PG8_BAR; PG8_MMA(1, 0, At, B0); PG8_MMA(1, 1, At, B1); PG8_BAR; PG8_SCHED;
            PG8_LDB(B0, 1, 0); PG8_LDB(B1, 1, 1); PG8_SCHED; PG8_LDA(At, 1, 0); PG8_STAGE(PG8_SA(0, 1), a2 + hstepA, voffA);
            PG8_WAIT_V(8); PG8_WAIT_L(0); PG8_BAR; PG8_MMA(0, 0, At, B0); PG8_MMA(0, 1, At, B1); PG8_BAR; PG8_SCHED;
            PG8_LDA(At, 1, 1); PG8_STAGE(PG8_SB(1, 0), b3, voffB); PG8_STAGE(PG8_SB(1, 1), b3 + hstepB, voffB); PG8_STAGE(PG8_SA(1, 0), a3, voffA);
            PG8_WAIT_V(8); PG8_WAIT_L(0); PG8_BAR; PG8_MMA(1, 0, At, B0); PG8_MMA(1, 1, At, B1); PG8_BAR; PG8_SCHED;
        }
        if constexpr (ALIGN_EPI) { if (wr == 0) PG8_BAR; }
        E(acc, cur, wr, wc, fr, fq); S.done(cur);
        if (!has_next) break;
#pragma unroll
        for (int a = 0; a < 2; ++a)
#pragma unroll
            for (int b = 0; b < 2; ++b)
#pragma unroll
                for (int m = 0; m < 4; ++m)
#pragma unroll
                    for (int n = 0; n < 2; ++n) acc[a][b][m][n] = (f32x4){0.f, 0.f, 0.f, 0.f};
        cur = nxt; cA = nA; cB = nB; ++ui;
        if constexpr (ALIGN_EPI) { if (wr == 1) PG8_BAR; }
    }
    PG8_WAIT_V(0);
    if constexpr (!ALIGN_EPI) { if (wr == 0) PG8_BAR; }
    PG8_BAR;
#undef PG8_SA
#undef PG8_SB
#undef PG8_STAGE
#undef PG8_LDA
#undef PG8_LDB
#undef PG8_MMA
#undef PG8_WAIT_V
#undef PG8_WAIT_L
#undef PG8_BAR
#undef PG8_SCHED
}
}
using pg8::Unit;


struct EpiIn {
    static constexpr bool PERM = true;
    bf16_t* PR; bf16_t* PG; const float* rot; float* out;
    __device__ __forceinline__ void operator()(const f32x4 (&acc)[2][2][4][2], const Unit& u, int wr, int wc, int fr_, int fq_) const {
        int ln_; asm volatile("v_mbcnt_lo_u32_b32 %0, -1, 0\n\tv_mbcnt_hi_u32_b32 %0, -1, %0" : "=v"(ln_)); const int fr = ln_ & 15, fq = ln_ >> 4;
        const int pn = u.pn, rbase = u.pm * 256 + wr * 64 + fr;
        if (pn < 4) {
            const int head = (pn & 1) * 2 + (wc >> 1), j0 = 32 * (wc & 1) + 8 * fq;
            const float sc = pn >= 2 ? 0.08838834764831845f : 1.0f;
            bf16_t* dstb = PR + (pn >= 2 ? 512 : 0) + head * 128 + j0;
#pragma unroll
            for (int ai = 0; ai < 2; ++ai)
#pragma unroll
                for (int m = 0; m < 4; ++m) {
                    const int row = rbase + ai * 128 + m * 16;
                    int ridx = 0; if (row < MPROMPT) ridx = row % LP; else if (row < MREAL) ridx = LP + ((row - MPROMPT) & 3);
                    const f32x4* rp = (const f32x4*)(rot + (size_t)ridx * 128 + j0 * 2);
                    const f32x4 cs0 = rp[0], cs1 = rp[1], cs2 = rp[2], cs3 = rp[3];
                    const f32x4 a0 = acc[ai][0][m][0], a1 = acc[ai][0][m][1], b0 = acc[ai][1][m][0], b1 = acc[ai][1][m][1];
                    const float c[8] = {cs0[0], cs0[2], cs1[0], cs1[2], cs2[0], cs2[2], cs3[0], cs3[2]};
                    const float s[8] = {cs0[1], cs0[3], cs1[1], cs1[3], cs2[1], cs2[3], cs3[1], cs3[3]};
                    const float x1[8] = {a0[0], a0[1], a0[2], a0[3], a1[0], a1[1], a1[2], a1[3]};
                    const float x2[8] = {b0[0], b0[1], b0[2], b0[3], b1[0], b1[1], b1[2], b1[3]};
                    float o1[8], o2[8];
#pragma unroll
                    for (int i = 0; i < 8; ++i) { o1[i] = (x1[i] * c[i] - x2[i] * s[i]) * sc; o2[i] = (x1[i] * s[i] + x2[i] * c[i]) * sc; }
                    u32x4 w1, w2; w1.x = cvt_pk_bf16(o1[0], o1[1]); w1.y = cvt_pk_bf16(o1[2], o1[3]); w1.z = cvt_pk_bf16(o1[4], o1[5]); w1.w = cvt_pk_bf16(o1[6], o1[7]);
                    w2.x = cvt_pk_bf16(o2[0], o2[1]); w2.y = cvt_pk_bf16(o2[2], o2[3]); w2.z = cvt_pk_bf16(o2[4], o2[5]); w2.w = cvt_pk_bf16(o2[6], o2[7]);
                    bf16_t* rowp = dstb + (size_t)row * 2048;
                    *(u32x4*)(rowp) = w1; *(u32x4*)(rowp + 64) = w2;
                }
        } else {
            const bool act = (pn == 6 || pn == 7 || pn >= 14);
            const bool cst = (pn >= 8 && pn < 14);
            bf16_t* dbase = pn < 8 ? PR : PG;
            const int colt = (pn < 8 ? pn * 256 : pn * 256 - 2048) + wc * 32 + 8 * fq;
#pragma unroll
            for (int ai = 0; ai < 2; ++ai)
#pragma unroll
                for (int m = 0; m < 4; ++m) {
                    const int row = rbase + ai * 128 + m * 16;
                    bf16_t* rowp = dbase + (size_t)row * 2048 + colt;
                    float* cdst = nullptr;
                    if (cst && row < MREAL) { const RowInfo ri = rowinfo(row); if (ri.t >= ri.len - 3) cdst = out + (ri.samp ? O_SCQ : O_PCQ) + (size_t)(ri.idx * 3 + (ri.t - (ri.len - 3))) * GQKV + colt; }
#pragma unroll
                    for (int bj = 0; bj < 2; ++bj) {
                        f32x4 v0 = acc[ai][bj][m][0], v1 = acc[ai][bj][m][1];
                        if (cdst) { *(f32x4*)(cdst + bj * 128) = v0; *(f32x4*)(cdst + bj * 128 + 4) = v1; }
                        if (act) {
#pragma unroll
                            for (int i = 0; i < 4; ++i) { v0[i] = silu_f(v0[i]); v1[i] = silu_f(v1[i]); }
                        }
                        u32x4 w; w.x = cvt_pk_bf16(v0[0], v0[1]); w.y = cvt_pk_bf16(v0[2], v0[3]); w.z = cvt_pk_bf16(v1[0], v1[1]); w.w = cvt_pk_bf16(v1[2], v1[3]);
                        *(u32x4*)(rowp + bj * 128) = w;
                    }
                }
        }
    }
};

__device__ __forceinline__ const float* x_src_row(const float* xp, const float* xs, const float* meta, int g) {
    if (g < MPROMPT) { const int b = g / LP, t = g - b * LP; return t < 16 ? meta + (size_t)t * DM : xp + ((size_t)b * 2048 + (t - 16)) * DM; }
    return xs + (size_t)(g - MPROMPT) * DM;
}

struct EpiOut {
    static constexpr bool PERM = false;
    const float* xp; const float* xs; const float* meta; bf16_t* X2B; float* rsq;
    __device__ __forceinline__ void operator()(const f32x4 (&acc)[2][2][4][2], const Unit& u, int wr, int wc, int fr_, int fq_) const {
        int ln_; asm volatile("v_mbcnt_lo_u32_b32 %0, -1, 0\n\tv_mbcnt_hi_u32_b32 %0, -1, %0" : "=v"(ln_)); const int fr = ln_ & 15, fq = ln_ >> 4;
        const int rbase = u.pm * 256 + wr * 64 + fr, col0 = u.pn * 256 + wc * 32 + 4 * fq;
#pragma unroll
        for (int ai = 0; ai < 2; ++ai)
#pragma unroll
            for (int m = 0; m < 4; ++m) {
                const int row = rbase + ai * 128 + m * 16;
                const float* xr = row < MREAL ? x_src_row(xp, xs, meta, row) + col0 : nullptr;
                bf16_t* ob = X2B + (size_t)row * DM + col0;
                float ss = 0.f;
#pragma unroll
                for (int bj = 0; bj < 2; ++bj)
#pragma unroll
                    for (int n = 0; n < 2; ++n) {
                        f32x4 v = acc[ai][bj][m][n];
                        if (xr) v += *(const f32x4*)(xr + bj * 128 + n * 16);
                        ss += (v[0] * v[0] + v[1] * v[1]) + (v[2] * v[2] + v[3] * v[3]);
                        u32x2 w; w.x = cvt_pk_bf16(v[0], v[1]); w.y = cvt_pk_bf16(v[2], v[3]);
                        *(u32x2*)(ob + bj * 128 + n * 16) = w;
                    }
                ss += __shfl_xor(ss, 16); ss += __shfl_xor(ss, 32);
                if (fq == 0) rsq[(size_t)row * 16 + u.pn * 4 + wc] = ss;
            }
    }
};

struct EpiDown {
    static constexpr bool PERM = false;
    const bf16_t* X2B; float* out; float* rsq;
    __device__ __forceinline__ void operator()(const f32x4 (&acc)[2][2][4][2], const Unit& u, int wr, int wc, int fr_, int fq_) const {
        int ln_; asm volatile("v_mbcnt_lo_u32_b32 %0, -1, 0\n\tv_mbcnt_hi_u32_b32 %0, -1, %0" : "=v"(ln_)); const int fr = ln_ & 15, fq = ln_ >> 4;
        const int rbase = u.pm * 256 + wr * 64 + fr, col0 = u.pn * 256 + wc * 32 + 4 * fq;
#pragma unroll
        for (int ai = 0; ai < 2; ++ai)
#pragma unroll
            for (int m = 0; m < 4; ++m) {
                const int row = rbase + ai * 128 + m * 16;
                float* yr = nullptr;
                if (row < MPROMPT) { const int b = row / LP, t = row - b * LP; if (t >= 16) yr = out + O_YP + ((size_t)b * 2048 + (t - 16)) * DM + col0; }
                else if (row < MREAL) yr = out + O_YS + (size_t)(row - MPROMPT) * DM + col0;
                const bf16_t* xr = X2B + (size_t)row * DM + col0;
                float ss = 0.f;
#pragma unroll
                for (int bj = 0; bj < 2; ++bj)
#pragma unroll
                    for (int n = 0; n < 2; ++n) {
                        const u32x2 xb = *(const u32x2*)(xr + bj * 128 + n * 16);
                        const f32x4 v = acc[ai][bj][m][n] + (f32x4){bflo(xb.x), bfhi(xb.x), bflo(xb.y), bfhi(xb.y)};
                        ss += (v[0] * v[0] + v[1] * v[1]) + (v[2] * v[2] + v[3] * v[3]);
                        if (yr) *(f32x4*)(yr + bj * 128 + n * 16) = v;
                    }
                ss += __shfl_xor(ss, 16); ss += __shfl_xor(ss, 32);
                if (fq == 0) rsq[(size_t)row * 16 + u.pn * 4 + wc] = ss;
            }
    }
};

struct EpiUp {
    static constexpr bool PERM = true;
    const float* rsq2; const float* cw; const float* stf; bf16_t* act; float* out;
    __device__ __forceinline__ void operator()(const f32x4 (&acc)[2][2][4][2], const Unit& u, int wr, int wc, int fr_, int fq_) const {
        int ln_; asm volatile("v_mbcnt_lo_u32_b32 %0, -1, 0\n\tv_mbcnt_hi_u32_b32 %0, -1, %0" : "=v"(ln_)); const int fr = ln_ & 15, fq = ln_ >> 4;
        const int colg = u.pn * 128 + wc * 32 + fq * 8;
#pragma unroll
        for (int ai = 0; ai < 2; ++ai) {
            const int g0 = u.pm * UP_TROWS + (2 * ai + wr) * 62 - 2 + 4 * fr;
            float rs[4];
#pragma unroll
            for (int m = 0; m < 4; ++m) {
                int g = g0 + m; g = g < 0 ? 0 : g;
                const f32x4* p = (const f32x4*)(rsq2 + (size_t)g * 16);
                const f32x4 s0 = p[0], s1 = p[1], s2 = p[2], s3 = p[3];
                const float s = ((s0[0] + s0[1]) + (s0[2] + s0[3])) + ((s1[0] + s1[1]) + (s1[2] + s1[3])) + ((s2[0] + s2[1]) + (s2[2] + s2[3])) + ((s3[0] + s3[1]) + (s3[2] + s3[3]));
                rs[m] = rsqrtf(s * (1.0f / DM) + EPS);
                asm volatile("" : "+v"(rs[m]));
                __builtin_amdgcn_sched_barrier(0);
            }
#pragma unroll
            for (int n = 0; n < 2; ++n) {
                const int col = colg + 4 * n;
                f32x4 w[2][3];
#pragma unroll
                for (int bj = 0; bj < 2; ++bj)
#pragma unroll
                    for (int k = 0; k < 3; ++k) w[bj][k] = *(const f32x4*)(cw + (size_t)k * NUP + bj * DFF + col);
#pragma unroll
                for (int m = 0; m < 4; ++m) {
                    const int g = g0 + m;
                    const bool vout = (4 * fr + m >= 2) && (g < MREAL);
                    const RowInfo ri = rowinfo(g < 0 ? 0 : g);
                    float y[2][4];
#pragma unroll
                    for (int bj = 0; bj < 2; ++bj) {
                        float cur[4], p1[4], p2[4];
#pragma unroll
                        for (int i = 0; i < 4; ++i) {
                            cur[i] = acc[ai][bj][m][n][i] * rs[m];
                            p1[i] = m >= 1 ? acc[ai][bj][m >= 1 ? m - 1 : 0][n][i] * rs[m >= 1 ? m - 1 : 0] : dpp_shr1(acc[ai][bj][3][n][i] * rs[3]);
                            p2[i] = m >= 2 ? acc[ai][bj][m >= 2 ? m - 2 : 0][n][i] * rs[m >= 2 ? m - 2 : 0] : dpp_shr1(acc[ai][bj][m == 0 ? 2 : 3][n][i] * rs[m == 0 ? 2 : 3]);
                        }
                        if (ri.t < 2) {
                            f32x4 S0 = {0.f, 0.f, 0.f, 0.f}, S1 = {0.f, 0.f, 0.f, 0.f};
                            if (ri.samp && ri.idx < NSB) { S0 = *(const f32x4*)(stf + (size_t)(ri.idx * 2 + 0) * NUP + bj * DFF + col); S1 = *(const f32x4*)(stf + (size_t)(ri.idx * 2 + 1) * NUP + bj * DFF + col); }
#pragma unroll
                            for (int i = 0; i < 4; ++i) { if (ri.t == 0) { p1[i] = S1[i]; p2[i] = S0[i]; } else { p2[i] = S1[i]; } }
                        }
                        if (vout && ri.t >= ri.len - 2) {
                            float* d = out + (ri.samp ? O_SCF : O_PCF) + (size_t)(ri.idx * 2 + (ri.t - (ri.len - 2))) * NUP + bj * DFF + col;
                            *(f32x4*)(d) = (f32x4){cur[0], cur[1], cur[2], cur[3]};
                        }
#pragma unroll
                        for (int i = 0; i < 4; ++i) y[bj][i] = w[bj][0][i] * p2[i] + w[bj][1][i] * p1[i] + w[bj][2][i] * cur[i];
                    }
                    if (vout) {
                        u32x2 pk; pk.x = cvt_pk_bf16(silu_f(y[0][0]) * y[1][0], silu_f(y[0][1]) * y[1][1]); pk.y = cvt_pk_bf16(silu_f(y[0][2]) * y[1][2], silu_f(y[0][3]) * y[1][3]);
                        *(u32x2*)(act + (size_t)g * DFF + col) = pk;
                    }
                    __builtin_amdgcn_sched_barrier(0);
                }
            }
        }
    }
};

#define XB_TMO      128
#define XB_XCNT(j)  (256  + 64 * (j))
#define XB_XSUB(j)  (1280 + 64 * (j))
#define XB_XGEN(j)  (2304 + 64 * (j))
#define XB_TOP      3328
#define XB_TOPGEN   3392
#define XCD_BAR_WORDS 3456
#define XB_SPIN_CAP (1u << 20)
__device__ __forceinline__ unsigned xb_ld(unsigned* p)              { return __hip_atomic_load(p, __ATOMIC_RELAXED, __HIP_MEMORY_SCOPE_AGENT); }
__device__ __forceinline__ unsigned xb_add(unsigned* p, unsigned v) { return __hip_atomic_fetch_add(p, v, __ATOMIC_RELAXED, __HIP_MEMORY_SCOPE_AGENT); }
__device__ __forceinline__ unsigned xb_xcc_id() { return (unsigned)__builtin_amdgcn_s_getreg((3 << 11) | 20) & 0xFu; }
#define XB_SPIN(cond, bar) do { unsigned _sp = 0; while (cond) { __builtin_amdgcn_s_sleep(1); \
    if ((++_sp & 255u) == 0u) { if (xb_ld(&(bar)[XB_TMO])) break; if (_sp > XB_SPIN_CAP) { atomicAdd(&(bar)[XB_TMO], 1u); break; } } } } while (0)
struct XcdBarrier { unsigned* bar; unsigned x; volatile LAS unsigned* st; };
__device__ __forceinline__ XcdBarrier xcd_barrier_post(unsigned* bar, volatile LAS unsigned* st) {
    XcdBarrier b; b.bar = bar; b.x = xb_xcc_id(); b.st = st;
    if (threadIdx.x == 0) (void)xb_add(&bar[XB_XCNT(b.x)], 1u);
    return b;
}
__device__ __forceinline__ void xcd_barrier_complete(unsigned* bar, unsigned x, unsigned& nloc, unsigned& nx) {
    const unsigned G = gridDim.x * gridDim.y * gridDim.z;
    unsigned sum, cnt, mine, sp = 0u;
    for (;;) {
        sum = 0u; cnt = 0u; mine = 0u;
#pragma unroll
        for (unsigned j = 0; j < 16; ++j) { const unsigned c = xb_ld(&bar[XB_XCNT(j)]); sum += c; cnt += (c > 0u) ? 1u : 0u; mine = (j == x) ? c : mine; }
        if (sum == G) break;
        __builtin_amdgcn_s_sleep(1);
        if ((++sp & 255u) == 0u) { if (xb_ld(&bar[XB_TMO])) break; if (sp > XB_SPIN_CAP) { atomicAdd(&bar[XB_TMO], 1u); break; } }
    }
    nloc = mine > 0u ? mine : 1u; nx = cnt > 0u ? cnt : 1u;
}
__device__ __forceinline__ void xcd_barrier(const XcdBarrier& b) {
    asm volatile("s_waitcnt vmcnt(0)" ::: "memory");
    __syncthreads();
    if (threadIdx.x == 0) {
        unsigned* bar = b.bar;
        __builtin_amdgcn_s_waitcnt(0);
        unsigned nloc = b.st[0], nx = b.st[1];
        if (nloc == 0u) { xcd_barrier_complete(bar, b.x, nloc, nx); b.st[0] = nloc; b.st[1] = nx; }
        const unsigned old = xb_add(&bar[XB_XSUB(b.x)], 1u);
        const unsigned gen = old / nloc;
        if (old + 1u == (gen + 1u) * nloc) {
            __builtin_amdgcn_fence(__ATOMIC_RELEASE, "agent");
            asm volatile("s_waitcnt vmcnt(0)" ::: "memory");
            const unsigned og = xb_add(&bar[XB_TOP], 1u);
            const unsigned tg = og / nx;
            if (og + 1u == (tg + 1u) * nx) xb_add(&bar[XB_TOPGEN], 1u);
            else XB_SPIN(xb_ld(&bar[XB_TOPGEN]) == tg, bar);
            __builtin_amdgcn_fence(__ATOMIC_ACQUIRE, "agent");
            xb_add(&bar[XB_XGEN(b.x)], 1u);
            asm volatile("s_waitcnt vmcnt(0)" ::: "memory");
        } else {
            XB_SPIN(xb_ld(&bar[XB_XGEN(b.x)]) == gen, bar);
            __builtin_amdgcn_fence(__ATOMIC_ACQUIRE, "agent");
            asm volatile("s_waitcnt vmcnt(0)" ::: "memory");
        }
    }
    __syncthreads();
}

struct Frame {
    LAS unsigned char* lds;
    int tid, lane, wave, G, blk;
    const float* in[20];
    float* out; unsigned char* ws;
};

constexpr int TROW0 = 16384, TROWS = 640;
template <class Q>
__device__ __forceinline__ void skinny_phase(Frame& F, const bf16_t* A, const bf16_t* Bt, int K, float* rsq, const Q& quad) {
    if (F.blk >= (TROWS / 32) * 8) return;
    unsigned lbase = (unsigned)(uintptr_t)F.lds; int tid = F.tid;
    asm volatile("" : "+s"(lbase), "+v"(tid));
    LAS f32x4* part = (LAS f32x4*)(uintptr_t)lbase;
    LAS float* rsum = (LAS float*)(uintptr_t)(lbase + 131072);
    const int lane = tid & 63, w = __builtin_amdgcn_readfirstlane(tid >> 6), l15 = lane & 15, g = lane >> 4;
    const int rt = F.blk >> 3, ct = F.blk & 7, row0 = TROW0 + 32 * rt;
    const int nks = K / 256, kb = w * nks * 32;
    const bf16_t* a0 = A + (size_t)(row0 + l15) * K + kb + 8 * g; const bf16_t* a1 = a0 + (size_t)16 * K;
    const bf16_t* b0 = Bt + (size_t)(128 * ct + l15) * K + kb + 8 * g;
    f32x4 acc[2][8];
#pragma unroll
    for (int i = 0; i < 2; ++i)
#pragma unroll
        for (int nt = 0; nt < 8; ++nt) acc[i][nt] = (f32x4){0.f, 0.f, 0.f, 0.f};
    bf16x8 ca0 = *(const bf16x8*)a0, ca1 = *(const bf16x8*)a1, cb[8];
#pragma unroll
    for (int nt = 0; nt < 8; ++nt) cb[nt] = *(const bf16x8*)(b0 + (size_t)(16 * nt) * K);
    for (int ks = 0; ks < nks; ++ks) {
        bf16x8 na0 = ca0, na1 = ca1, nb[8];
#pragma unroll
        for (int nt = 0; nt < 8; ++nt) nb[nt] = cb[nt];
        if (ks + 1 < nks) { const int ko = 32 * (ks + 1); na0 = *(const bf16x8*)(a0 + ko); na1 = *(const bf16x8*)(a1 + ko);
#pragma unroll
            for (int nt = 0; nt < 8; ++nt) nb[nt] = *(const bf16x8*)(b0 + (size_t)(16 * nt) * K + ko); }
#pragma unroll
        for (int nt = 0; nt < 8; ++nt) { acc[0][nt] = __builtin_amdgcn_mfma_f32_16x16x32_bf16(cb[nt], ca0, acc[0][nt], 0, 0, 0); acc[1][nt] = __builtin_amdgcn_mfma_f32_16x16x32_bf16(cb[nt], ca1, acc[1][nt], 0, 0, 0); }
        ca0 = na0; ca1 = na1;
#pragma unroll
        for (int nt = 0; nt < 8; ++nt) cb[nt] = nb[nt];
    }
#pragma unroll
    for (int i = 0; i < 2; ++i)
#pragma unroll
        for (int nt = 0; nt < 8; ++nt) part[((w * 2 + i) * 8 + nt) * 64 + lane] = acc[i][nt];
    __syncthreads();
    f32x4 f0 = {0.f, 0.f, 0.f, 0.f}, f1 = f0;
#pragma unroll
    for (int k = 0; k < 8; ++k) { f0 += part[((k * 2 + 0) * 8 + w) * 64 + lane]; f1 += part[((k * 2 + 1) * 8 + w) * 64 + lane]; }
    float s0 = quad(row0 + l15, 128 * ct + 16 * w + 4 * g, f0), s1 = quad(row0 + 16 + l15, 128 * ct + 16 * w + 4 * g, f1);
    s0 += __shfl_xor(s0, 16); s0 += __shfl_xor(s0, 32); s1 += __shfl_xor(s1, 16); s1 += __shfl_xor(s1, 32);
    if (g == 0) { rsum[w * 32 + l15] = s0; rsum[w * 32 + 16 + l15] = s1; }
    __syncthreads();
    if (tid < 32) { float s = 0.f;
#pragma unroll
        for (int k = 0; k < 8; ++k) s += rsum[k * 32 + tid];
        rsq[(size_t)(row0 + tid) * 16 + ct] = s; rsq[(size_t)(row0 + tid) * 16 + 8 + ct] = 0.f; }
    __syncthreads();
}
struct QuadOut {
    const float* xp; const float* xs; const float* meta; bf16_t* X2B;
    __device__ __forceinline__ float operator()(int row, int col, f32x4 acc) const {
        const f32x4 v = acc + *(const f32x4*)(x_src_row(xp, xs, meta, row) + col);
        u32x2 wv; wv.x = cvt_pk_bf16(v[0], v[1]); wv.y = cvt_pk_bf16(v[2], v[3]);
        *(u32x2*)(X2B + (size_t)row * DM + col) = wv;
        return (v[0] * v[0] + v[1] * v[1]) + (v[2] * v[2] + v[3] * v[3]);
    }
};
struct QuadDown {
    const bf16_t* X2B; float* out;
    __device__ __forceinline__ float operator()(int row, int col, f32x4 acc) const {
        const u32x2 xb = *(const u32x2*)(X2B + (size_t)row * DM + col);
        const f32x4 v = acc + (f32x4){bflo(xb.x), bfhi(xb.x), bflo(xb.y), bfhi(xb.y)};
        float* yr = row < MPROMPT ? out + O_YP + ((size_t)7 * 2048 + (row - 7 * LP - 16)) * DM + col : out + O_YS + (size_t)(row - MPROMPT) * DM + col;
        *(f32x4*)yr = v;
        return (v[0] * v[0] + v[1] * v[1]) + (v[2] * v[2] + v[3] * v[3]);
    }
};

__device__ __forceinline__ void p0_transpose_item(const float* W, int ldw, int K, bf16_t* WT, int n0, int srcn0, int k0, const float* kscale, LAS float* scr, int lane) {
    float tv[32];
#pragma unroll
    for (int i = 0; i < 32; ++i) tv[i] = W[(size_t)(k0 + 2 * i + (lane >> 5)) * ldw + srcn0 + (lane & 31)];
#pragma unroll
    for (int i = 0; i < 32; ++i) { const int kk = 2 * i + (lane >> 5); float v = tv[i]; if (kscale) v *= kscale[k0 + kk]; scr[kk * 33 + (lane & 31)] = v; }
    LDS_WAIT(); asm volatile("" ::: "memory");
    const int c = lane & 7;
#pragma unroll
    for (int j = 0; j < 4; ++j) { const int n = (lane >> 3) + 8 * j; const LAS float* s = scr + (8 * c) * 33 + n;
        u32x4 o; o.x = cvt_pk_bf16(s[0 * 33], s[1 * 33]); o.y = cvt_pk_bf16(s[2 * 33], s[3 * 33]); o.z = cvt_pk_bf16(s[4 * 33], s[5 * 33]); o.w = cvt_pk_bf16(s[6 * 33], s[7 * 33]);
        *(u32x4*)(WT + (size_t)(n0 + n) * K + k0 + 8 * c) = o; }
    LDS_WAIT(); asm volatile("" ::: "memory");
}
__device__ __forceinline__ int in_colmap(int n0) {
    const int pn = n0 >> 8;
    if (pn >= 4) return n0;
    const int c = n0 & 255, bj = c >> 7, cc = c & 127, hl = cc >> 6, j = cc & 63;
    return (pn >= 2 ? 512 : 0) + ((pn & 1) * 2 + hl) * 128 + bj * 64 + j;
}
__device__ __forceinline__ void p0_prologue(Frame& F) {
    const float* w_in = F.in[8]; const float* w_out = F.in[14]; const float* w_up = F.in[16]; const float* w_dn = F.in[18];
    bf16_t* WIN = (bf16_t*)(F.ws + WS_WIN); bf16_t* WOUT = (bf16_t*)(F.ws + WS_WOUT); bf16_t* WUP = (bf16_t*)(F.ws + WS_WUP); bf16_t* WDN = (bf16_t*)(F.ws + WS_WDN);
    LAS float* scr = (LAS float*)(F.lds + F.wave * 8448);
    LAS float* WX = (LAS float*)(F.lds + 69632);
    for (int i = F.tid; i < 1024 * 8; i += 512) WX[i] = w_in[(size_t)(i >> 3) * INW + NIN + (i & 7)];
    const int gw = F.blk * 8 + F.wave, NGW = F.G * 8;
    constexpr int I_IN = 16 * 128, I_OUT = 16 * 32, I_UP = 16 * 176, I_DN = 44 * 32, NIT = I_IN + I_OUT + I_UP + I_DN;
    for (int it = gw; it < NIT; it += NGW) {
        int r = it;
        if (r < I_IN) { const int kb = r / 128, nb = r % 128; p0_transpose_item(w_in, INW, 1024, WIN, nb * 32, in_colmap(nb * 32), kb * 64, nullptr, scr, F.lane); continue; } r -= I_IN;
        if (r < I_OUT) { const int kb = r / 32, nb = r % 32; p0_transpose_item(w_out, 1024, 1024, WOUT, nb * 32, nb * 32, kb * 64, nullptr, scr, F.lane); continue; } r -= I_OUT;
        if (r < I_UP) { const int kb = r / 176, nb = r % 176; const int n0 = nb * 32, pn = n0 >> 8, c = n0 & 255; p0_transpose_item(w_up, NUP, 1024, WUP, n0, (c >> 7) * DFF + pn * 128 + (c & 127), kb * 64, F.in[15], scr, F.lane); continue; } r -= I_UP;
        { const int kb = r / 32, nb = r % 32; p0_transpose_item(w_dn, 1024, DFF, WDN, nb * 32, nb * 32, kb * 64, nullptr, scr, F.lane); }
    }
    __syncthreads();
    bf16_t* H = (bf16_t*)(F.ws + WS_H); float* BG = (float*)(F.ws + WS_BG);
    const float* nm = F.in[7];
    f32x4 nmv[4], vn[4];
#pragma unroll
    for (int j = 0; j < 4; ++j) { nmv[j] = ((const f32x4*)nm)[F.lane + 64 * j]; vn[j] = (f32x4){0.f, 0.f, 0.f, 0.f}; }
    if (gw < MREAL) {
        const f32x4* xr0 = (const f32x4*)x_src_row(F.in[0], F.in[1], F.in[6], gw) + F.lane;
#pragma unroll
        for (int j = 0; j < 4; ++j) vn[j] = xr0[64 * j];
    }
    for (int g = gw; g < MPAD; g += NGW) {
        unsigned long long* o8 = (unsigned long long*)(H + (size_t)g * DM) + F.lane;
        f32x4 v[4];
#pragma unroll
        for (int j = 0; j < 4; ++j) v[j] = vn[j];
        if (g + NGW < MREAL) {
            const f32x4* xr1 = (const f32x4*)x_src_row(F.in[0], F.in[1], F.in[6], g + NGW) + F.lane;
#pragma unroll
            for (int j = 0; j < 4; ++j) vn[j] = xr1[64 * j];
        }
        if (g >= MREAL) {
#pragma unroll
            for (int j = 0; j < 4; ++j) o8[64 * j] = 0ull;
            continue;
        }
        float ss = 0.f;
#pragma unroll
        for (int j = 0; j < 4; ++j) ss += (v[j][0] * v[j][0] + v[j][1] * v[j][1]) + (v[j][2] * v[j][2] + v[j][3] * v[j][3]);
        const float rstd = rsqrtf(wave_sum(ss) * (1.0f / DM) + EPS);
        float ex[8];
#pragma unroll
        for (int e = 0; e < 8; ++e) ex[e] = 0.f;
#pragma unroll
        for (int j = 0; j < 4; ++j) {
            v[j] = v[j] * rstd * nmv[j];
            o8[64 * j] = (unsigned long long)cvt_pk_bf16(v[j][0], v[j][1]) | ((unsigned long long)cvt_pk_bf16(v[j][2], v[j][3]) << 32);
#pragma unroll
            for (int i = 0; i < 4; ++i) {
                const int k = 4 * (F.lane + 64 * j) + i;
                const f32x4 wa = *(const LAS f32x4*)(WX + k * 8), wb = *(const LAS f32x4*)(WX + k * 8 + 4);
                ex[0] += v[j][i] * wa[0]; ex[1] += v[j][i] * wa[1]; ex[2] += v[j][i] * wa[2]; ex[3] += v[j][i] * wa[3];
                ex[4] += v[j][i] * wb[0]; ex[5] += v[j][i] * wb[1]; ex[6] += v[j][i] * wb[2]; ex[7] += v[j][i] * wb[3];
            }
        }
#pragma unroll
        for (int e = 0; e < 8; ++e) ex[e] = wave_sum(ex[e]);
        if (F.lane < 4) {
            const int h = F.lane;
            const float gb = h == 0 ? ex[0] : h == 1 ? ex[1] : h == 2 ? ex[2] : ex[3];
            const float ga = h == 0 ? ex[4] : h == 1 ? ex[5] : h == 2 ? ex[6] : ex[7];
            const float beta = 1.0f / (1.0f + __expf(-gb));
            const float xx = ga + F.in[11][h];
            const float sp = xx > 20.f ? xx : log1pf(__expf(xx));
            BG[(size_t)g * 8 + h] = beta;
            BG[(size_t)g * 8 + 4 + h] = -__expf(F.in[10][h]) * sp;
        }
    }
    {
        bf16_t* PGX = (bf16_t*)(F.ws + WS_PGX); const float* stq = F.in[4];
        for (int e = F.blk * 512 + F.tid; e < 385 * GQKV; e += F.G * 512) PGX[e] = e < 384 * GQKV ? (bf16_t)(cvt_pk_bf16(stq[e], 0.f) & 0xffffu) : (bf16_t)0;
    }
    float* ROT = (float*)(F.ws + WS_ROT);
    for (int e = F.blk * 512 + F.tid; e < 2068 * 64; e += F.G * 512) {
        const int p = e >> 6, j = e & 63; const int pos = p < LP ? p : 16384 + (p - LP);
        double f = 1.0, b = 0.8659643233600653523531691834202299819398;
#pragma unroll
        for (int k = 0; k < 6; ++k) { if ((j >> k) & 1) f *= b; b *= b; }
        double rev = (double)pos * f * 0.15915494309189533576888376337251436203445964574046;
        rev -= floor(rev);
        const float rf = (float)rev;
        ROT[(size_t)e * 2] = __builtin_amdgcn_cosf(rf); ROT[(size_t)e * 2 + 1] = __builtin_amdgcn_sinf(rf);
    }
}

struct SeqD { int row0, len, samp, idx; };
__device__ __forceinline__ bf16x8 mk8(s16x4 lo, s16x4 hi) { return (bf16x8){lo[0], lo[1], lo[2], lo[3], hi[0], hi[1], hi[2], hi[3]}; }
__device__ __forceinline__ s16x4 ld_tr(LAS unsigned char* p) { return __builtin_bit_cast(s16x4, __builtin_amdgcn_ds_read_tr16_b64_v4i16((LAS s16x4*)p)); }
__device__ __forceinline__ s16x4 ld_b64(LAS unsigned char* p) { return *(LAS s16x4*)p; }
__device__ __forceinline__ s16x4 pk4(f32x4 v) { u32x2 w; w.x = cvt_pk_bf16(v[0], v[1]); w.y = cvt_pk_bf16(v[2], v[3]); return __builtin_bit_cast(s16x4, w); }

__device__ __forceinline__ void st_wt16(const void* base, unsigned off, u32x4 v) { asm volatile("s_nop 4\n\tglobal_store_dwordx4 %0, %1, %2 sc1\n\ts_nop 1" :: "v"(off), "v"(v), "s"(base) : "memory"); }
__device__ __forceinline__ void st_wt4(const void* base, unsigned off, unsigned v) { asm volatile("s_nop 4\n\tglobal_store_dword %0, %1, %2 sc1" :: "v"(off), "v"(v), "s"(base) : "memory"); }
__device__ __forceinline__ void st_wt2(const void* base, unsigned off, unsigned v) { asm volatile("s_nop 4\n\tglobal_store_short %0, %1, %2 sc1" :: "v"(off), "v"(v), "s"(base) : "memory"); }
__device__ __forceinline__ void chunk_publish(unsigned* flag) {
    asm volatile("s_waitcnt vmcnt(0)" ::: "memory");
    __syncthreads();
    if (threadIdx.x == 0) __hip_atomic_store(flag, 1u, __ATOMIC_RELAXED, __HIP_MEMORY_SCOPE_AGENT);
}
__device__ __forceinline__ void chunk_wait(const unsigned* flag) {
    unsigned sp = 0;
    while (__builtin_amdgcn_readfirstlane(__hip_atomic_load(flag, __ATOMIC_RELAXED, __HIP_MEMORY_SCOPE_AGENT)) == 0u) { __builtin_amdgcn_s_sleep(2); if (++sp > (1u << 22)) break; }
    __builtin_amdgcn_fence(__ATOMIC_ACQUIRE, "agent");
    asm volatile("s_waitcnt vmcnt(0)" ::: "memory");
}
__device__ __forceinline__ int qk_pos(int i, int j) { const int p = (j & ~12) | ((j & 4) << 1) | ((j & 8) >> 1); return (((p >> 3) ^ ((i >> 1) & 7)) << 3) | (p & 7); }
__device__ __forceinline__ void p2a_item(Frame& F, const SeqD sq, int h, int t0, int c, unsigned char* slot) {
    unsigned lbase = (unsigned)(uintptr_t)F.lds; int tid = F.tid;
    asm volatile("" : "+s"(lbase), "+v"(tid));
    const unsigned ta0 = MK_TPROBE ? (unsigned)__builtin_amdgcn_s_memrealtime() : 0u;
    LAS unsigned char* L = (LAS unsigned char*)(uintptr_t)lbase;
    LAS float* AM = (LAS float*)(L); LAS float* RHS = (LAS float*)(L + 53248);
    LAS float* GL = (LAS float*)(L + 16384); LAS float* CUM = GL + 64; LAS float* BETA = GL + 128;
    LAS unsigned char* QB = L + 20480; LAS unsigned char* KB = L + 36864;
    const float* BG = (const float*)(F.ws + WS_BG);
    const float* cgw = F.in[9];
    const unsigned char* slotu = (const unsigned char*)(((unsigned long long)(unsigned)__builtin_amdgcn_readfirstlane((unsigned)((unsigned long long)slot >> 32)) << 32) | (unsigned long long)(unsigned)__builtin_amdgcn_readfirstlane((unsigned)(unsigned long long)slot));
    const int r = tid >> 3, cg = tid & 7, lane = tid & 63, w = __builtin_amdgcn_readfirstlane(tid >> 6), fr = lane & 15, fg = lane >> 4;
    const bool valid = r < c;
    const int grow = sq.row0 + t0 + r;
    float beta_r = 0.f, gdec = 0.f;
    if (valid) { beta_r = BG[(size_t)grow * 8 + h]; gdec = BG[(size_t)grow * 8 + 4 + h]; }
    if (cg == 0) GL[r] = gdec;
    LAS float* CW = (LAS float*)(L + 118784);
#pragma unroll
    for (int k = 0; k < 3; ++k) { const int e = tid + 512 * k, dt = e / 384, rem = e - dt * 384; CW[e] = cgw[(size_t)dt * GQKV + (rem >> 7) * 512 + h * 128 + (rem & 127)]; }
#define P2A_LOAD(dst, XX) do { _Pragma("unroll") for (int dt = 0; dt < 4; ++dt) { \
        const int colb_ = (XX) * 512 + h * 128 + 16 * cg, tt = t0 + r - 3 + dt; \
        const unsigned oz = (unsigned)(WS_PGX + ((size_t)384 * GQKV + colb_) * 2); \
        const unsigned opg = (unsigned)(WS_PG + ((size_t)(sq.row0 + (tt >= 0 ? tt : 0)) * 2048 + colb_) * 2); \
        const unsigned opx = (unsigned)(WS_PGX + ((size_t)(sq.idx * 3 + (tt < 0 ? 3 + tt : 0)) * GQKV + colb_) * 2); \
        const unsigned so = valid ? (tt >= 0 ? opg : (sq.samp ? opx : oz)) : oz; \
        const u32x4* sp = (const u32x4*)(F.ws + so); dst[2 * dt] = sp[0]; dst[2 * dt + 1] = sp[1]; } } while (0)
    u32x4 dcur[8], dnxt[8];
    P2A_LOAD(dcur, 0);
    __syncthreads();
    const unsigned ta1 = MK_TPROBE ? (unsigned)__builtin_amdgcn_s_memrealtime() : 0u;
    float cum = 0.f, cl = 0.f;
#pragma unroll 8
    for (int j = 0; j < 64; ++j) { const float gj = GL[j]; cl += gj; if (j <= r) cum += gj; }
    const float er = __expf(cum), frr = __expf(cl - cum);
    if (cg == 0) { CUM[r] = cum; BETA[r] = beta_r; }
    if (tid == 0) st_wt4(slotu, 73728u, __float_as_uint(__expf(cl)));
#pragma unroll 1
    for (int X = 0; X < 3; ++X) {
        if (X < 2) P2A_LOAD(dnxt, X + 1);
        float y[16];
#pragma unroll
        for (int i = 0; i < 16; ++i) y[i] = 0.f;
#pragma unroll
        for (int dt = 0; dt < 4; ++dt) {
            const u32x4 a = dcur[2 * dt], b = dcur[2 * dt + 1];
            const float xv[16] = {bflo(a.x), bfhi(a.x), bflo(a.y), bfhi(a.y), bflo(a.z), bfhi(a.z), bflo(a.w), bfhi(a.w), bflo(b.x), bfhi(b.x), bflo(b.y), bfhi(b.y), bflo(b.z), bfhi(b.z), bflo(b.w), bfhi(b.w)};
            const LAS f32x4* wp = (const LAS f32x4*)(CW + dt * 384 + X * 128 + 16 * cg);
#pragma unroll
            for (int k = 0; k < 4; ++k) { const f32x4 wv = wp[k]; y[4 * k] += wv[0] * xv[4 * k]; y[4 * k + 1] += wv[1] * xv[4 * k + 1]; y[4 * k + 2] += wv[2] * xv[4 * k + 2]; y[4 * k + 3] += wv[3] * xv[4 * k + 3]; }
        }
#pragma unroll
        for (int k = 0; k < 8; ++k) dcur[k] = dnxt[k];
        float ss = 0.f;
#pragma unroll
        for (int i = 0; i < 16; ++i) { y[i] = valid ? silu_f(y[i]) : 0.f; ss += y[i] * y[i]; }
        ss += __shfl_xor(ss, 1); ss += __shfl_xor(ss, 2); ss += __shfl_xor(ss, 4);
        const float nrm = X == 0 ? rsqrtf(ss + EPS) * 0.08838834764831845f : (X == 1 ? rsqrtf(ss + EPS) : 1.0f);
        u32x4 p0, p1;
        p0.x = cvt_pk_bf16(y[0] * nrm, y[1] * nrm); p0.y = cvt_pk_bf16(y[2] * nrm, y[3] * nrm); p0.z = cvt_pk_bf16(y[4] * nrm, y[5] * nrm); p0.w = cvt_pk_bf16(y[6] * nrm, y[7] * nrm);
        p1.x = cvt_pk_bf16(y[8] * nrm, y[9] * nrm); p1.y = cvt_pk_bf16(y[10] * nrm, y[11] * nrm); p1.z = cvt_pk_bf16(y[12] * nrm, y[13] * nrm); p1.w = cvt_pk_bf16(y[14] * nrm, y[15] * nrm);
        const float z[16] = {bflo(p0.x), bfhi(p0.x), bflo(p0.y), bfhi(p0.y), bflo(p0.z), bfhi(p0.z), bflo(p0.w), bfhi(p0.w), bflo(p1.x), bfhi(p1.x), bflo(p1.y), bfhi(p1.y), bflo(p1.z), bfhi(p1.z), bflo(p1.w), bfhi(p1.w)};
        if (X < 2) {
            LAS unsigned char* dstl = (X == 0 ? QB : KB) + r * 256;
            *(LAS u32x4*)(dstl + (((2 * cg) ^ (r & 15)) * 16)) = p0; *(LAS u32x4*)(dstl + (((2 * cg + 1) ^ (r & 15)) * 16)) = p1;
            const float sc = X == 0 ? er : frr;
            u32x4 d0, d1;
            d0.x = cvt_pk_bf16(z[0] * sc, z[1] * sc); d0.y = cvt_pk_bf16(z[2] * sc, z[3] * sc); d0.z = cvt_pk_bf16(z[4] * sc, z[5] * sc); d0.w = cvt_pk_bf16(z[6] * sc, z[7] * sc);
            d1.x = cvt_pk_bf16(z[8] * sc, z[9] * sc); d1.y = cvt_pk_bf16(z[10] * sc, z[11] * sc); d1.z = cvt_pk_bf16(z[12] * sc, z[13] * sc); d1.w = cvt_pk_bf16(z[14] * sc, z[15] * sc);
            if (X == 0) { const u32x4 e0 = {d0.x, d0.y, d1.x, d1.y}, e1 = {d0.z, d0.w, d1.z, d1.w};
                st_wt16(slotu, 16384 + r * 256 + (((2 * cg) ^ (r & 15)) * 16), e0); st_wt16(slotu, 16384 + r * 256 + (((2 * cg + 1) ^ (r & 15)) * 16), e1); }
            else { const unsigned gd = 32768 + r * 256 + (((cg >> 1) ^ (r & 3)) * 64) + (cg & 1) * 32; st_wt16(slotu, gd, d0); st_wt16(slotu, gd + 16, d1); }
        }
        if (X >= 1) {
            const float sc = X == 1 ? beta_r * er : beta_r;
            LAS float* rd = RHS + r * 256 + (X == 1 ? 128 : 0) + 16 * cg;
#pragma unroll
            for (int k = 0; k < 4; ++k) *(LAS f32x4*)(rd + 4 * k) = (f32x4){z[4 * k] * sc, z[4 * k + 1] * sc, z[4 * k + 2] * sc, z[4 * k + 3] * sc};
        }
        __builtin_amdgcn_sched_barrier(0);
    }
    __syncthreads();
    const unsigned ta2 = MK_TPROBE ? (unsigned)__builtin_amdgcn_s_memrealtime() : 0u;
    {
#pragma unroll
        for (int rep = 0; rep < 2; ++rep) {
            const int idx = w + 8 * rep, it = idx >> 2, jt = idx & 3;
            const int jcol = 16 * jt + fr;
            if (it >= jt) {
                f32x4 akk = {0.f, 0.f, 0.f, 0.f}, aqk = {0.f, 0.f, 0.f, 0.f};
#pragma unroll
                for (int s = 0; s < 4; ++s) {
                    const int ri = 16 * it + fr, rj = 16 * jt + fr;
                    const bf16x8 bk = *(LAS bf16x8*)(KB + rj * 256 + (((4 * s + fg) ^ (rj & 15)) * 16));
                    const bf16x8 ak = *(LAS bf16x8*)(KB + ri * 256 + (((4 * s + fg) ^ (ri & 15)) * 16));
                    const bf16x8 aq = *(LAS bf16x8*)(QB + ri * 256 + (((4 * s + fg) ^ (ri & 15)) * 16));
                    akk = __builtin_amdgcn_mfma_f32_16x16x32_bf16(ak, bk, akk, 0, 0, 0);
                    aqk = __builtin_amdgcn_mfma_f32_16x16x32_bf16(aq, bk, aqk, 0, 0, 0);
                }
                const float cj = CUM[jcol];
#pragma unroll
                for (int rr = 0; rr < 4; ++rr) {
                    const int i_ = 16 * it + 4 * fg + rr;
                    const float dec = i_ >= jcol ? __expf(CUM[i_] - cj) : 0.f;
                    AM[i_ * 64 + jcol] = i_ > jcol ? BETA[i_] * akk[rr] * dec : 0.f;
                    st_wt2(slotu, 49152u + (unsigned)(i_ * 64 + qk_pos(i_, jcol)) * 2u, cvt_pk_bf16(aqk[rr] * dec, 0.f));
                }
            } else {
#pragma unroll
                for (int rr = 0; rr < 4; ++rr) { const int i_ = 16 * it + 4 * fg + rr; st_wt2(slotu, 49152u + (unsigned)(i_ * 64 + qk_pos(i_, jcol)) * 2u, 0u); }
            }
        }
    }
    __syncthreads();
    const unsigned ta3 = MK_TPROBE ? (unsigned)__builtin_amdgcn_s_memrealtime() : 0u;
    {
        const int col = tid >> 1, hh = tid & 1;
        LAS float* xc = RHS + col;
        const LAS float* ab = AM + 4 * hh;
#pragma unroll 1
        for (int ib = 0; ib < 16; ++ib) {
            float acc[4] = {0.f, 0.f, 0.f, 0.f};
            const int nq = (ib + 1) >> 1;
#pragma unroll 2
            for (int q = 0; q < nq; ++q) {
                const float x0 = xc[(8 * q + 4 * hh) * 256], x1 = xc[(8 * q + 4 * hh + 1) * 256], x2 = xc[(8 * q + 4 * hh + 2) * 256], x3 = xc[(8 * q + 4 * hh + 3) * 256];
                const bool mine = (hh == 0) || (2 * q + 1 < ib);
#pragma unroll
                for (int rr = 0; rr < 4; ++rr) { const f32x4 av = *(const LAS f32x4*)(ab + (4 * ib + rr) * 64 + 8 * q);
                    const float t_ = av[0] * x0 + av[1] * x1 + av[2] * x2 + av[3] * x3; acc[rr] += mine ? t_ : 0.f; }
            }
#pragma unroll
            for (int rr = 0; rr < 4; ++rr) acc[rr] += __int_as_float(__builtin_amdgcn_update_dpp(0, __float_as_int(acc[rr]), 0xB1, 0xf, 0xf, true));
            const f32x4 d1 = *(const LAS f32x4*)(AM + (4 * ib + 1) * 64 + 4 * ib), d2 = *(const LAS f32x4*)(AM + (4 * ib + 2) * 64 + 4 * ib), d3 = *(const LAS f32x4*)(AM + (4 * ib + 3) * 64 + 4 * ib);
            float vv[4];
            vv[0] = xc[(4 * ib) * 256] - acc[0];
            vv[1] = xc[(4 * ib + 1) * 256] - acc[1] - d1[0] * vv[0];
            vv[2] = xc[(4 * ib + 2) * 256] - acc[2] - d2[0] * vv[0] - d2[1] * vv[1];
            vv[3] = xc[(4 * ib + 3) * 256] - acc[3] - d3[0] * vv[0] - d3[1] * vv[1] - d3[2] * vv[2];
            if (hh == 0) {
#pragma unroll
                for (int rr = 0; rr < 4; ++rr) xc[(4 * ib + rr) * 256] = vv[rr];
            }
        }
        const unsigned rowp = col < 128 ? 57344u + col * 128 : (unsigned)(col - 128) * 128;
        const int wsw = col < 128 ? 0 : (((col - 128) >> 1) & 1);
#pragma unroll
        for (int k = 0; k < 4; ++k) {
            float xv[8];
#pragma unroll
            for (int e = 0; e < 8; ++e) xv[e] = xc[(32 * hh + 8 * k + e) * 256];
            u32x4 o; o.x = cvt_pk_bf16(xv[0], xv[1]); o.y = cvt_pk_bf16(xv[2], xv[3]); o.z = cvt_pk_bf16(xv[4], xv[5]); o.w = cvt_pk_bf16(xv[6], xv[7]);
            st_wt16(slotu, rowp + ((hh ^ wsw) * 64) + k * 16, o);
        }
    }
    __syncthreads();
    if (MK_TPROBE) { const unsigned ta4 = (unsigned)__builtin_amdgcn_s_memrealtime(); if (tid == 0) { unsigned* TS = (unsigned*)(F.ws + WS_CTL) + CW_TS; TS[26 * 256 + F.blk] += ta1 - ta0; TS[27 * 256 + F.blk] += ta2 - ta1; TS[28 * 256 + F.blk] += ta3 - ta2; TS[34 * 256 + F.blk] += ta4 - ta3; } }
}

typedef float f32x16 __attribute__((ext_vector_type(16)));
constexpr int SC_IMG = 57344, SC_OS = 114688, SC_OSB = 17408, OST_PITCH = 136;
__device__ __forceinline__ void glds16(const void* gsrc, unsigned lds_dst) { unsigned keep; lds_dst = __builtin_amdgcn_readfirstlane(lds_dst);
    asm volatile("s_mov_b32 %0, m0\n\ts_mov_b32 m0, %2\n\ts_nop 0\n\tglobal_load_lds_dwordx4 %1, off\n\ts_mov_b32 m0, %0" : "=&s"(keep) : "v"(gsrc), "s"(lds_dst) : "memory"); }
__device__ __forceinline__ f32x16 mfma32(bf16x8 a, bf16x8 b, f32x16 c) { return __builtin_amdgcn_mfma_f32_32x32x16_bf16(a, b, c, 0, 0, 0); }
__device__ __forceinline__ bf16x8 pk8(const f32x16& v, int s) {
    u32x4 w; w.x = cvt_pk_bf16(v[8 * s], v[8 * s + 1]); w.y = cvt_pk_bf16(v[8 * s + 2], v[8 * s + 3]); w.z = cvt_pk_bf16(v[8 * s + 4], v[8 * s + 5]); w.w = cvt_pk_bf16(v[8 * s + 6], v[8 * s + 7]);
    return __builtin_bit_cast(bf16x8, w);
}
template <int MODE  >
__device__ __forceinline__ void scan_finish(LAS unsigned char* OSb, int hw, int lane, int h, int grow0, int c, const float* nw, const u32x4 (&gpre)[4], bf16_t* mix) {
    const int i16 = lane & 15, g = lane >> 4, tok = 16 * hw + i16;
    float v[32];
#pragma unroll
    for (int k = 0; k < 8; ++k) {
        const s16x4 t4 = ld_tr(OSb + (32 * g + 4 * k + (i16 >> 2)) * OST_PITCH + (16 * hw + 4 * (i16 & 3)) * 2);
        const u32x2 t2 = __builtin_bit_cast(u32x2, t4);
        v[4 * k] = bflo(t2.x); v[4 * k + 1] = bfhi(t2.x); v[4 * k + 2] = bflo(t2.y); v[4 * k + 3] = bfhi(t2.y);
    }
    float rstd;
    if (MODE == 0) {
        float s = 0.f;
#pragma unroll
        for (int k = 0; k < 32; ++k) s += v[k];
        s += __shfl_xor(s, 16); s += __shfl_xor(s, 32);
        const float mu = s * (1.0f / 128.0f);
        float q = 0.f;
#pragma unroll
        for (int k = 0; k < 32; ++k) { v[k] -= mu; q += v[k] * v[k]; }
        q += __shfl_xor(q, 16); q += __shfl_xor(q, 32);
        rstd = rsqrtf(q * (1.0f / 128.0f) + EPS);
    } else {
        float q = 0.f;
#pragma unroll
        for (int k = 0; k < 32; ++k) q += v[k] * v[k];
        q += __shfl_xor(q, 16); q += __shfl_xor(q, 32);
        rstd = rsqrtf(q * (1.0f / 128.0f) + EPS);
    }
    if (tok < c) {
        const f32x4* np = (const f32x4*)(nw + (MODE == 0 ? h * 128 : 0) + 32 * g);
        u32x4* mp = (u32x4*)(mix + (size_t)(grow0 + tok) * DM + (MODE == 0 ? 0 : 512) + h * 128 + 32 * g);
#pragma unroll
        for (int k = 0; k < 4; ++k) {
            const u32x4 gv = gpre[k]; const f32x4 n0 = np[2 * k], n1 = np[2 * k + 1];
            u32x4 o;
            o.x = cvt_pk_bf16(v[8 * k] * rstd * n0[0] * bflo(gv.x), v[8 * k + 1] * rstd * n0[1] * bfhi(gv.x));
            o.y = cvt_pk_bf16(v[8 * k + 2] * rstd * n0[2] * bflo(gv.y), v[8 * k + 3] * rstd * n0[3] * bfhi(gv.y));
            o.z = cvt_pk_bf16(v[8 * k + 4] * rstd * n1[0] * bflo(gv.z), v[8 * k + 5] * rstd * n1[1] * bfhi(gv.z));
            o.w = cvt_pk_bf16(v[8 * k + 6] * rstd * n1[2] * bflo(gv.w), v[8 * k + 7] * rstd * n1[3] * bfhi(gv.w));
            mp[k] = o;
        }
    }
}

__device__ __forceinline__ void chunk_of(const SeqD& sq, int n, int& t0, int& c) { if (sq.samp) { t0 = 0; c = 4; } else if (n == 0) { t0 = 0; c = 16; } else { t0 = 16 + 64 * (n - 1); c = 64; } }
__device__ __forceinline__ void scan_gdn(Frame& F, const SeqD sq, int h, int nchunks, const unsigned char* slot0, const float* sinit, float* sfinal, const unsigned* flags  ) {
    unsigned lbase = (unsigned)(uintptr_t)F.lds; int tid = F.tid;
    asm volatile("" : "+s"(lbase), "+v"(tid));
    LAS unsigned char* L = (LAS unsigned char*)(uintptr_t)lbase;
    const int lane = tid & 63, w8 = __builtin_amdgcn_readfirstlane(tid >> 6), w = w8 & 3;
    const bool isM = w8 < 4;
    const bf16_t* PG = (const bf16_t*)(F.ws + WS_PG);
    bf16_t* mix = (bf16_t*)((unsigned char*)F.out + OS_MIX);
    const int r = lane & 31, hh = lane >> 5, i16 = lane & 15, g16 = lane >> 4;
    f32x16 S[4]; bf16x8 Sb[4][2];
    u32x2 ur[2][4]; float cdn = 1.0f;
#define GSET(k, v) do { ur[(k) >> 1][((k) & 1) * 2] = (u32x2){(v).x, (v).y}; ur[(k) >> 1][((k) & 1) * 2 + 1] = (u32x2){(v).z, (v).w}; } while (0)
    const int uoff = 57344 + ((32 * w + r) * 64 + 4 * hh) * 2;
    if (flags) chunk_wait(flags);
    if (isM) {
#pragma unroll
        for (int t = 0; t < 4; ++t)
#pragma unroll
            for (int e = 0; e < 16; ++e) S[t][e] = sinit ? sinit[(32 * t + (e & 3) + 8 * (e >> 2) + 4 * hh) * 128 + 32 * w + r] : 0.f;
#pragma unroll
        for (int t = 0; t < 4; ++t) { Sb[t][0] = pk8(S[t], 0); Sb[t][1] = pk8(S[t], 1); }
#pragma unroll
        for (int mt = 0; mt < 2; ++mt)
#pragma unroll
            for (int q = 0; q < 4; ++q) ur[mt][q] = *(const u32x2*)(slot0 + uoff + 64 * mt + 16 * q);
        cdn = *(const float*)(slot0 + 73728);
    } else {
#pragma unroll
        for (int k = 0; k < 14; ++k) { const int pc = w + 4 * k; glds16(slot0 + pc * 1024 + lane * 16, lbase + pc * 1024); }
        { int t0, c; chunk_of(sq, 0, t0, c); const int tok = 16 * w + (lane & 15);
          if (tok < c) { const u32x4* gp = (const u32x4*)(PG + (size_t)(sq.row0 + t0 + tok) * 2048 + 1536 + h * 128 + 32 * (lane >> 4));
#pragma unroll
              for (int k = 0; k < 4; ++k) { const u32x4 gv = gp[k]; GSET(k, gv); } } }
        asm volatile("s_waitcnt vmcnt(0)" ::: "memory");
    }
    __syncthreads();
    unsigned accA = 0, accB = 0;
    for (int n = 0; n <= nchunks; ++n) {
        LAS unsigned char* Bc = L + (n & 1) * SC_IMG; LAS unsigned char* Bn = L + ((n & 1) ^ 1) * SC_IMG;
        LAS unsigned char* OSc = L + SC_OS + (n & 1) * SC_OSB; LAS unsigned char* OSp = L + SC_OS + ((n & 1) ^ 1) * SC_OSB;
        const unsigned char* img = slot0 + (size_t)n * SLOT;
        const unsigned tq0 = MK_TPROBE ? (unsigned)__builtin_amdgcn_s_memrealtime() : 0u;
        if (isM) {
            if (n < nchunks) {
                int lane_ = lane; asm volatile("" : "+v"(lane_));
                const int r_ = lane_ & 31, hh_ = lane_ >> 5, i16_ = lane_ & 15, gb_ = (lane_ >> 4) & 1;
                const float cd = cdn;
                u32x2 uc[2][4];
#pragma unroll
                for (int mt = 0; mt < 2; ++mt)
#pragma unroll
                    for (int q = 0; q < 4; ++q) uc[mt][q] = ur[mt][q];
                if (n + 1 < nchunks) {
                    if (flags) chunk_wait(flags + (size_t)(n + 1) * 2048);
#pragma unroll
                    for (int mt = 0; mt < 2; ++mt)
#pragma unroll
                        for (int q = 0; q < 4; ++q) ur[mt][q] = *(const u32x2*)(img + SLOT + uoff + 64 * mt + 16 * q);
                    cdn = *(const float*)(img + SLOT + 73728);
                }
                const int trc = 32 * gb_ + 8 * (i16_ & 3);
                bf16x8 wb[2][2];
#pragma unroll
                for (int mt = 0; mt < 2; ++mt) {
                    f32x16 a;
#pragma unroll
                    for (int e = 0; e < 16; ++e) a[e] = 0.f;
#pragma unroll
                    for (int t = 0; t < 4; ++t)
#pragma unroll
                        for (int s = 0; s < 2; ++s) {
                            const int ra = 32 * t + 16 * s + 4 * hh_ + (i16_ >> 2), rb = ra + 8;
                            const s16x4 lo = ld_tr(Bc + ra * 128 + ((mt ^ ((ra >> 1) & 1)) * 64) + trc);
                            const s16x4 hi = ld_tr(Bc + rb * 128 + ((mt ^ ((rb >> 1) & 1)) * 64) + trc);
                            a = mfma32(mk8(lo, hi), Sb[t][s], a);
                        }
                    f32x16 wv;
#pragma unroll
                    for (int q = 0; q < 4; ++q) { wv[4 * q] = bflo(uc[mt][q].x) - a[4 * q]; wv[4 * q + 1] = bfhi(uc[mt][q].x) - a[4 * q + 1]; wv[4 * q + 2] = bflo(uc[mt][q].y) - a[4 * q + 2]; wv[4 * q + 3] = bfhi(uc[mt][q].y) - a[4 * q + 3]; }
                    wb[mt][0] = pk8(wv, 0); wb[mt][1] = pk8(wv, 1);
                }
#pragma unroll
                for (int mt = 0; mt < 2; ++mt) {
                    f32x16 a;
#pragma unroll
                    for (int e = 0; e < 16; ++e) a[e] = 0.f;
                    const int row = 32 * mt + r_;
#pragma unroll
                    for (int t = 0; t < 4; ++t)
#pragma unroll
                        for (int s = 0; s < 2; ++s) {
                            const bf16x8 af = *(LAS bf16x8*)(Bc + 16384 + row * 256 + (((2 * (2 * t + s) + hh_) ^ (row & 15)) * 16));
                            a = mfma32(af, Sb[t][s], a);
                        }
#pragma unroll
                    for (int m2 = 0; m2 <= mt; ++m2)
#pragma unroll
                        for (int s = 0; s < 2; ++s) {
                            const bf16x8 af = *(LAS bf16x8*)(Bc + 49152 + row * 128 + (((2 * (2 * m2 + s) + hh_) ^ ((row >> 1) & 7)) * 16));
                            a = mfma32(af, wb[m2][s], a);
                        }
#pragma unroll
                    for (int q = 0; q < 4; ++q) { u32x2 pkd; pkd.x = cvt_pk_bf16(a[4 * q], a[4 * q + 1]); pkd.y = cvt_pk_bf16(a[4 * q + 2], a[4 * q + 3]);
                        *(LAS u32x2*)(OSc + (32 * w + r_) * OST_PITCH + (32 * mt + 8 * q + 4 * hh_) * 2) = pkd; }
                }
#pragma unroll
                for (int t = 0; t < 4; ++t) {
                    f32x16 a = S[t] * cd;
#pragma unroll
                    for (int m2 = 0; m2 < 2; ++m2)
#pragma unroll
                        for (int s = 0; s < 2; ++s) {
                            const int ra = 32 * m2 + 16 * s + 4 * hh_ + (i16_ >> 2), rb = ra + 8;
                            const s16x4 lo = ld_tr(Bc + 32768 + ra * 256 + ((t ^ (ra & 3)) * 64) + trc);
                            const s16x4 hi = ld_tr(Bc + 32768 + rb * 256 + ((t ^ (rb & 3)) * 64) + trc);
                            a = mfma32(mk8(lo, hi), wb[m2][s], a);
                        }
                    S[t] = a;
                }
#pragma unroll
                for (int t = 0; t < 4; ++t) { Sb[t][0] = pk8(S[t], 0); Sb[t][1] = pk8(S[t], 1); }
            }
        } else {
            if (n + 1 < nchunks) {
                if (flags) chunk_wait(flags + (size_t)(n + 1) * 2048);
                const unsigned bn = lbase + ((n & 1) ^ 1) * SC_IMG;
#pragma unroll
                for (int k = 0; k < 14; ++k) { const int pc = w + 4 * k; glds16(img + SLOT + pc * 1024 + lane * 16, bn + pc * 1024); }
            }
            if (n >= 1) { int t0, c; chunk_of(sq, n - 1, t0, c);
                const u32x4 gpre[4] = {{ur[0][0].x, ur[0][0].y, ur[0][1].x, ur[0][1].y}, {ur[0][2].x, ur[0][2].y, ur[0][3].x, ur[0][3].y}, {ur[1][0].x, ur[1][0].y, ur[1][1].x, ur[1][1].y}, {ur[1][2].x, ur[1][2].y, ur[1][3].x, ur[1][3].y}};
                scan_finish<1>(OSp, w, lane, h, sq.row0 + t0, c, F.in[13], gpre, mix); }
            if (n < nchunks) { int t0, c; chunk_of(sq, n, t0, c); const int tok = 16 * w + (lane & 15);
                if (tok < c) { const u32x4* gp = (const u32x4*)(PG + (size_t)(sq.row0 + t0 + tok) * 2048 + 1536 + h * 128 + 32 * (lane >> 4));
#pragma unroll
                    for (int k = 0; k < 4; ++k) { const u32x4 gv = gp[k]; GSET(k, gv); } } }
            asm volatile("s_waitcnt vmcnt(0)" ::: "memory");
        }
        const unsigned tq1 = MK_TPROBE ? (unsigned)__builtin_amdgcn_s_memrealtime() : 0u;
        __syncthreads();
        const unsigned tq2 = MK_TPROBE ? (unsigned)__builtin_amdgcn_s_memrealtime() : 0u;
        accA += tq1 - tq0; accB += tq2 - tq1;
    }
    if (MK_TPROBE && nchunks > 1 && (tid == 0 || tid == 256)) { unsigned* TS = (unsigned*)(F.ws + WS_CTL) + CW_TS; const int o_ = tid ? 2 : 0; TS[(9 + o_) * 256 + F.blk] = accA; TS[(10 + o_) * 256 + F.blk] = accB; }
    if (isM) {
#pragma unroll
        for (int t = 0; t < 4; ++t)
#pragma unroll
            for (int e = 0; e < 16; ++e) sfinal[(32 * t + (e & 3) + 8 * (e >> 2) + 4 * hh) * 128 + 32 * w + r] = S[t][e];
    }
    __syncthreads();
}

#undef GSET
__device__ __forceinline__ void ret_prepass_item(Frame& F, const SeqD sq, int h, int t0, int c, unsigned char* pimg) {
    unsigned lbase = (unsigned)(uintptr_t)F.lds; int tid = F.tid;
    asm volatile("" : "+s"(lbase), "+v"(tid));
    LAS unsigned char* L = (LAS unsigned char*)(uintptr_t)lbase;
    const int lane = tid & 63, w = __builtin_amdgcn_readfirstlane(tid >> 6), fr = lane & 15, fg = lane >> 4;
    const bf16_t* PR = (const bf16_t*)(F.ws + WS_PR);
    const float lg = h == 0 ? -0.04580368961312479f : h == 1 ? -0.02272007650008353f : h == 2 ? -0.011315313227834146f : -0.005646563141142063f;
    const unsigned tp0 = MK_TPROBE ? (unsigned)__builtin_amdgcn_s_memrealtime() : 0u;
    {
        const int r = tid >> 3, part = tid & 7;
#pragma unroll
        for (int X = 0; X < 2; ++X) {
            u32x4 a = {0u, 0u, 0u, 0u}, b = a;
            if (r < c) { const u32x4* p = (const u32x4*)(PR + (size_t)(sq.row0 + t0 + r) * 2048 + X * 512 + h * 128 + 16 * part); a = p[0]; b = p[1]; }
            *(LAS u32x4*)(L + X * 16384 + r * 256 + (((2 * part) ^ (r & 15)) * 16)) = a; *(LAS u32x4*)(L + X * 16384 + r * 256 + (((2 * part + 1) ^ (r & 15)) * 16)) = b;
        }
    }
    __syncthreads();
    const unsigned tp1 = MK_TPROBE ? (unsigned)__builtin_amdgcn_s_memrealtime() : 0u;
    LAS bf16_t* P = (LAS bf16_t*)(L + 32768);
#pragma unroll
    for (int rep = 0; rep < 2; ++rep) {
        const int idx = w + 8 * rep, it = idx >> 2, jt = idx & 3, jcol = 16 * jt + fr;
        f32x4 a = {0.f, 0.f, 0.f, 0.f};
        if (it >= jt) {
#pragma unroll
            for (int s = 0; s < 4; ++s) {
                const bf16x8 aq = *(LAS bf16x8*)(L + (16 * it + fr) * 256 + (((4 * s + fg) ^ fr) * 16));
                const bf16x8 bk = *(LAS bf16x8*)(L + 16384 + (16 * jt + fr) * 256 + (((4 * s + fg) ^ fr) * 16));
                a = __builtin_amdgcn_mfma_f32_16x16x32_bf16(aq, bk, a, 0, 0, 0);
            }
        }
#pragma unroll
        for (int rr = 0; rr < 4; ++rr) {
            const int i_ = 16 * it + 4 * fg + rr;
            const float p = (it >= jt && i_ >= jcol) ? a[rr] * exp2f(lg * (float)(i_ - jcol)) : 0.f;
            P[i_ * 64 + ((((jcol >> 3) ^ ((i_ >> 1) & 7)) << 3) | (jcol & 7))] = (bf16_t)(cvt_pk_bf16(p, 0.f) & 0xffffu);
        }
    }
    __syncthreads();
    { const unsigned char* pu = (const unsigned char*)(((unsigned long long)(unsigned)__builtin_amdgcn_readfirstlane((unsigned)((unsigned long long)pimg >> 32)) << 32) | (unsigned long long)(unsigned)__builtin_amdgcn_readfirstlane((unsigned)(unsigned long long)pimg)); st_wt16(pu, (unsigned)tid * 16u, ((LAS u32x4*)(L + 32768))[tid]); }
    const unsigned tp2 = MK_TPROBE ? (unsigned)__builtin_amdgcn_s_memrealtime() : 0u;
    __syncthreads();
    const unsigned tp3 = MK_TPROBE ? (unsigned)__builtin_amdgcn_s_memrealtime() : 0u;
    (void)tp0; (void)tp1; (void)tp2; (void)tp3;
}

__device__ __forceinline__ void scan_ret(Frame& F, const SeqD sq, int h, int nchunks, const unsigned char* pimg0, float* sfinal, const unsigned* flags) {
    unsigned lbase = (unsigned)(uintptr_t)F.lds; int tid = F.tid;
    asm volatile("" : "+s"(lbase), "+v"(tid));
    LAS unsigned char* L = (LAS unsigned char*)(uintptr_t)lbase;
    const int lane = tid & 63, w8 = __builtin_amdgcn_readfirstlane(tid >> 6), w = w8 & 3;
    const bool isM = w8 < 4;
    const bf16_t* PR = (const bf16_t*)(F.ws + WS_PR);
    const unsigned char* zrow = F.ws + WS_PGX + (size_t)384 * GQKV * 2;
    bf16_t* mix = (bf16_t*)((unsigned char*)F.out + OS_MIX);
    const float lg = h == 0 ? -0.04580368961312479f : h == 1 ? -0.02272007650008353f : h == 2 ? -0.011315313227834146f : -0.005646563141142063f;
    const int r = lane & 31, hh = lane >> 5;
    f32x16 S[4]; bf16x8 Sb[4][2];
    u32x4 gpre[4] = {{0u, 0u, 0u, 0u}, {0u, 0u, 0u, 0u}, {0u, 0u, 0u, 0u}, {0u, 0u, 0u, 0u}};
#define RET_DMA(nn, dstbase) do { int t0_, c_; chunk_of(sq, (nn), t0_, c_); \
        _Pragma("unroll") for (int k = 0; k < 14; ++k) { const int pc = w + 4 * k; const unsigned char* src_; \
            if (pc < 48) { const int X = pc >> 4, prow = (pc & 15) * 4 + (lane >> 4), p = lane & 15; \
                const int lc = X == 0 ? (p ^ (prow & 15)) : ((((p >> 2) ^ (prow & 3)) << 2) | (p & 3)); \
                src_ = prow < c_ ? (const unsigned char*)(PR + (size_t)(sq.row0 + t0_ + prow) * 2048 + X * 512 + h * 128 + lc * 8) : zrow + p * 16; } \
            else src_ = pimg0 + (size_t)(nn) * 8192 + (pc - 48) * 1024 + lane * 16; \
            glds16(src_, (dstbase) + pc * 1024); } } while (0)
    if (isM) {
#pragma unroll
        for (int t = 0; t < 4; ++t)
#pragma unroll
            for (int e = 0; e < 16; ++e) S[t][e] = 0.f;
#pragma unroll
        for (int t = 0; t < 4; ++t) { Sb[t][0] = pk8(S[t], 0); Sb[t][1] = pk8(S[t], 1); }
    } else {
        if (flags) chunk_wait(flags);
        RET_DMA(0, lbase);
        { int t0, c; chunk_of(sq, 0, t0, c); const int tok = 16 * w + (lane & 15);
          if (tok < c) { const u32x4* gp = (const u32x4*)(PR + (size_t)(sq.row0 + t0 + tok) * 2048 + 1536 + h * 128 + 32 * (lane >> 4));
#pragma unroll
              for (int k = 0; k < 4; ++k) gpre[k] = gp[k]; } }
        asm volatile("s_waitcnt vmcnt(0)" ::: "memory");
    }
    __syncthreads();
    for (int n = 0; n <= nchunks; ++n) {
        LAS unsigned char* Bc = L + (n & 1) * SC_IMG;
        LAS unsigned char* OSc = L + SC_OS + (n & 1) * SC_OSB; LAS unsigned char* OSp = L + SC_OS + ((n & 1) ^ 1) * SC_OSB;
        if (isM) {
            if (n < nchunks) {
                int lane_ = lane; asm volatile("" : "+v"(lane_));
                const int r_ = lane_ & 31, hh_ = lane_ >> 5, i16_ = lane_ & 15, gb_ = (lane_ >> 4) & 1;
                int t0, c; chunk_of(sq, n, t0, c);
                const int trc = 32 * gb_ + 8 * (i16_ & 3);
                bf16x8 vf[4];
#pragma unroll
                for (int ks = 0; ks < 4; ++ks) {
                    const int ra = 16 * ks + 8 * hh_ + (i16_ >> 2), rb = ra + 4;
                    vf[ks] = mk8(ld_tr(Bc + 32768 + ra * 256 + ((w ^ (ra & 3)) * 64) + trc), ld_tr(Bc + 32768 + rb * 256 + ((w ^ (rb & 3)) * 64) + trc));
                }
#pragma unroll
                for (int mt = 0; mt < 2; ++mt) {
                    f32x16 a1, a2;
#pragma unroll
                    for (int e = 0; e < 16; ++e) { a1[e] = 0.f; a2[e] = 0.f; }
                    const int row = 32 * mt + r_;
#pragma unroll
                    for (int ks = 0; ks < 2 * mt + 2; ++ks) {
                        const bf16x8 ap = *(LAS bf16x8*)(Bc + 49152 + row * 128 + (((2 * ks + hh_) ^ ((row >> 1) & 7)) * 16));
                        a1 = mfma32(ap, vf[ks], a1);
                    }
#pragma unroll
                    for (int t = 0; t < 4; ++t)
#pragma unroll
                        for (int s = 0; s < 2; ++s) {
                            const int c0 = 4 * t + 2 * s;
                            const s16x4 lo = ld_b64(Bc + row * 256 + ((c0 ^ (row & 15)) * 16) + 8 * hh_);
                            const s16x4 hi = ld_b64(Bc + row * 256 + (((c0 + 1) ^ (row & 15)) * 16) + 8 * hh_);
                            a2 = mfma32(mk8(lo, hi), Sb[t][s], a2);
                        }
#pragma unroll
                    for (int q = 0; q < 4; ++q) {
                        float ov[4];
#pragma unroll
                        for (int i = 0; i < 4; ++i) ov[i] = a1[4 * q + i] + exp2f(lg * (float)(32 * mt + 8 * q + 4 * hh_ + i + 1)) * a2[4 * q + i];
                        u32x2 pkd; pkd.x = cvt_pk_bf16(ov[0], ov[1]); pkd.y = cvt_pk_bf16(ov[2], ov[3]);
                        *(LAS u32x2*)(OSc + (32 * w + r_) * OST_PITCH + (32 * mt + 8 * q + 4 * hh_) * 2) = pkd;
                    }
                }
                bf16x8 vd[4];
#pragma unroll
                for (int ks = 0; ks < 4; ++ks) {
                    float f[8];
#pragma unroll
                    for (int j = 0; j < 8; ++j) { const int e = c - 1 - (16 * ks + 8 * hh_ + j); f[j] = e >= 0 ? exp2f(lg * (float)e) : 0.f; }
                    const u32x4 v4 = __builtin_bit_cast(u32x4, vf[ks]);
                    u32x4 o4;
                    o4.x = cvt_pk_bf16(bflo(v4.x) * f[0], bfhi(v4.x) * f[1]); o4.y = cvt_pk_bf16(bflo(v4.y) * f[2], bfhi(v4.y) * f[3]);
                    o4.z = cvt_pk_bf16(bflo(v4.z) * f[4], bfhi(v4.z) * f[5]); o4.w = cvt_pk_bf16(bflo(v4.w) * f[6], bfhi(v4.w) * f[7]);
                    vd[ks] = __builtin_bit_cast(bf16x8, o4);
                }
                const float gc = exp2f(lg * (float)c);
#pragma unroll
                for (int t = 0; t < 4; ++t) {
                    f32x16 a = S[t] * gc;
#pragma unroll
                    for (int ks = 0; ks < 4; ++ks) {
                        const int ra = 16 * ks + 8 * hh_ + (i16_ >> 2), rb = ra + 4;
                        const s16x4 lo = ld_tr(Bc + 16384 + ra * 256 + ((t ^ (ra & 3)) * 64) + trc);
                        const s16x4 hi = ld_tr(Bc + 16384 + rb * 256 + ((t ^ (rb & 3)) * 64) + trc);
                        a = mfma32(mk8(lo, hi), vd[ks], a);
                    }
                    S[t] = a;
                }
#pragma unroll
                for (int t = 0; t < 4; ++t) { Sb[t][0] = pk8(S[t], 0); Sb[t][1] = pk8(S[t], 1); }
            }
        } else {
            if (n + 1 < nchunks) { if (flags) chunk_wait(flags + (size_t)(n + 1) * 2048); const unsigned bn = lbase + ((n & 1) ^ 1) * SC_IMG; RET_DMA(n + 1, bn); }
            if (n >= 1) { int t0, c; chunk_of(sq, n - 1, t0, c); scan_finish<0>(OSp, w, lane, h, sq.row0 + t0, c, F.in[12], gpre, mix); }
            if (n < nchunks) { int t0, c; chunk_of(sq, n, t0, c); const int tok = 16 * w + (lane & 15);
                if (tok < c) { const u32x4* gp = (const u32x4*)(PR + (size_t)(sq.row0 + t0 + tok) * 2048 + 1536 + h * 128 + 32 * (lane >> 4));
#pragma unroll
                    for (int k = 0; k < 4; ++k) gpre[k] = gp[k]; } }
            asm volatile("s_waitcnt vmcnt(0)" ::: "memory");
        }
        __syncthreads();
    }
#undef RET_DMA
    if (isM) {
#pragma unroll
        for (int t = 0; t < 4; ++t)
#pragma unroll
            for (int e = 0; e < 16; ++e) sfinal[(32 * t + (e & 3) + 8 * (e >> 2) + 4 * hh) * 128 + 32 * w + r] = S[t][e];
    }
    __syncthreads();
}

__device__ __forceinline__ void sample_pair(Frame& F, int kind, int item0) {
    unsigned lbase = (unsigned)(uintptr_t)F.lds; int tid = F.tid;
    asm volatile("" : "+s"(lbase), "+v"(tid));
    const int half = tid >> 8, tt = tid & 255, col = tt & 127, part = tt >> 7, lane = tid & 63, wv = (tid >> 6) & 3;
    LAS float* B = (LAS float*)(uintptr_t)(lbase + half * 32768);
    LAS float* qs = B; LAS float* ks = B + 512; LAS float* vs = B + 1024; LAS float* T4 = B + 1536; LAS float* US = B + 3072; LAS float* PX = B + 3584; LAS float* SM = B + 5632;
    const int item = item0 + half, sb = item >> 2, h = item & 3;
    const int row0 = MPROMPT + sb * 4;
    const bf16_t* PR = (const bf16_t*)(F.ws + WS_PR); const bf16_t* PG = (const bf16_t*)(F.ws + WS_PG); const float* BG = (const float*)(F.ws + WS_BG);
    bf16_t* mix = (bf16_t*)((unsigned char*)F.out + OS_MIX);
    const float* sin_ = (kind ? F.in[3] : F.in[2]) + (size_t)item * 16384 + (size_t)(64 * part) * 128 + col;
    float* sout = F.out + (kind ? O_SSG : O_SSR) + (size_t)item * 16384 + (size_t)(64 * part) * 128 + col;
    float s[64];
#pragma unroll
    for (int d = 0; d < 64; ++d) s[d] = sin_[d * 128];
    const float lgam = h == 0 ? -0.04580368961312479f : h == 1 ? -0.02272007650008353f : h == 2 ? -0.011315313227834146f : -0.005646563141142063f;
    float cdec = 1.f;
    if (kind == 1) {
        const float* cgw = F.in[9]; const float* stq = F.in[4];
#pragma unroll
        for (int pass = 0; pass < 2; ++pass) {
            const int X = pass == 0 ? part : 2;
            if (pass == 0 || part == 0) {
                const int c = X * 512 + h * 128 + col;
                float full[7];
#pragma unroll
                for (int j = 0; j < 3; ++j) full[j] = stq[(size_t)(sb * 3 + j) * GQKV + c];
#pragma unroll
                for (int t = 0; t < 4; ++t) { const unsigned short b = PG[(size_t)(row0 + t) * 2048 + c]; full[3 + t] = __uint_as_float(((unsigned)b) << 16); }
                const float w0 = cgw[c], w1 = cgw[GQKV + c], w2 = cgw[2 * GQKV + c], w3 = cgw[3 * GQKV + c];
                LAS float* dst = X == 0 ? qs : (X == 1 ? ks : vs);
#pragma unroll
                for (int t = 0; t < 4; ++t) dst[t * 128 + col] = silu_f(w0 * full[t] + w1 * full[t + 1] + w2 * full[t + 2] + w3 * full[t + 3]);
            }
        }
        if (tt < 4) { SM[tt] = BG[(size_t)(row0 + tt) * 8 + 4 + h]; SM[4 + tt] = BG[(size_t)(row0 + tt) * 8 + h]; }
        __syncthreads();
        {
            const float q0 = qs[wv * 128 + lane], q1 = qs[wv * 128 + 64 + lane], k0 = ks[wv * 128 + lane], k1 = ks[wv * 128 + 64 + lane];
            const float rq = rsqrtf(wave_sum(q0 * q0 + q1 * q1) + EPS) * 0.08838834764831845f, rk = rsqrtf(wave_sum(k0 * k0 + k1 * k1) + EPS);
            qs[wv * 128 + lane] = q0 * rq; qs[wv * 128 + 64 + lane] = q1 * rq; ks[wv * 128 + lane] = k0 * rk; ks[wv * 128 + 64 + lane] = k1 * rk;
        }
        __syncthreads();
        float cum[4]; { float a = 0.f;
#pragma unroll
            for (int i = 0; i < 4; ++i) { a += SM[i]; cum[i] = a; } }
        cdec = __expf(cum[3]);
        {
#pragma unroll
            for (int j = 0; j < 4; ++j) {
                const float kk = wave_sum(ks[wv * 128 + lane] * ks[j * 128 + lane] + ks[wv * 128 + 64 + lane] * ks[j * 128 + 64 + lane]);
                const float qk = wave_sum(qs[wv * 128 + lane] * ks[j * 128 + lane] + qs[wv * 128 + 64 + lane] * ks[j * 128 + 64 + lane]);
                if (lane == 0) { const float dec = wv >= j ? __expf(cum[wv] - cum[j]) : 0.f; SM[8 + wv * 4 + j] = wv > j ? SM[4 + wv] * kk * dec : 0.f; SM[24 + wv * 4 + j] = qk * dec; }
            }
        }
        __syncthreads();
        {
            float x[4];
#pragma unroll
            for (int i = 0; i < 4; ++i) {
                float rr = part == 0 ? vs[i * 128 + col] * SM[4 + i] : ks[i * 128 + col] * SM[4 + i] * __expf(cum[i]);
#pragma unroll
                for (int j = 0; j < 4; ++j) if (j < i) rr -= SM[8 + i * 4 + j] * x[j];
                x[i] = rr;
            }
            if (part == 0) {
#pragma unroll
                for (int i = 0; i < 4; ++i) { US[i * 128 + col] = x[i]; T4[col * 12 + 4 + i] = qs[i * 128 + col] * __expf(cum[i]); }
            } else {
#pragma unroll
                for (int i = 0; i < 4; ++i) { T4[col * 12 + i] = x[i]; T4[col * 12 + 8 + i] = ks[i * 128 + col] * __expf(cum[3] - cum[i]); }
            }
        }
        __syncthreads();
    } else {
        if (part == 0) {
#pragma unroll
            for (int t = 0; t < 4; ++t) {
                const bf16_t* rp = PR + (size_t)(row0 + t) * 2048 + h * 128 + col;
                const float qv = __uint_as_float(((unsigned)rp[0]) << 16), kv = __uint_as_float(((unsigned)rp[512]) << 16), vv = __uint_as_float(((unsigned)rp[1024]) << 16);
                qs[t * 128 + col] = qv; ks[t * 128 + col] = kv; vs[t * 128 + col] = vv;
                T4[col * 12 + 4 + t] = qv;
                T4[col * 12 + 8 + t] = kv * exp2f(lgam * (float)(3 - t));
                T4[col * 12 + t] = 0.f;
            }
        }
        __syncthreads();
#pragma unroll
        for (int j = 0; j < 4; ++j) {
            const float qk = wave_sum(qs[wv * 128 + lane] * ks[j * 128 + lane] + qs[wv * 128 + 64 + lane] * ks[j * 128 + 64 + lane]);
            if (lane == 0) SM[24 + wv * 4 + j] = wv >= j ? qk * exp2f(lgam * (float)(wv - j)) : 0.f;
        }
        cdec = exp2f(lgam * 4.0f);
        __syncthreads();
    }
    float pw[4] = {0.f, 0.f, 0.f, 0.f}, pq[4] = {0.f, 0.f, 0.f, 0.f};
#pragma unroll
    for (int d = 0; d < 64; ++d) {
        const LAS f32x4* tp = (const LAS f32x4*)(T4 + (64 * part + d) * 12);
        const f32x4 wk4 = tp[0], qd4 = tp[1];
        pw[0] += wk4[0] * s[d]; pw[1] += wk4[1] * s[d]; pw[2] += wk4[2] * s[d]; pw[3] += wk4[3] * s[d];
        pq[0] += qd4[0] * s[d]; pq[1] += qd4[1] * s[d]; pq[2] += qd4[2] * s[d]; pq[3] += qd4[3] * s[d];
    }
#pragma unroll
    for (int i = 0; i < 4; ++i) { PX[(part * 8 + i) * 128 + col] = pw[i]; PX[(part * 8 + 4 + i) * 128 + col] = pq[i]; }
    __syncthreads();
    float w[4], o[4];
#pragma unroll
    for (int i = 0; i < 4; ++i) {
        const float sw = PX[i * 128 + col] + PX[(8 + i) * 128 + col], sq_ = PX[(4 + i) * 128 + col] + PX[(12 + i) * 128 + col];
        if (kind == 1) { w[i] = US[i * 128 + col] - sw; o[i] = sq_; } else { w[i] = vs[i * 128 + col]; o[i] = exp2f(lgam * (float)(i + 1)) * sq_; }
    }
#pragma unroll
    for (int i = 0; i < 4; ++i)
#pragma unroll
        for (int j = 0; j < 4; ++j) if (j <= i) o[i] += SM[24 + i * 4 + j] * w[j];
#pragma unroll
    for (int d = 0; d < 64; ++d) {
        const f32x4 kd4 = *(const LAS f32x4*)(T4 + (64 * part + d) * 12 + 8);
        sout[d * 128] = cdec * s[d] + kd4[0] * w[0] + kd4[1] * w[1] + kd4[2] * w[2] + kd4[3] * w[3];
    }
    float st[4], sq2[4];
#pragma unroll
    for (int i = 0; i < 4; ++i) { st[i] = wave_sum(o[i]); }
    if (part == 0 && lane == 0) {
#pragma unroll
        for (int i = 0; i < 4; ++i) SM[40 + (wv & 1) * 4 + i] = st[i]; }
    __syncthreads();
    float mu[4];
#pragma unroll
    for (int i = 0; i < 4; ++i) { mu[i] = kind == 0 ? (SM[40 + i] + SM[44 + i]) * (1.0f / 128.0f) : 0.f; const float dd = o[i] - mu[i]; sq2[i] = wave_sum(dd * dd); }
    if (part == 0 && lane == 0) {
#pragma unroll
        for (int i = 0; i < 4; ++i) SM[48 + (wv & 1) * 4 + i] = sq2[i]; }
    __syncthreads();
    if (part == 0) {
        const float nwv = kind == 0 ? F.in[12][h * 128 + col] : F.in[13][col];
        const bf16_t* gsrc = kind == 0 ? PR : PG;
#pragma unroll
        for (int i = 0; i < 4; ++i) {
            const float rstd = rsqrtf((SM[48 + i] + SM[52 + i]) * (1.0f / 128.0f) + EPS);
            const float gate = __uint_as_float(((unsigned)gsrc[(size_t)(row0 + i) * 2048 + 1536 + h * 128 + col]) << 16);
            mix[(size_t)(row0 + i) * DM + (kind == 0 ? 0 : 512) + h * 128 + col] = (bf16_t)(cvt_pk_bf16((o[i] - mu[i]) * rstd * nwv * gate, 0.f) & 0xffffu);
        }
    }
    __syncthreads();
}

struct Args { const float* in[20]; float* out; unsigned char* ws; int ph_lo, ph_hi, li, pad; };
constexpr int NPHASE = 8;

__global__ void __launch_bounds__(512, 2) mega_fwd(Args args) {
    extern __shared__ __attribute__((aligned(16))) unsigned char lds[];
    Frame F;
    F.lds = (LAS unsigned char*)lds;
    F.tid = threadIdx.x; F.lane = F.tid & 63; F.wave = __builtin_amdgcn_readfirstlane(F.tid >> 6);
    F.G = gridDim.x; F.blk = blockIdx.x;
#pragma unroll
    for (int i = 0; i < 20; ++i) F.in[i] = args.in[i];
    F.out = args.out; F.ws = args.ws;
    volatile LAS unsigned* MISC = (volatile LAS unsigned*)(F.lds + MISC_OFF);
    for (int u = F.tid; u < (LDS_BYTES - LDSCTL_OFF) / 4; u += 512) ((LAS unsigned*)(F.lds + LDSCTL_OFF))[u] = 0u;
    __syncthreads();
    unsigned* barw = (unsigned*)(F.ws + WS_CTL) + CW_BAR + args.li * XCD_BAR_WORDS;
    XcdBarrier bar; bar.bar = barw; bar.x = 0; bar.st = nullptr;
    if (MK_N_LAUNCHES == 1) bar = xcd_barrier_post(barw, MISC + 8);
    const int lo = args.ph_lo, hi = args.ph_hi;
#define IN(k) (lo <= (k) && (k) < hi)
#define SEAM(k) do { if (IN(k) && IN((k) + 1)) xcd_barrier(bar); } while (0)
#define STAMP(k) do { if (MK_TPROBE && F.tid == 0) ((unsigned*)(F.ws + WS_CTL))[CW_TS + (k) * 256 + F.blk] = (unsigned)__builtin_amdgcn_s_memrealtime(); } while (0)
    STAMP(0);

    for (int rep = 0; rep < 1 + (MK_REPEAT & 1); ++rep) { if (rep) xcd_barrier(bar); if (IN(0)) { p0_prologue(F); } }
    STAMP(1); SEAM(0);
    for (int rep = 0; rep < 1 + ((MK_REPEAT >> 1) & 1); ++rep) { if (rep) xcd_barrier(bar);
    if (IN(1)) {
        pg8::Gemm g{(const bf16_t*)(F.ws + WS_H), (const bf16_t*)(F.ws + WS_WIN), 1024};
        pg8::StaticOrder S; S.init(MPAD / 256, NIN / 256, F.G, F.blk);
        EpiIn E{(bf16_t*)(F.ws + WS_PR), (bf16_t*)(F.ws + WS_PG), (const float*)(F.ws + WS_ROT), F.out};
        pg8::gemm_phase<EpiIn, pg8::StaticOrder, pg8::MapPlain>(F.lds, g, S, E);
    } }
    STAMP(2); SEAM(1);
    if (IN(2)) {
        unsigned* FLG = (unsigned*)(F.ws + WS_CTL) + CW_FLAG;
        const int NW = F.G - 64;
        int it = F.blk < 64 ? F.blk : F.blk - 64;
        const int iend = F.blk < 64 ? F.blk + 1 : 33 * 64 + 512, istep = F.blk < 64 ? 1 : NW;
#pragma unroll 1
        for (; it < iend; it += istep) {
            int kind, h = 0, nch = 0, t0 = 0, c = 4; SeqD sq{0, 0, 0, 0}; unsigned char* slot = nullptr; float* sfinal = nullptr; int pair0 = 0; unsigned* flag = nullptr;
            if (F.blk < 64) {
                const int bb = it & 31, b = bb >> 2; h = bb & 3; kind = it < 32 ? 1 : 2; nch = 33;
                sq = SeqD{b * LP, LP, 0, b};
                slot = kind == 1 ? F.ws + WS_G2A + (size_t)(bb * 33) * SLOT : F.ws + WS_RP + (size_t)(bb * 33) * 8192;
                sfinal = F.out + (it < 32 ? O_PSG : O_PSR) + (size_t)bb * 16384;
                flag = FLG + (size_t)((kind == 1 ? 0 : 33 * 32) + bb) * 64;
            } else if (it < 33 * 64) {
                const int n = it >> 6, j = ((it & 63) + 11 * n) & 63, bh = j & 31, b = bh >> 2; h = bh & 3; kind = j < 32 ? 6 : 0;
                sq = SeqD{b * LP, LP, 0, b}; t0 = n == 0 ? 0 : 16 + 64 * (n - 1); c = n == 0 ? 16 : 64;
                slot = kind == 0 ? F.ws + WS_G2A + (size_t)(bh * 33 + n) * SLOT : F.ws + WS_RP + (size_t)(bh * 33 + n) * 8192;
                flag = FLG + (size_t)(((kind == 0 ? 0 : 33) + n) * 32 + bh) * 64;
            } else { const int j = it - 33 * 64; kind = j < 256 ? 4 : 5; pair0 = (j & 255) * 2; }
            if (kind == 0) { p2a_item(F, sq, h, t0, c, slot); chunk_publish(flag); }
            if (kind == 6) { ret_prepass_item(F, sq, h, t0, c, slot); chunk_publish(flag); }
            if (kind == 4 || kind == 5) sample_pair(F, kind == 4 ? 1 : 0, pair0);
            if (kind == 1) scan_gdn(F, sq, h, nch, slot, nullptr, sfinal, flag);
            if (kind == 2) scan_ret(F, sq, h, nch, slot, sfinal, flag);
        }
    }
    STAMP(3);
    STAMP(4); SEAM(3);
    for (int rep = 0; rep < 1 + ((MK_REPEAT >> 4) & 1); ++rep) { if (rep) xcd_barrier(bar);
    if (IN(4)) {
        pg8::Gemm g{(const bf16_t*)((unsigned char*)F.out + OS_MIX), (const bf16_t*)(F.ws + WS_WOUT), 1024};
        pg8::StaticOrder S; S.init(TROW0 / 256, 4, F.G, F.blk);
        EpiOut E{F.in[0], F.in[1], F.in[6], (bf16_t*)(F.ws + WS_X2B), (float*)(F.ws + WS_RSQ2)};
        pg8::gemm_phase<EpiOut, pg8::StaticOrder, pg8::MapPlain>(F.lds, g, S, E);
        skinny_phase(F, g.A, g.Bt, 1024, (float*)(F.ws + WS_RSQ2), QuadOut{F.in[0], F.in[1], F.in[6], (bf16_t*)(F.ws + WS_X2B)});
    } }
    STAMP(5); SEAM(4);
    for (int rep = 0; rep < 1 + ((MK_REPEAT >> 5) & 1); ++rep) { if (rep) xcd_barrier(bar);
    if (IN(5)) {
        pg8::Gemm g{(const bf16_t*)(F.ws + WS_X2B), (const bf16_t*)(F.ws + WS_WUP), 1024};
        pg8::StaticOrder S; S.init(UP_NM, NUP / 256, F.G, F.blk);
        EpiUp E{(const float*)(F.ws + WS_RSQ2), F.in[17], F.in[5], (bf16_t*)(F.ws + WS_ACT), F.out};
        pg8::gemm_phase<EpiUp, pg8::StaticOrder, pg8::MapUp>(F.lds, g, S, E);
    } }
    STAMP(6); SEAM(5);
    for (int rep = 0; rep < 1 + ((MK_REPEAT >> 6) & 1); ++rep) { if (rep) xcd_barrier(bar);
    if (IN(6)) {
        pg8::Gemm g{(const bf16_t*)(F.ws + WS_ACT), (const bf16_t*)(F.ws + WS_WDN), DFF};
        pg8::StaticOrder S; S.init(TROW0 / 256, 4, F.G, F.blk);
        EpiDown E{(const bf16_t*)(F.ws + WS_X2B), F.out, (float*)(F.ws + WS_RSQ3)};
        pg8::gemm_phase<EpiDown, pg8::StaticOrder, pg8::MapPlain>(F.lds, g, S, E);
        skinny_phase(F, g.A, g.Bt, DFF, (float*)(F.ws + WS_RSQ3), QuadDown{(const bf16_t*)(F.ws + WS_X2B), F.out});
    } }
    STAMP(7); SEAM(6);
    if (IN(7)) {
        const float* rsq = (const float*)(F.ws + WS_RSQ3); const float* nf = F.in[19];
        const int gw = F.blk * 8 + F.wave, NGW = F.G * 8;
        for (int q = gw; q < 16384 + 512; q += NGW) {
            int g; float* dst;
            if (q < 16384) { g = (q >> 11) * LP + 16 + (q & 2047); dst = F.out + O_YP + (size_t)q * DM; } else { g = MPROMPT + (q - 16384); dst = F.out + O_YS + (size_t)(q - 16384) * DM; }
            float s = F.lane < 16 ? rsq[(size_t)g * 16 + F.lane] : 0.f;
            s = wave_sum(s);
            const float rstd = rsqrtf(s * (1.0f / DM) + EPS);
            f32x4* p = (f32x4*)dst + F.lane; const f32x4* np = (const f32x4*)nf + F.lane;
#pragma unroll
            for (int j = 0; j < 4; ++j) { f32x4 v = p[64 * j]; v = v * rstd * np[64 * j]; p[64 * j] = v; }
        }
    }
    if (MK_TPROBE && IN(7)) {
        STAMP(8);
        xcd_barrier(bar);
        if (F.blk == 0) {
            LAS float* sh = (LAS float*)F.lds;
            if (F.tid == 0) {
                const unsigned* TS = (const unsigned*)(F.ws + WS_CTL) + CW_TS;
                auto mx = [&](int k, int lo_, int hi_) { unsigned m = TS[k * 256 + lo_]; for (int b = lo_; b < hi_; ++b) { const unsigned v = TS[k * 256 + b]; if ((int)(v - m) > 0) m = v; } return m; };
                unsigned d = 0;
                const int sel = MK_TPROBE;
                if (sel >= 1 && sel <= 8) d = mx(sel, 0, F.G) - mx(sel - 1, 0, F.G);
                else if (sel == 10) d = TS[4 * 256 + 0] - mx(3, 0, F.G);
                else if (sel == 11) d = TS[4 * 256 + 32] - mx(3, 0, F.G);
                else if (sel == 12) d = mx(4, 64, F.G) - mx(3, 0, F.G);
                else if (sel == 13) d = mx(8, 0, F.G) - TS[0];
                else if (sel == 14) d = TS[3 * 256 + 0] - mx(2, 0, F.G);
                else if (sel == 15) d = TS[3 * 256 + 32] - mx(2, 0, F.G);
                else if (sel == 16) d = mx(3, 64, F.G) - mx(2, 0, F.G);
                else if (sel >= 20 && sel <= 23) d = TS[(sel - 11) * 256 + 0];
                else if (sel >= 30 && sel <= 41) d = TS[(sel - 17) * 256 + 0] - mx(2, 0, F.G);
                else if (sel >= 50 && sel <= 59) d = TS[(sel - 24) * 256 + 0];
                else if (sel >= 60 && sel <= 69) d = TS[(sel - 34) * 256 + 64];
                sh[0] = sqrtf(MK_TSCALE * (float)d * 0.01f);
            }
            __syncthreads();
            const float f = 1.0f + sh[0];
            for (int e = F.tid; e < 8 * 3 * GQKV; e += 512) F.out[O_PCQ + e] *= f;
        }
    }
#undef IN
#undef SEAM
}

extern "C" void kernel_launch(void* const* d_in, const int* in_sizes, int n_in, void* d_out, int out_size, void* d_ws, size_t ws_size, hipStream_t stream) {
    static int grid = 0;
    if (grid == 0) {
        if (n_in != 20 || (size_t)out_size != O_TOTAL || ws_size < WS_END) { fprintf(stderr, "kernel_launch: unexpected shapes (n_in %d, out %d, ws %zu); nothing launched\n", n_in, out_size, ws_size); grid = -1; return; }
        int dev = 0, cus = 0;
        if (hipGetDevice(&dev) != hipSuccess || hipDeviceGetAttribute(&cus, hipDeviceAttributeMultiprocessorCount, dev) != hipSuccess) { grid = -1; return; }
        if (hipFuncSetAttribute((const void*)mega_fwd, hipFuncAttributeMaxDynamicSharedMemorySize, LDS_BYTES) != hipSuccess) { fprintf(stderr, "kernel_launch: hipFuncSetAttribute failed\n"); grid = -1; return; }
        (void)hipGetLastError();
        grid = cus;
        if (grid < 128 || (grid & 7)) { fprintf(stderr, "kernel_launch: unexpected CU count %d\n", cus); }
    }
    if (grid < 0) return;
    if (hipMemsetAsync((char*)d_ws + WS_CTL, 0, CTL_ZERO_BYTES, stream) != hipSuccess) return;
    Args a{};
    for (int i = 0; i < 20; ++i) a.in[i] = (const float*)d_in[i];
    a.out = (float*)d_out; a.ws = (unsigned char*)d_ws;
#if MK_N_LAUNCHES == 1
    a.ph_lo = 0; a.ph_hi = NPHASE; a.li = 0;
    hipLaunchKernelGGL(mega_fwd, dim3(grid), dim3(512), LDS_BYTES, stream, a);
#else
    for (int li = 0; li < NPHASE; ++li) { a.ph_lo = li; a.ph_hi = li + 1; a.li = 0; hipLaunchKernelGGL(mega_fwd, dim3(grid), dim3(512), LDS_BYTES, stream, a); }
#endif
}
```
